# Optimizing an MI355X kernel written in HIP

```python
import numpy as np
import jax
import jax.numpy as jnp
from jax import lax

D_MODEL = 1024
BATCH = 4
SEQ = 8192
DEPTH = 1

D_CONV = 512
CONV_K = 31
N_HEADS = 16
N_KV_GROUPS = 4
HEADS_PER_GROUP = N_HEADS // N_KV_GROUPS
HEAD_DIM = 64
CMP_BLOCK = 32
CMP_STRIDE = 16
CMP_HIDDEN = 2 * HEAD_DIM
SEL_BLOCK = 64
SEL_TOPK = 16
WINDOW = 512
Q_CHUNK = 64
FORCED_SCORE = 1e4
N_EXPERTS = 256
TOP_K = 8
N_GROUPS = 8
TOPK_GROUPS = 4
D_EXPERT = 256
D_SHARED = 256
ROUTED_SCALE = 2.5
MOE_BLOCK = 128

EPS = 1e-6
NEG = -1e30

N_Q = N_HEADS * HEAD_DIM
N_KV = 3 * 2 * N_KV_GROUPS * HEAD_DIM
N_NSA_GATE = 3 * N_HEADS
N_IN = 2 * D_CONV + N_Q + N_KV + N_NSA_GATE + 2 * D_MODEL

kernel_name = 'hybrid_conv_nsa_moe_adaln_block'


def rmsnorm(x, g):
    xf = x.astype(jnp.float32)
    y = xf * lax.rsqrt(jnp.mean(xf * xf, axis=-1, keepdims=True) + EPS)
    return (y * g.astype(jnp.float32)).astype(x.dtype)


def layernorm(x, g, b):
    xf = x.astype(jnp.float32)
    mu = jnp.mean(xf, axis=-1, keepdims=True)
    var = jnp.mean(jnp.square(xf - mu), axis=-1, keepdims=True)
    y = (xf - mu) * lax.rsqrt(var + EPS)
    return (y * g.astype(jnp.float32) + b.astype(jnp.float32)).astype(x.dtype)


def modulate(h, shift, scale):
    return h * (1.0 + scale[:, None, :]) + shift[:, None, :]


def masked_softmax(s, mask):
    p = jax.nn.softmax(jnp.where(mask, s, NEG), axis=-1)
    return jnp.where(mask, p, 0.0)


def swiglu(x, w_gate, w_up, w_down):
    return (jax.nn.silu(x @ w_gate) * (x @ w_up)) @ w_down


def conformer_conv(u_glu, conv_w, conv_b, ln_g, ln_b, w_o, b_o):
    a, gt = jnp.split(u_glu, 2, axis=-1)
    u = a * jax.nn.sigmoid(gt)
    u = lax.conv_general_dilated(u, conv_w[:, None, :].astype(u.dtype), window_strides=(1,),
                                 padding=[(CONV_K - 1, 0)], dimension_numbers=('NWC', 'WIO', 'NWC'),
                                 feature_group_count=D_CONV) + conv_b
    u = jax.nn.silu(layernorm(u, ln_g, ln_b))
    return u @ w_o + b_o


def compress_kv(z, pe, w1, w2):
    B, S, G, Dh = z.shape
    n_cmp = (S - CMP_BLOCK) // CMP_STRIDE + 1
    idx = CMP_STRIDE * np.arange(n_cmp)[:, None] + np.arange(CMP_BLOCK)[None, :]
    blk = z[:, idx] + pe[None, None, :, None, :]
    blk = blk.transpose(0, 1, 3, 2, 4).reshape(B, n_cmp, G, CMP_BLOCK * Dh)
    return jax.nn.gelu(blk @ w1) @ w2


def nsa_attention(q, k_c, v_c, k_s, v_s, k_w, v_w, gates):
    B, S, G, HG, Dh = q.shape
    n_cmp = k_c.shape[1]
    n_sel = S // SEL_BLOCK
    n_top = min(SEL_TOPK, n_sel)
    scale = Dh ** -0.5
    cmp_end = jnp.asarray(CMP_STRIDE * np.arange(n_cmp) + CMP_BLOCK - 1, dtype=jnp.int32)
    cs = CMP_STRIDE * np.arange(n_cmp)[:, None]
    ss = SEL_BLOCK * np.arange(n_sel)[None, :]
    overlap = jnp.asarray(((cs <= ss + SEL_BLOCK - 1) & (cs + CMP_BLOCK - 1 >= ss)).astype(np.float32))
    ks_blk = k_s.reshape(B, n_sel, SEL_BLOCK, G, Dh).transpose(0, 3, 1, 2, 4)
    vs_blk = v_s.reshape(B, n_sel, SEL_BLOCK, G, Dh).transpose(0, 3, 1, 2, 4)
    kw_pad = jnp.pad(k_w, ((0, 0), (WINDOW, 0), (0, 0), (0, 0)))
    vw_pad = jnp.pad(v_w, ((0, 0), (WINDOW, 0), (0, 0), (0, 0)))
    b_ix = jnp.arange(B)[:, None, None, None]
    g_ix = jnp.arange(G)[None, :, None, None]
    sel_ids = jnp.arange(n_sel)

    def chunk(ci):
        t0 = ci * Q_CHUNK
        tq = t0 + jnp.arange(Q_CHUNK)
        qc = lax.dynamic_slice_in_dim(q, t0, Q_CHUNK, axis=1)
        gc = lax.dynamic_slice_in_dim(gates, t0, Q_CHUNK, axis=1)
        s = jnp.einsum('bqghd,bngd->bghqn', qc, k_c).astype(jnp.float32) * scale
        p_c = masked_softmax(s, cmp_end[None, :] <= tq[:, None])
        o_c = jnp.einsum('bghqn,bngd->bqghd', p_c.astype(v_c.dtype), v_c)
        imp = jnp.einsum('bgqn,nj->bgqj', p_c.sum(axis=2), overlap)
        jq = tq // SEL_BLOCK
        forced = (sel_ids[None, :] == 0) | (sel_ids[None, :] == jq[:, None]) | (sel_ids[None, :] == jq[:, None] - 1)
        imp = jnp.where(forced, FORCED_SCORE, jnp.where(sel_ids[None, :] <= jq[:, None], imp, -1.0))
        _, sel = lax.top_k(imp, n_top)
        k_sel = ks_blk[b_ix, g_ix, sel].reshape(B, G, Q_CHUNK, n_top * SEL_BLOCK, Dh)
        v_sel = vs_blk[b_ix, g_ix, sel].reshape(B, G, Q_CHUNK, n_top * SEL_BLOCK, Dh)
        pos = (sel[..., None] * SEL_BLOCK + jnp.arange(SEL_BLOCK)).reshape(B, G, Q_CHUNK, n_top * SEL_BLOCK)
        s = jnp.einsum('bqghd,bgqkd->bghqk', qc, k_sel).astype(jnp.float32) * scale
        p_s = masked_softmax(s, (pos <= tq[None, None, :, None])[:, :, None])
        o_s = jnp.einsum('bghqk,bgqkd->bqghd', p_s.astype(v_sel.dtype), v_sel)
        kwc = lax.dynamic_slice_in_dim(kw_pad, t0, WINDOW + Q_CHUNK, axis=1)
        vwc = lax.dynamic_slice_in_dim(vw_pad, t0, WINDOW + Q_CHUNK, axis=1)
        kpos = t0 - WINDOW + jnp.arange(WINDOW + Q_CHUNK)
        wmask = (kpos[None, :] <= tq[:, None]) & (kpos[None, :] > tq[:, None] - WINDOW) & (kpos[None, :] >= 0)
        s = jnp.einsum('bqghd,bkgd->bghqk', qc, kwc).astype(jnp.float32) * scale
        p_w = masked_softmax(s, wmask)
        o_w = jnp.einsum('bghqk,bkgd->bqghd', p_w.astype(vwc.dtype), vwc)
        return gc[..., 0:1] * o_c + gc[..., 1:2] * o_s + gc[..., 2:3] * o_w

    o = lax.map(chunk, jnp.arange(S // Q_CHUNK))
    return o.transpose(1, 0, 2, 3, 4, 5).reshape(B, S, G * HG * Dh)


def moe_route(xf, w_router, router_bias):
    T = xf.shape[0]
    scores = jax.nn.sigmoid((xf @ w_router).astype(jnp.float32))
    sfc = scores + router_bias.astype(jnp.float32)
    grp = sfc.reshape(T, N_GROUPS, N_EXPERTS // N_GROUPS)
    grp_score = lax.top_k(grp, 2)[0].sum(axis=-1)
    _, gidx = lax.top_k(grp_score, TOPK_GROUPS)
    gmask = jax.nn.one_hot(gidx, N_GROUPS, dtype=jnp.float32).sum(axis=-2) > 0
    emask = jnp.repeat(gmask, N_EXPERTS // N_GROUPS, axis=-1)
    _, idx = lax.top_k(jnp.where(emask, sfc, NEG), TOP_K)
    w = jnp.take_along_axis(scores, idx, axis=-1)
    w = w / jnp.sum(w, axis=-1, keepdims=True) * ROUTED_SCALE
    return idx, w


def moe_routed(xf, idx, wts, w_gate, w_up, w_down):
    T, D = xf.shape
    A = T * TOP_K
    flat_e = idx.reshape(A)
    flat_tok = jnp.arange(A, dtype=jnp.int32) // TOP_K
    flat_w = wts.reshape(A).astype(xf.dtype)
    order = jnp.argsort(flat_e)
    sorted_e = flat_e[order]
    counts = jnp.bincount(flat_e, length=N_EXPERTS)
    padded = (counts + MOE_BLOCK - 1) // MOE_BLOCK * MOE_BLOCK
    pad_end = jnp.cumsum(padded)
    pad_start = pad_end - padded
    start = jnp.cumsum(counts) - counts
    dest = pad_start[sorted_e] + jnp.arange(A) - start[sorted_e]
    n_blocks = -(-A // MOE_BLOCK) + N_EXPERTS
    P = n_blocks * MOE_BLOCK
    buf_tok = jnp.full((P,), T, jnp.int32).at[dest].set(flat_tok[order])
    buf_w = jnp.zeros((P,), xf.dtype).at[dest].set(flat_w[order])
    block_e = jnp.minimum(jnp.searchsorted(pad_end, jnp.arange(n_blocks) * MOE_BLOCK, side='right'), N_EXPERTS - 1)
    x_pad = jnp.concatenate([xf, jnp.zeros((1, D), xf.dtype)], axis=0)

    def body(acc, inp):
        tok, w, e = inp
        xb = x_pad[tok]
        yb = swiglu(xb, w_gate[e], w_up[e], w_down[e]) * w[:, None]
        return acc.at[tok].add(yb), None

    acc, _ = lax.scan(body, jnp.zeros((T + 1, D), xf.dtype),
                      (buf_tok.reshape(n_blocks, MOE_BLOCK), buf_w.reshape(n_blocks, MOE_BLOCK), block_e))
    return acc[:T]


def hybrid_layer(x, c, w_ada, b_ada, norm1_g, w_in, b_in, conv_w, conv_b, conv_ln_g, conv_ln_b,
                 w_conv_out, b_conv_out, cmp_pe_k, cmp_w1_k, cmp_w2_k, cmp_pe_v, cmp_w1_v, cmp_w2_v,
                 w_nsa_out, w_out, norm2_g, w_router, router_bias, w_sh_gate, w_sh_up, w_sh_down,
                 w_gate, w_up, w_down):
    B, S, D = x.shape
    mod = jax.nn.silu(c) @ w_ada + b_ada
    sh1, sc1, g1, sh2, sc2, g2 = jnp.split(mod, 6, axis=-1)
    h = modulate(rmsnorm(x, norm1_g), sh1, sc1)
    proj = h @ w_in + b_in
    offs = [2 * D_CONV, 2 * D_CONV + N_Q, 2 * D_CONV + N_Q + N_KV, 2 * D_CONV + N_Q + N_KV + N_NSA_GATE]
    p_conv, p_q, p_kv, p_ng, p_merge = jnp.split(proj, offs, axis=-1)
    y_a = conformer_conv(p_conv, conv_w, conv_b, conv_ln_g, conv_ln_b, w_conv_out, b_conv_out)
    q = p_q.reshape(B, S, N_KV_GROUPS, HEADS_PER_GROUP, HEAD_DIM)
    kv = p_kv.reshape(B, S, 3, 2, N_KV_GROUPS, HEAD_DIM)
    k_c = compress_kv(kv[:, :, 0, 0], cmp_pe_k, cmp_w1_k, cmp_w2_k)
    v_c = compress_kv(kv[:, :, 0, 1], cmp_pe_v, cmp_w1_v, cmp_w2_v)
    gates = jax.nn.sigmoid(p_ng.reshape(B, S, N_KV_GROUPS, HEADS_PER_GROUP, 3))
    o = nsa_attention(q, k_c, v_c, kv[:, :, 1, 0], kv[:, :, 1, 1], kv[:, :, 2, 0], kv[:, :, 2, 1], gates)
    y_b = o @ w_nsa_out
    gm_a, gm_b = jnp.split(jax.nn.sigmoid(p_merge), 2, axis=-1)
    mix = (gm_a * y_a + gm_b * y_b) @ w_out
    x = x + g1[:, None, :] * mix
    h2 = modulate(rmsnorm(x, norm2_g), sh2, sc2)
    hf = h2.reshape(B * S, D)
    idx, wts = moe_route(hf, w_router, router_bias)
    y = swiglu(hf, w_sh_gate, w_sh_up, w_sh_down) + moe_routed(hf, idx, wts, w_gate, w_up, w_down)
    return x + g2[:, None, :] * y.reshape(B, S, D)


def setup_inputs(seed: int = 0) -> dict:
    key = jax.random.key(seed)
    ks = jax.random.split(key, 40)
    L = DEPTH

    def nrm(k, shape, s):
        return jax.random.normal(k, shape, jnp.float32) * s

    return {
        'x': nrm(ks[0], (BATCH, SEQ, D_MODEL), 1.0),
        'c': nrm(ks[1], (BATCH, D_MODEL), 1.0),
        'w_ada': nrm(ks[2], (L, D_MODEL, 6 * D_MODEL), 0.5 * D_MODEL ** -0.5),
        'b_ada': nrm(ks[3], (L, 6 * D_MODEL), 0.02),
        'norm1_g': 1.0 + nrm(ks[4], (L, D_MODEL), 0.02),
        'w_in': nrm(ks[5], (L, D_MODEL, N_IN), D_MODEL ** -0.5),
        'b_in': nrm(ks[6], (L, N_IN), 0.02),
        'conv_w': nrm(ks[7], (L, CONV_K, D_CONV), CONV_K ** -0.5),
        'conv_b': nrm(ks[8], (L, D_CONV), 0.02),
        'conv_ln_g': 1.0 + nrm(ks[9], (L, D_CONV), 0.02),
        'conv_ln_b': nrm(ks[10], (L, D_CONV), 0.02),
        'w_conv_out': nrm(ks[11], (L, D_CONV, D_MODEL), D_CONV ** -0.5),
        'b_conv_out': nrm(ks[12], (L, D_MODEL), 0.02),
        'cmp_pe_k': nrm(ks[13], (L, CMP_BLOCK, HEAD_DIM), 0.02),
        'cmp_w1_k': nrm(ks[14], (L, CMP_BLOCK * HEAD_DIM, CMP_HIDDEN), (CMP_BLOCK * HEAD_DIM) ** -0.5),
        'cmp_w2_k': nrm(ks[15], (L, CMP_HIDDEN, HEAD_DIM), CMP_HIDDEN ** -0.5),
        'cmp_pe_v': nrm(ks[16], (L, CMP_BLOCK, HEAD_DIM), 0.02),
        'cmp_w1_v': nrm(ks[17], (L, CMP_BLOCK * HEAD_DIM, CMP_HIDDEN), (CMP_BLOCK * HEAD_DIM) ** -0.5),
        'cmp_w2_v': nrm(ks[18], (L, CMP_HIDDEN, HEAD_DIM), CMP_HIDDEN ** -0.5),
        'w_nsa_out': nrm(ks[19], (L, N_Q, D_MODEL), N_Q ** -0.5),
        'w_out': nrm(ks[20], (L, D_MODEL, D_MODEL), D_MODEL ** -0.5),
        'norm2_g': 1.0 + nrm(ks[21], (L, D_MODEL), 0.02),
        'w_router': nrm(ks[22], (L, D_MODEL, N_EXPERTS), D_MODEL ** -0.5),
        'router_bias': nrm(ks[23], (L, N_EXPERTS), 0.01),
        'w_sh_gate': nrm(ks[24], (L, D_MODEL, D_SHARED), D_MODEL ** -0.5),
        'w_sh_up': nrm(ks[25], (L, D_MODEL, D_SHARED), D_MODEL ** -0.5),
        'w_sh_down': nrm(ks[26], (L, D_SHARED, D_MODEL), D_SHARED ** -0.5),
        'w_gate': nrm(ks[27], (L, N_EXPERTS, D_MODEL, D_EXPERT), D_MODEL ** -0.5),
        'w_up': nrm(ks[28], (L, N_EXPERTS, D_MODEL, D_EXPERT), D_MODEL ** -0.5),
        'w_down': nrm(ks[29], (L, N_EXPERTS, D_EXPERT, D_MODEL), D_EXPERT ** -0.5),
        'final_g': 1.0 + nrm(ks[30], (D_MODEL,), 0.02),
    }


def reference(x, c, w_ada, b_ada, norm1_g, w_in, b_in, conv_w, conv_b, conv_ln_g, conv_ln_b,
              w_conv_out, b_conv_out, cmp_pe_k, cmp_w1_k, cmp_w2_k, cmp_pe_v, cmp_w1_v, cmp_w2_v,
              w_nsa_out, w_out, norm2_g, w_router, router_bias, w_sh_gate, w_sh_up, w_sh_down,
              w_gate, w_up, w_down, final_g):
    for l in range(DEPTH):
        x = hybrid_layer(x, c, w_ada[l], b_ada[l], norm1_g[l], w_in[l], b_in[l], conv_w[l], conv_b[l],
                         conv_ln_g[l], conv_ln_b[l], w_conv_out[l], b_conv_out[l], cmp_pe_k[l],
                         cmp_w1_k[l], cmp_w2_k[l], cmp_pe_v[l], cmp_w1_v[l], cmp_w2_v[l], w_nsa_out[l],
                         w_out[l], norm2_g[l], w_router[l], router_bias[l], w_sh_gate[l], w_sh_up[l],
                         w_sh_down[l], w_gate[l], w_up[l], w_down[l])
    return rmsnorm(x, final_g)
```

```cpp
#include <hip/hip_runtime.h>
#include <cstdio>
#include <cstdint>

#define GAS __attribute__((address_space(1)))
#define LAS __attribute__((address_space(3)))
typedef unsigned short bf16;
typedef short bf16x8 __attribute__((ext_vector_type(8)));
typedef float f32x4 __attribute__((ext_vector_type(4)));
typedef float f32x2 __attribute__((ext_vector_type(2)));
typedef float f32x16 __attribute__((ext_vector_type(16)));
typedef unsigned u32x4 __attribute__((ext_vector_type(4)));
typedef unsigned u32x2 __attribute__((ext_vector_type(2)));
typedef GAS unsigned gu32;

constexpr int BATCH = 4, SEQ = 8192, DM = 1024, T = BATCH * SEQ;
constexpr int DCONV = 512, CONVK = 31;
constexpr int NH = 16, NG = 4, HG = 4, HD = 64;
constexpr int NCMP = 511, NSEL = 128, SELTOP = 16, WINDOW = 512;
constexpr int NEXP = 256, TOPK = 8, DEXP = 256;
constexpr int NIN = 5680, NINP = 5888;
constexpr float EPS = 1e-6f;
constexpr int NWAVES = 8, NTHREADS = 512;

constexpr size_t MiB = 1u << 20;
constexpr size_t WS_CTL = 0, CTL_ZERO_BYTES = 1 * MiB;
constexpr size_t WS_MODP = 1 * MiB;
constexpr size_t WS_MODF = 2 * MiB;
constexpr size_t WS_PEBP = 2 * MiB + 128 * 1024;
constexpr size_t WS_PEBF = 2 * MiB + 160 * 1024;
constexpr size_t WS_BINP = 2 * MiB + 192 * 1024;
constexpr size_t WS_WIN = 3 * MiB;
constexpr size_t WS_WC = 15 * MiB;
constexpr size_t WS_WN = 16 * MiB;
constexpr size_t WS_WO = 18 * MiB;
constexpr size_t WS_WR = 20 * MiB;
constexpr size_t WS_WSHGU = 21 * MiB;
constexpr size_t WS_WSHD = 22 * MiB;
constexpr size_t WS_CW1 = 23 * MiB;
constexpr size_t WS_CW2 = 24 * MiB;
constexpr size_t WS_WGU = 32 * MiB;
constexpr size_t WS_WD = 288 * MiB;
constexpr size_t WS_XN = 416 * MiB;
constexpr size_t WS_U = 480 * MiB;
constexpr size_t WS_CF = 512 * MiB;
constexpr size_t WS_Q = 544 * MiB;
constexpr size_t WS_O = 608 * MiB;
constexpr size_t WS_KV = 672 * MiB;
constexpr size_t KV_STRIDE = 16 * MiB;
constexpr size_t WS_VST = 768 * MiB;
constexpr size_t WS_VWT = 784 * MiB;
constexpr size_t WS_KC = 800 * MiB;
constexpr size_t WS_VCT = 801 * MiB;
constexpr size_t WS_NGT = 802 * MiB;
constexpr size_t WS_GM = 808 * MiB;
constexpr size_t WS_MIX = 936 * MiB;
constexpr size_t WS_LOG = 480 * MiB;
constexpr size_t WS_RTE = 512 * MiB;
constexpr size_t WS_RTS = 513 * MiB;
constexpr size_t WS_RTW = 514 * MiB;
constexpr size_t WS_TOKL = 516 * MiB;
constexpr size_t WS_ACT = 548 * MiB;
constexpr size_t WS_ACTSH = 680 * MiB;
constexpr size_t WS_YS = 696 * MiB;
constexpr size_t WS_END = 952 * MiB;

constexpr int CW_TMO = 0, CW_CODE = 1;
constexpr int CW_BAR = 4096;
constexpr int CW_CNT = 32768;

constexpr int RING_OFF = 0, RING_BYTES = 131072;
constexpr int LDSCTL_OFF = RING_BYTES, MISC_OFF = LDSCTL_OFF + 320;
constexpr int TAB_OFF = LDSCTL_OFF + 1024;
constexpr int LDS_BYTES = 147456;

#define LDS_WAIT() asm volatile("s_waitcnt lgkmcnt(0)" ::: "memory")
#define VM_WAIT() asm volatile("s_waitcnt vmcnt(0)" ::: "memory")
#define RLX_AGENT __ATOMIC_RELAXED, __HIP_MEMORY_SCOPE_AGENT

__device__ __forceinline__ unsigned f2bf(float f) { unsigned u = __builtin_bit_cast(unsigned, f); return (u + 0x7fffu + ((u >> 16) & 1u)) >> 16; }
__device__ __forceinline__ unsigned pk2(float lo, float hi) { return f2bf(lo) | (f2bf(hi) << 16); }
__device__ __forceinline__ float bf2f(unsigned b) { return __builtin_bit_cast(float, b << 16); }
__device__ __forceinline__ float bflo(unsigned w) { return __builtin_bit_cast(float, w << 16); }
__device__ __forceinline__ float bfhi(unsigned w) { return __builtin_bit_cast(float, w & 0xffff0000u); }
__device__ __forceinline__ float sigmoidf_(float x) { return __builtin_amdgcn_rcpf(1.0f + __expf(-x)); }
__device__ __forceinline__ float wave_sum(float v) {
#pragma unroll
    for (int o = 1; o < 64; o <<= 1) v += __shfl_xor(v, o);
    return v;
}
__device__ __forceinline__ float wave_max(float v) {
#pragma unroll
    for (int o = 1; o < 64; o <<= 1) v = fmaxf(v, __shfl_xor(v, o));
    return v;
}

namespace pg8 {
constexpr int BM = 256, BK = 64, HALF = 128, HTB = HALF * BK * 2, STAGE_BYTES = 8 * HTB, NXCD = 8, WGM = 8;
__host__ __device__ __forceinline__ int lds_byte(int r, int c) { const int st = (r >> 4) * 2 + (c >> 5), rr = r & 15, cc = c & 31, ob = rr * 64 + cc * 2; return st * 1024 + (ob ^ (((ob >> 9) & 1) << 5)); }
__host__ __device__ __forceinline__ void stage_rc(int b, int& R, int& C) { const int st = b / 1024, sb = b % 1024, swz = sb ^ (((sb >> 9) & 1) << 5); R = (st >> 1) * 16 + swz / 64; C = (st & 1) * 32 + (swz % 64) / 2; }
__host__ __device__ __forceinline__ int perm32(int rho) { const int n = rho >> 4, i = rho & 15; return 8 * (i >> 2) + 4 * n + (i & 3); }

struct Unit { int pm, pn; const char* A; const char* B; int e, mt, cnt, off; };

typedef __bf16 bf16x2_t __attribute__((ext_vector_type(2)));
__device__ __forceinline__ unsigned cvt_pk_bf16(float lo, float hi) { f32x2 v = {lo, hi}; bf16x2_t b = __builtin_convertvector(v, bf16x2_t); return __builtin_bit_cast(unsigned, b); }

struct DenseOrder {
    const char* A; const char* Bt; int lda_b, K; int nM, nN, nwg, G, c;
    __device__ void init(const void* A_, int lda_bytes, const void* Bt_, int K_, int M, int N, int G_, int c_) { A = (const char*)A_; Bt = (const char*)Bt_; lda_b = lda_bytes; K = K_; nM = M / BM; nN = N / BM; nwg = nM * nN; G = G_; c = c_; }
    __device__ __forceinline__ bool next(int i, Unit& u) const {
        const long L = (long)i * G + c; if (L >= nwg) return false;
        int wgid = (int)L; { const int q = nwg / NXCD, r = nwg % NXCD, xcd = wgid % NXCD, off = wgid / NXCD; wgid = (xcd < r ? xcd * (q + 1) : r * (q + 1) + (xcd - r) * q) + off; }
        const int nig = WGM * nN, gid = wgid / nig, fm = gid * WGM, gsz = (nM - fm) < WGM ? (nM - fm) : WGM;
        u.pm = fm + ((wgid % nig) % gsz); u.pn = (wgid % nig) / gsz;
        u.A = A + (size_t)u.pm * BM * lda_b; u.B = Bt + (size_t)u.pn * BM * K * 2; u.e = 0; u.mt = 0; u.cnt = 0; u.off = 0; return true;
    }
    __device__ __forceinline__ unsigned row_off(const Unit&, int r) const { return (unsigned)r * (unsigned)lda_b; }
};

template <class Epi, class Sched, bool ALIGN_EPI, bool SP2>
__device__ __forceinline__ void gemm_phase(LAS unsigned char* lds, const int K, const Sched& S, const Epi& E) {
    const int tid = threadIdx.x, wid = __builtin_amdgcn_readfirstlane(tid >> 6), lane = tid & 63, wr = wid >> 2, wc = wid & 3, fr = lane & 15, fq = lane >> 4;
    const int nt = K / BK;
    int Rr[2], Cc[2]; unsigned voffB[2];
#pragma unroll
    for (int i = 0; i < 2; ++i) { int R, C; stage_rc(tid * 16 + i * 8192, R, C); const int Rb = Epi::PERM ? ((R & ~31) + perm32(R & 31)) : R; Rr[i] = R; Cc[i] = C * 2; voffB[i] = (unsigned)(Rb * K + C) * 2u; }
    const size_t kstep = (size_t)(BK * 2);
    const size_t hstepB = (size_t)HALF * K * 2;
    const unsigned ldsw = (unsigned)wid * 1024u;
    const int aoff = lds_byte(wr * 64 + fr, fq * 8), boff = lds_byte(wc * 32 + fr, fq * 8);
#define PG8_SA(b, h) (((b) * 2 + (h)) * HTB)
#define PG8_SB(b, h) ((4 + (b) * 2 + (h)) * HTB)
#define PG8_STAGE2(bufoff, gbase, o0, o1) do { \
        __builtin_amdgcn_global_load_lds((const unsigned*)((const char*)(gbase) + (o0)), (LAS unsigned*)(lds + (bufoff) + ldsw), 16, 0, 0); \
        __builtin_amdgcn_global_load_lds((const unsigned*)((const char*)(gbase) + (o1)), (LAS unsigned*)(lds + (bufoff) + ldsw + 8192), 16, 0, 0); } while (0)
#define PG8_STAGEB(bufoff, gbase) PG8_STAGE2(bufoff, gbase, voffB[0], voffB[1])
#define PG8_LDA(dst, b, h) do { _Pragma("unroll") for (int m = 0; m < 4; ++m) _Pragma("unroll") for (int k = 0; k < 2; ++k) dst[m][k] = *(const LAS bf16x8*)(lds + PG8_SA(b, h) + aoff + m * 2048 + k * 1024); } while (0)
#define PG8_LDB(dst, b, h) do { _Pragma("unroll") for (int n = 0; n < 2; ++n) _Pragma("unroll") for (int k = 0; k < 2; ++k) dst[n][k] = *(const LAS bf16x8*)(lds + PG8_SB(b, h) + boff + n * 2048 + k * 1024); } while (0)
#define PG8_MMA(ai, bj, At, Bt) do { __builtin_amdgcn_s_setprio(1); _Pragma("unroll") for (int m = 0; m < 4; ++m) _Pragma("unroll") for (int n = 0; n < 2; ++n) _Pragma("unroll") for (int k = 0; k < 2; ++k) \
        acc[ai][bj][m][n] = __builtin_amdgcn_mfma_f32_16x16x32_bf16(Bt[n][k], At[m][k], acc[ai][bj][m][n], 0, 0, 0); __builtin_amdgcn_s_setprio(0); } while (0)
#define PG8_WAIT_V(n) asm volatile("s_waitcnt vmcnt(" #n ")" ::: "memory")
#define PG8_WAIT_L(n) asm volatile("s_waitcnt lgkmcnt(" #n ")" ::: "memory")
#define PG8_BAR __builtin_amdgcn_s_barrier()
#define PG8_SCHED __builtin_amdgcn_sched_barrier(0)
    Unit cur, nxt; int ui = 0;
    if (!S.next(0, cur)) return;
    f32x4 acc[2][2][4][2];
#pragma unroll
    for (int a = 0; a < 2; ++a)
#pragma unroll
        for (int b = 0; b < 2; ++b)
#pragma unroll
            for (int m = 0; m < 4; ++m)
#pragma unroll
                for (int n = 0; n < 2; ++n) acc[a][b][m][n] = (f32x4){0.f, 0.f, 0.f, 0.f};
    bf16x8 At[4][2], B0[2][2], B1[2][2];
    unsigned vc00, vc01, vc10, vc11, vn00, vn01, vn10, vn11;
    vc00 = S.row_off(cur, Rr[0]) + Cc[0]; vc01 = S.row_off(cur, Rr[1]) + Cc[1]; vc10 = S.row_off(cur, HALF + Rr[0]) + Cc[0]; vc11 = S.row_off(cur, HALF + Rr[1]) + Cc[1];
    const char* cA = cur.A; const char* cB = cur.B;
    PG8_STAGEB(PG8_SB(0, 0), cB); PG8_STAGEB(PG8_SB(0, 1), cB + hstepB); PG8_STAGE2(PG8_SA(0, 0), cA, vc00, vc01); PG8_STAGE2(PG8_SA(0, 1), cA, vc10, vc11);
    if (wr == 1) PG8_BAR;
    PG8_WAIT_V(2); PG8_BAR;
    PG8_STAGEB(PG8_SB(1, 0), cB + kstep); PG8_STAGE2(PG8_SA(1, 0), cA + kstep, vc00, vc01); PG8_STAGEB(PG8_SB(1, 1), cB + hstepB + kstep);
    PG8_WAIT_V(6); PG8_BAR;
    for (;;) {
        const bool has_next = S.next(ui + 1, nxt);
        const char* nA = has_next ? nxt.A : cA; const char* nB = has_next ? nxt.B : cB;
        if (has_next) { vn00 = S.row_off(nxt, Rr[0]) + Cc[0]; vn01 = S.row_off(nxt, Rr[1]) + Cc[1]; vn10 = S.row_off(nxt, HALF + Rr[0]) + Cc[0]; vn11 = S.row_off(nxt, HALF + Rr[1]) + Cc[1]; }
        else { vn00 = vc00; vn01 = vc01; vn10 = vc10; vn11 = vc11; }
        for (int t = 0; t < nt; t += 2) {
            const bool last = (t == nt - 2);
            const char* a1 = cA + (size_t)(t + 1) * kstep;
            const char* a2 = last ? nA : cA + (size_t)(t + 2) * kstep; const char* b2 = last ? nB : cB + (size_t)(t + 2) * kstep;
            const char* a3 = a2 + kstep; const char* b3 = b2 + kstep;
            const unsigned x00 = last ? vn00 : vc00, x01 = last ? vn01 : vc01, x10 = last ? vn10 : vc10, x11 = last ? vn11 : vc11;
            PG8_LDB(B0, 0, 0); PG8_LDB(B1, 0, 1); PG8_SCHED; PG8_LDA(At, 0, 0); PG8_STAGE2(PG8_SA(1, 1), a1, vc10, vc11);
            PG8_WAIT_V(8); PG8_WAIT_L(0); PG8_BAR; PG8_MMA(0, 0, At, B0); PG8_MMA(0, 1, At, B1); PG8_BAR; PG8_SCHED;
            PG8_LDA(At, 0, 1); PG8_STAGEB(PG8_SB(0, 0), b2); PG8_STAGEB(PG8_SB(0, 1), b2 + hstepB); PG8_STAGE2(PG8_SA(0, 0), a2, x00, x01);
            PG8_WAIT_V(8); PG8_WAIT_L(0); PG8_BAR; PG8_MMA(1, 0, At, B0); PG8_MMA(1, 1, At, B1); PG8_BAR; PG8_SCHED;
            PG8_LDB(B0, 1, 0); PG8_LDB(B1, 1, 1); PG8_SCHED; PG8_LDA(At, 1, 0); PG8_STAGE2(PG8_SA(0, 1), a2, x10, x11);
            PG8_WAIT_V(8); PG8_WAIT_L(0); PG8_BAR; PG8_MMA(0, 0, At, B0); PG8_MMA(0, 1, At, B1); PG8_BAR; PG8_SCHED;
            PG8_LDA(At, 1, 1); PG8_STAGEB(PG8_SB(1, 0), b3); PG8_STAGEB(PG8_SB(1, 1), b3 + hstepB); PG8_STAGE2(PG8_SA(1, 0), a3, x00, x01);
            PG8_WAIT_V(8); PG8_WAIT_L(0); PG8_BAR; PG8_MMA(1, 0, At, B0); PG8_MMA(1, 1, At, B1); PG8_BAR; PG8_SCHED;
        }
        if constexpr (ALIGN_EPI) { if (wr == 0) PG8_BAR; }
        E(acc, cur, wr, wc, fr, fq);
        if (!has_next) break;
#pragma unroll
        for (int a = 0; a < 2; ++a)
#pragma unroll
            for (int b = 0; b < 2; ++b)
#pragma unroll
                for (int m = 0; m < 4; ++m)
#pragma unroll
                    for (int n = 0; n < 2; ++n) acc[a][b][m][n] = (f32x4){0.f, 0.f, 0.f, 0.f};
        cur = nxt; cA = nA; cB = nB; ++ui; vc00 = vn00; vc01 = vn01; vc10 = vn10; vc11 = vn11;
        if constexpr (ALIGN_EPI) { if (wr == 1) PG8_BAR; }
    }
    PG8_WAIT_V(0);
    if constexpr (!ALIGN_EPI) { if (wr == 0) PG8_BAR; }
    PG8_BAR;
#undef PG8_SA
#undef PG8_SB
#undef PG8_STAGE2
#undef PG8_STAGEB
#undef PG8_LDA
#undef PG8_LDB
#undef PG8_MMA
#undef PG8_WAIT_V
#undef PG8_WAIT_L
#undef PG8_BAR
#undef PG8_SCHED
}
}
using pg8::Unit;
using pg8::cvt_pk_bf16;

__device__ __forceinline__ u32x4 pack8(const f32x4& v0, const f32x4& v1) { u32x4 w; w.x = cvt_pk_bf16(v0[0], v0[1]); w.y = cvt_pk_bf16(v0[2], v0[3]); w.z = cvt_pk_bf16(v1[0], v1[1]); w.w = cvt_pk_bf16(v1[2], v1[3]); return w; }
__device__ __forceinline__ f32x4 sig4(const f32x4& v) { return (f32x4){sigmoidf_(v[0]), sigmoidf_(v[1]), sigmoidf_(v[2]), sigmoidf_(v[3])}; }
__device__ __forceinline__ void unpack8(const u32x4& w, f32x4& a, f32x4& b) { a = (f32x4){bflo(w.x), bfhi(w.x), bflo(w.y), bfhi(w.y)}; b = (f32x4){bflo(w.z), bfhi(w.z), bflo(w.w), bfhi(w.w)}; }

struct EpiIn {
    static constexpr bool PERM = true;
    const float* binp; bf16* U; bf16* Q; bf16* KV; bf16* NGt; bf16* GM;
    __device__ __forceinline__ void operator()(const f32x4 (&acc)[2][2][4][2], const Unit& u, int wr, int wc, int fr, int fq) const {
        const int row0 = u.pm * 256 + wr * 64 + fr, pn = u.pn, cin = wc * 32 + 8 * fq;
        f32x4 bv[2][2];
#pragma unroll
        for (int bj = 0; bj < 2; ++bj)
#pragma unroll
            for (int n = 0; n < 2; ++n) bv[bj][n] = *(const f32x4*)(binp + pn * 256 + bj * 128 + cin + 4 * n);
        if (pn < 4) {
#pragma unroll
            for (int ai = 0; ai < 2; ++ai)
#pragma unroll
                for (int m = 0; m < 4; ++m) { const size_t row = (size_t)(row0 + ai * 128 + m * 16);
                    const f32x4 a0 = acc[ai][0][m][0] + bv[0][0], a1 = acc[ai][0][m][1] + bv[0][1], g0 = sig4(acc[ai][1][m][0] + bv[1][0]), g1 = sig4(acc[ai][1][m][1] + bv[1][1]);
                    *(u32x4*)(U + row * 512 + pn * 128 + cin) = pack8(a0 * g0, a1 * g1); }
        } else if (pn < 14) {
            bf16* base; int ld; float sc = 1.f;
            if (pn < 8) { base = Q + (pn - 4) * 256; ld = 1024; sc = 0.125f; } else { base = KV + (size_t)(pn - 8) * (KV_STRIDE / 2); ld = 256; }
#pragma unroll
            for (int ai = 0; ai < 2; ++ai)
#pragma unroll
                for (int m = 0; m < 4; ++m) { bf16* rp = base + (size_t)(row0 + ai * 128 + m * 16) * ld + cin;
#pragma unroll
                    for (int bj = 0; bj < 2; ++bj) *(u32x4*)(rp + bj * 128) = pack8((acc[ai][bj][m][0] + bv[bj][0]) * sc, (acc[ai][bj][m][1] + bv[bj][1]) * sc); }
        } else if (pn == 14) {
            if (wc < 2) {
#pragma unroll
                for (int ai = 0; ai < 2; ++ai)
#pragma unroll
                    for (int m = 0; m < 4; ++m) { const size_t row = (size_t)(row0 + ai * 128 + m * 16);
                        *(u32x4*)(NGt + row * 64 + cin) = pack8(sig4(acc[ai][0][m][0] + bv[0][0]), sig4(acc[ai][0][m][1] + bv[0][1])); }
            }
        } else {
#pragma unroll
            for (int ai = 0; ai < 2; ++ai)
#pragma unroll
                for (int m = 0; m < 4; ++m) { bf16* rp = GM + (size_t)(row0 + ai * 128 + m * 16) * 2048 + (pn - 15) * 256 + cin;
#pragma unroll
                    for (int bj = 0; bj < 2; ++bj) *(u32x4*)(rp + bj * 128) = pack8(sig4(acc[ai][bj][m][0] + bv[bj][0]), sig4(acc[ai][bj][m][1] + bv[bj][1])); }
        }
    }
};

template <int MODE> struct EpiMix {
    static constexpr bool PERM = true;
    const bf16* GM; bf16* MIX; const float* bias;
    __device__ __forceinline__ void operator()(const f32x4 (&acc)[2][2][4][2], const Unit& u, int wr, int wc, int fr, int fq) const {
        const int row0 = u.pm * 256 + wr * 64 + fr, col0 = u.pn * 256 + wc * 32 + 8 * fq;
        f32x4 bv[2][2];
#pragma unroll
        for (int bj = 0; bj < 2; ++bj)
#pragma unroll
            for (int n = 0; n < 2; ++n) bv[bj][n] = (MODE == 0) ? *(const f32x4*)(bias + col0 + bj * 128 + 4 * n) : (f32x4){0.f, 0.f, 0.f, 0.f};
#pragma unroll
        for (int ai = 0; ai < 2; ++ai)
#pragma unroll
            for (int m = 0; m < 4; ++m) { const size_t row = (size_t)(row0 + ai * 128 + m * 16);
#pragma unroll
                for (int bj = 0; bj < 2; ++bj) { const int col = col0 + bj * 128;
                    f32x4 g0, g1; unpack8(*(const u32x4*)(GM + row * 2048 + MODE * 1024 + col), g0, g1);
                    f32x4 v0 = (acc[ai][bj][m][0] + bv[bj][0]) * g0, v1 = (acc[ai][bj][m][1] + bv[bj][1]) * g1;
                    if (MODE == 1) { f32x4 p0, p1; unpack8(*(const u32x4*)(MIX + row * 1024 + col), p0, p1); v0 += p0; v1 += p1; }
                    *(u32x4*)(MIX + row * 1024 + col) = pack8(v0, v1); } }
    }
};

struct EpiOut {
    static constexpr bool PERM = false;
    const float* x; float* out; const float* g1;
    __device__ __forceinline__ void operator()(const f32x4 (&acc)[2][2][4][2], const Unit& u, int wr, int wc, int fr, int fq) const {
        const int row0 = u.pm * 256 + wr * 64 + fr, col0 = u.pn * 256 + wc * 32 + 4 * fq; const int b = (u.pm * 256) >> 13;
        f32x4 gv[2][2];
#pragma unroll
        for (int bj = 0; bj < 2; ++bj)
#pragma unroll
            for (int n = 0; n < 2; ++n) gv[bj][n] = *(const f32x4*)(g1 + b * 6144 + col0 + bj * 128 + 16 * n);
#pragma unroll
        for (int ai = 0; ai < 2; ++ai)
#pragma unroll
            for (int m = 0; m < 4; ++m) { const size_t off = (size_t)(row0 + ai * 128 + m * 16) * 1024 + col0;
#pragma unroll
                for (int bj = 0; bj < 2; ++bj)
#pragma unroll
                    for (int n = 0; n < 2; ++n) { const f32x4 xv = *(const f32x4*)(x + off + bj * 128 + 16 * n); *(f32x4*)(out + off + bj * 128 + 16 * n) = xv + gv[bj][n] * acc[ai][bj][m][n]; } }
    }
};

struct EpiLogits {
    static constexpr bool PERM = false;
    float* L;
    __device__ __forceinline__ void operator()(const f32x4 (&acc)[2][2][4][2], const Unit& u, int wr, int wc, int fr, int fq) const {
        const int row0 = u.pm * 256 + wr * 64 + fr, col0 = wc * 32 + 4 * fq;
#pragma unroll
        for (int ai = 0; ai < 2; ++ai)
#pragma unroll
            for (int m = 0; m < 4; ++m) { const size_t off = (size_t)(row0 + ai * 128 + m * 16) * 256 + col0;
#pragma unroll
                for (int bj = 0; bj < 2; ++bj)
#pragma unroll
                    for (int n = 0; n < 2; ++n) *(f32x4*)(L + off + bj * 128 + 16 * n) = acc[ai][bj][m][n]; }
    }
};

struct EpiAct {
    static constexpr bool PERM = true;
    bf16* ACT; bf16* ACTSH;
    __device__ __forceinline__ void operator()(const f32x4 (&acc)[2][2][4][2], const Unit& u, int wr, int wc, int fr, int fq) const {
        const int slot0 = u.mt * 256 + wr * 64 + fr, col = (u.pn & 1) * 128 + wc * 32 + 8 * fq;
        bf16* base = (u.e == NEXP) ? ACTSH : ACT + (size_t)u.off * 256;
#pragma unroll
        for (int ai = 0; ai < 2; ++ai)
#pragma unroll
            for (int m = 0; m < 4; ++m) { const int slot = slot0 + ai * 128 + m * 16;
                if (slot < u.cnt) { const f32x4 g0 = acc[ai][0][m][0], g1 = acc[ai][0][m][1];
                    *(u32x4*)(base + (size_t)slot * 256 + col) = pack8(g0 * sig4(g0) * acc[ai][1][m][0], g1 * sig4(g1) * acc[ai][1][m][1]); } }
    }
};

struct EpiDown {
    static constexpr bool PERM = true;
    bf16* YS; float* out; const float* g2;
    __device__ __forceinline__ void operator()(const f32x4 (&acc)[2][2][4][2], const Unit& u, int wr, int wc, int fr, int fq) const {
        const int slot0 = u.mt * 256 + wr * 64 + fr, cin = wc * 32 + 8 * fq;
        if (u.e == NEXP) {
            const int b = (u.mt * 256) >> 13, col0 = u.pn * 256 + cin;
#pragma unroll
            for (int bj = 0; bj < 2; ++bj) { const f32x4 ga = *(const f32x4*)(g2 + b * 6144 + col0 + bj * 128), gb = *(const f32x4*)(g2 + b * 6144 + col0 + bj * 128 + 4);
#pragma unroll
                for (int ai = 0; ai < 2; ++ai)
#pragma unroll
                    for (int m = 0; m < 4; ++m) { float* p = out + (size_t)(slot0 + ai * 128 + m * 16) * 1024 + col0 + bj * 128;
                        const f32x4 o0 = *(const f32x4*)p, o1 = *(const f32x4*)(p + 4);
                        *(f32x4*)p = o0 + ga * acc[ai][bj][m][0]; *(f32x4*)(p + 4) = o1 + gb * acc[ai][bj][m][1]; } }
        } else {
            bf16* base = YS + (size_t)u.off * 512 + (u.pn & 1) * 256 + cin;
#pragma unroll
            for (int ai = 0; ai < 2; ++ai)
#pragma unroll
                for (int m = 0; m < 4; ++m) { const int slot = slot0 + ai * 128 + m * 16;
                    if (slot < u.cnt) {
#pragma unroll
                        for (int bj = 0; bj < 2; ++bj) *(u32x4*)(base + (size_t)slot * 512 + bj * 128) = pack8(acc[ai][bj][m][0], acc[ai][bj][m][1]); } }
        }
    }
};

struct ExpertOrder {
    LAS const int* tab; const char* Abase; const char* Bexp; const char* Bsh; const char* Ash; const int* tokl; int mode, hh, G, c, nunits;
    __device__ __forceinline__ bool next(int i, Unit& u) const {
        const int L = i * G + c; if (L >= nunits) return false;
        int lo = 0, hi = NEXP + 1;
        while (hi - lo > 1) { const int mid = (lo + hi) >> 1; if (tab[260 + mid] <= L) lo = mid; else hi = mid; }
        const int e = lo, cnt = tab[e], nte = (cnt + 255) >> 8, r = L - tab[260 + e], j = r / nte, mt = r - j * nte;
        u.e = e; u.mt = mt; u.cnt = cnt; u.off = tab[520 + e]; u.pm = 0;
        if (mode == 0) { u.pn = j; u.A = Abase; u.B = (e == NEXP) ? Bsh + (size_t)j * 256 * 1024 * 2 : Bexp + ((size_t)e * 512 + j * 256) * 1024 * 2; }
        else { const int pn = 2 * hh + j; u.pn = pn;
            u.A = (e == NEXP) ? Ash + (size_t)mt * 256 * 512 : Abase + ((size_t)u.off + (size_t)mt * 256) * 512;
            u.B = (e == NEXP) ? Bsh + (size_t)pn * 256 * 256 * 2 : Bexp + ((size_t)e * 1024 + pn * 256) * 256 * 2; }
        return true;
    }
    __device__ __forceinline__ unsigned row_off(const Unit& u, int r) const {
        if (mode == 0) { const int slot = u.mt * 256 + r; int tok = slot; if (u.e != NEXP) tok = (slot < u.cnt) ? tokl[(size_t)u.e * T + slot] : 0; return (unsigned)tok * 2048u; }
        return (unsigned)r * 512u;
    }
};

#define XB_TMO      128
#define XB_XCNT(j)  (256  + 64 * (j))
#define XB_XSUB(j)  (1280 + 64 * (j))
#define XB_XGEN(j)  (2304 + 64 * (j))
#define XB_TOP      3328
#define XB_TOPGEN   3392
#define XCD_BAR_WORDS 3456
#define XB_SPIN_CAP (1u << 22)
__device__ __forceinline__ unsigned xb_ld(unsigned* p)              { return __hip_atomic_load(p, __ATOMIC_RELAXED, __HIP_MEMORY_SCOPE_AGENT); }
__device__ __forceinline__ unsigned xb_add(unsigned* p, unsigned v) { return __hip_atomic_fetch_add(p, v, __ATOMIC_RELAXED, __HIP_MEMORY_SCOPE_AGENT); }
__device__ __forceinline__ unsigned xb_xcc_id() { return (unsigned)__builtin_amdgcn_s_getreg((3 << 11) | 20) & 0xFu; }
#define XB_SPIN(cond, bar) do { unsigned _sp = 0; while (cond) { __builtin_amdgcn_s_sleep(1); \
    if ((++_sp & 255u) == 0u) { if (xb_ld(&(bar)[XB_TMO])) break; if (_sp > XB_SPIN_CAP) { atomicAdd(&(bar)[XB_TMO], 1u); break; } } } } while (0)
struct XcdBarrier { unsigned* bar; unsigned x; volatile LAS unsigned* st; };
__device__ __forceinline__ XcdBarrier xcd_barrier_post(unsigned* bar, volatile LAS unsigned* st) {
    XcdBarrier b; b.bar = bar; b.x = xb_xcc_id(); b.st = st;
    if (threadIdx.x == 0) (void)xb_add(&bar[XB_XCNT(b.x)], 1u);
    return b;
}
__device__ __forceinline__ void xcd_barrier_complete(unsigned* bar, unsigned x, unsigned& nloc, unsigned& nx) {
    const unsigned G = gridDim.x * gridDim.y * gridDim.z;
    unsigned sum, cnt, mine, sp = 0u;
    for (;;) {
        sum = 0u; cnt = 0u; mine = 0u;
#pragma unroll
        for (unsigned j = 0; j < 16; ++j) { const unsigned c = xb_ld(&bar[XB_XCNT(j)]); sum += c; cnt += (c > 0u) ? 1u : 0u; mine = (j == x) ? c : mine; }
        if (sum == G) break;
        __builtin_amdgcn_s_sleep(1);
        if ((++sp & 255u) == 0u) { if (xb_ld(&bar[XB_TMO])) break; if (sp > XB_SPIN_CAP) { atomicAdd(&bar[XB_TMO], 1u); break; } }
    }
    nloc = mine > 0u ? mine : 1u; nx = cnt > 0u ? cnt : 1u;
}
__device__ __forceinline__ void xcd_barrier(const XcdBarrier& b) {
    asm volatile("s_waitcnt vmcnt(0)" ::: "memory");
    __syncthreads();
    if (threadIdx.x == 0) {
        unsigned* bar = b.bar;
        __builtin_amdgcn_s_waitcnt(0);
        unsigned nloc = b.st[0], nx = b.st[1];
        if (nloc == 0u) { xcd_barrier_complete(bar, b.x, nloc, nx); b.st[0] = nloc; b.st[1] = nx; }
        const unsigned old = xb_add(&bar[XB_XSUB(b.x)], 1u);
        const unsigned gen = old / nloc;
        if (old + 1u == (gen + 1u) * nloc) {
            __builtin_amdgcn_fence(__ATOMIC_RELEASE, "agent");
            asm volatile("s_waitcnt vmcnt(0)" ::: "memory");
            const unsigned og = xb_add(&bar[XB_TOP], 1u);
            const unsigned tg = og / nx;
            if (og + 1u == (tg + 1u) * nx) xb_add(&bar[XB_TOPGEN], 1u);
            else XB_SPIN(xb_ld(&bar[XB_TOPGEN]) == tg, bar);
            __builtin_amdgcn_fence(__ATOMIC_ACQUIRE, "agent");
            xb_add(&bar[XB_XGEN(b.x)], 1u);
            asm volatile("s_waitcnt vmcnt(0)" ::: "memory");
        } else {
            XB_SPIN(xb_ld(&bar[XB_XGEN(b.x)]) == gen, bar);
            __builtin_amdgcn_fence(__ATOMIC_ACQUIRE, "agent");
            asm volatile("s_waitcnt vmcnt(0)" ::: "memory");
        }
    }
    __syncthreads();
}
struct Args { const float* in[31]; float* out; unsigned char* ws; int ph_lo, ph_hi, li, pad; };
struct Frame {
    LAS unsigned char* lds;
    volatile LAS unsigned* MISC;
    gu32* ctl;
    int tid, lane, wave, vcu, G;
    unsigned char* ws;
    float* out;
};
#define AIN args.in
enum { I_X = 0, I_C, I_WADA, I_BADA, I_N1G, I_WIN, I_BIN, I_CONVW, I_CONVB, I_LNG, I_LNB, I_WCO, I_BCO, I_PEK, I_W1K, I_W2K, I_PEV, I_W1V, I_W2V, I_WNSA, I_WOUT, I_N2G, I_WR, I_RB, I_SHG, I_SHU, I_SHD, I_WG, I_WU, I_WDN, I_FG };

__device__ __forceinline__ void xpose_item(const float* W, int ldw, int ncols, bf16* WT, int K, LAS float* scr, int kb, int nb, int lane) {
    const int k0 = 64 * kb, n0 = 32 * nb, nl = lane & 31; const bool nv = (n0 + nl) < ncols;
#pragma unroll 8
    for (int i = 0; i < 32; ++i) { const int kk = 2 * i + (lane >> 5); scr[kk * 33 + nl] = nv ? W[(size_t)(k0 + kk) * ldw + n0 + nl] : 0.f; }
    LDS_WAIT(); asm volatile("" ::: "memory");
    const int c = lane & 7;
#pragma unroll
    for (int j = 0; j < 4; ++j) { const int n = (lane >> 3) + 8 * j; const LAS float* s = scr + (8 * c) * 33 + n;
        u32x4 o; o.x = pk2(s[0 * 33], s[1 * 33]); o.y = pk2(s[2 * 33], s[3 * 33]); o.z = pk2(s[4 * 33], s[5 * 33]); o.w = pk2(s[6 * 33], s[7 * 33]);
        *(GAS u32x4*)(WT + (size_t)(n0 + n) * K + k0 + 8 * c) = o; }
    LDS_WAIT(); asm volatile("" ::: "memory");
}
#define XSEC(Wp, ldw, ncols, WTp, K, nbl) do { const int _n = ((K) / 64) * (nbl); if (r < _n) { xpose_item((Wp), (ldw), (ncols), (WTp), (K), scr, r / (nbl), r % (nbl), F.lane); return; } r -= _n; } while (0)

__device__ __forceinline__ void p0_small_item(Frame& F, const Args& args, LAS float* scr, int r) {
    bf16* WIN = (bf16*)(F.ws + WS_WIN);
    const float* w_in = AIN[I_WIN];
#pragma unroll 1
    for (int p = 0; p < 4; ++p) { XSEC(w_in + 128 * p, NIN, 128, WIN + (size_t)(256 * p) * 1024, 1024, 4); }
#pragma unroll 1
    for (int p = 0; p < 4; ++p) { XSEC(w_in + 512 + 128 * p, NIN, 128, WIN + (size_t)(256 * p + 128) * 1024, 1024, 4); }
    XSEC(w_in + 1024, NIN, 2560, WIN + (size_t)1024 * 1024, 1024, 80);
    XSEC(w_in + 3584, NIN, 48, WIN + (size_t)3584 * 1024, 1024, 8);
    XSEC(w_in + 3632, NIN, 2048, WIN + (size_t)3840 * 1024, 1024, 64);
    XSEC(AIN[I_WCO], 1024, 1024, (bf16*)(F.ws + WS_WC), 512, 32);
    XSEC(AIN[I_WNSA], 1024, 1024, (bf16*)(F.ws + WS_WN), 1024, 32);
    XSEC(AIN[I_WOUT], 1024, 1024, (bf16*)(F.ws + WS_WO), 1024, 32);
    XSEC(AIN[I_WR], 256, 256, (bf16*)(F.ws + WS_WR), 1024, 8);
#pragma unroll 1
    for (int p = 0; p < 2; ++p) { XSEC(AIN[I_SHG] + 128 * p, 256, 128, (bf16*)(F.ws + WS_WSHGU) + (size_t)(256 * p) * 1024, 1024, 4); }
#pragma unroll 1
    for (int p = 0; p < 2; ++p) { XSEC(AIN[I_SHU] + 128 * p, 256, 128, (bf16*)(F.ws + WS_WSHGU) + (size_t)(256 * p + 128) * 1024, 1024, 4); }
    XSEC(AIN[I_SHD], 1024, 1024, (bf16*)(F.ws + WS_WSHD), 256, 32);
    XSEC(AIN[I_W1K], 128, 128, (bf16*)(F.ws + WS_CW1), 2048, 4);
    XSEC(AIN[I_W1V], 128, 128, (bf16*)(F.ws + WS_CW1) + (size_t)128 * 2048, 2048, 4);
    XSEC(AIN[I_W2K], 64, 64, (bf16*)(F.ws + WS_CW2), 128, 2);
    XSEC(AIN[I_W2V], 64, 64, (bf16*)(F.ws + WS_CW2) + 64 * 128, 128, 2);
}
constexpr int P0_SMALL_ITEMS = 8 * 64 + 1280 + 128 + 1024 + 256 + 512 + 512 + 128 + 4 * 64 + 128 + 128 + 128 + 4 + 4;
__device__ __forceinline__ void p0_expert_item(Frame& F, const Args& args, LAS float* scr, int it) {
    const int e = it / 384; int r = it - e * 384;
    bf16* WGU = (bf16*)(F.ws + WS_WGU) + (size_t)e * 512 * 1024;
    const float* wg = AIN[I_WG] + (size_t)e * 1024 * 256; const float* wu = AIN[I_WU] + (size_t)e * 1024 * 256;
#pragma unroll 1
    for (int p = 0; p < 2; ++p) { XSEC(wg + 128 * p, 256, 128, WGU + (size_t)(256 * p) * 1024, 1024, 4); }
#pragma unroll 1
    for (int p = 0; p < 2; ++p) { XSEC(wu + 128 * p, 256, 128, WGU + (size_t)(256 * p + 128) * 1024, 1024, 4); }
    XSEC(AIN[I_WDN] + (size_t)e * 256 * 1024, 1024, 1024, (bf16*)(F.ws + WS_WD) + (size_t)e * 1024 * 256, 256, 32);
}
__device__ __forceinline__ void p0_mod_item(Frame& F, const Args& args, int it) {
    const int kc = it / 96, nc = it - kc * 96;
    const float* W = AIN[I_WADA] + (size_t)(128 * kc) * 6144 + 64 * nc + F.lane; const float* c = AIN[I_C] + 128 * kc;
    float a0 = 0.f, a1 = 0.f, a2 = 0.f, a3 = 0.f;
#pragma unroll 8
    for (int k = 0; k < 128; ++k) { const float w = W[(size_t)k * 6144];
        const float c0 = c[k], c1 = c[1024 + k], c2 = c[2048 + k], c3 = c[3072 + k];
        a0 += c0 * sigmoidf_(c0) * w; a1 += c1 * sigmoidf_(c1) * w; a2 += c2 * sigmoidf_(c2) * w; a3 += c3 * sigmoidf_(c3) * w; }
    float* P = (float*)(F.ws + WS_MODP) + (size_t)kc * 4 * 6144 + 64 * nc + F.lane;
    P[0] = a0; P[6144] = a1; P[2 * 6144] = a2; P[3 * 6144] = a3;
}
__device__ __forceinline__ void p0_peb_item(Frame& F, const Args& args, int it) {
    const int which = it & 1, cc = (it >> 1) & 1, kc = it >> 2;
    const float* pe = AIN[which ? I_PEV : I_PEK] + 256 * kc; const float* w1 = AIN[which ? I_W1V : I_W1K] + (size_t)(256 * kc) * 128 + 64 * cc + F.lane;
    float a = 0.f;
#pragma unroll 8
    for (int k = 0; k < 256; ++k) a += pe[k] * w1[(size_t)k * 128];
    ((float*)(F.ws + WS_PEBP))[(kc * 2 + which) * 128 + 64 * cc + F.lane] = a;
}
__device__ __forceinline__ int binp_src(int d) {
    if (d < 1024) { const int p = d >> 8, o = d & 255; return (o < 128) ? 128 * p + o : 512 + 128 * p + (o - 128); }
    if (d < 3584) return d;
    if (d < 3840) return (d - 3584 < 48) ? d : -1;
    return 3632 + (d - 3840);
}
__device__ __forceinline__ void p0_prologue(Frame& F, const Args& args) {
    LAS float* scr = (LAS float*)(F.lds + RING_OFF + F.wave * 16384);
    const int gw = F.vcu * NWAVES + F.wave, NGW = F.G * NWAVES;
    constexpr int N_MOD = 768, N_PEB = 32, N_EXP = NEXP * 384;
    constexpr int NITEMS = N_MOD + N_PEB + P0_SMALL_ITEMS + N_EXP;
    for (int it = gw; it < NITEMS; it += NGW) {
        int r = it;
        if (r < N_MOD) { p0_mod_item(F, args, r); continue; } r -= N_MOD;
        if (r < N_PEB) { p0_peb_item(F, args, r); continue; } r -= N_PEB;
        if (r < P0_SMALL_ITEMS) { p0_small_item(F, args, scr, r); continue; } r -= P0_SMALL_ITEMS;
        p0_expert_item(F, args, scr, r);
    }
    float* binp = (float*)(F.ws + WS_BINP);
    for (int d = gw * 64 + F.lane; d < NINP; d += NGW * 64) { const int s = binp_src(d); binp[d] = (s >= 0) ? AIN[I_BIN][s] : 0.f; }
}

__device__ __forceinline__ float modsum(const Frame& F, const Args& args, int b, int j) {
    const float* P = (const float*)(F.ws + WS_MODP) + (size_t)b * 6144 + j; float s = AIN[I_BADA][j];
#pragma unroll
    for (int kc = 0; kc < 8; ++kc) s += P[(size_t)kc * 4 * 6144];
    return s;
}
template <bool FROM_PARTIALS>
__device__ __forceinline__ void norm_mod_rows(Frame& F, const Args& args, const float* src, bf16* dst, const float* gam, int shift_off, int scale_off) {
    const int gw = F.vcu * NWAVES + F.wave, NGW = F.G * NWAVES;
    for (int blk = gw; blk < T / 16; blk += NGW) {
        const int m0 = blk * 16, b = m0 >> 13;
        f32x4 av[4], sv[4];
#pragma unroll
        for (int j = 0; j < 4; ++j) { const int col = 4 * F.lane + 256 * j; const f32x4 g = *(const f32x4*)(gam + col); f32x4 sc, sh;
            if (FROM_PARTIALS) {
#pragma unroll
                for (int q = 0; q < 4; ++q) { sc[q] = modsum(F, args, b, scale_off + col + q); sh[q] = modsum(F, args, b, shift_off + col + q); }
            } else { const float* mf = (const float*)(F.ws + WS_MODF) + b * 6144; sc = *(const f32x4*)(mf + scale_off + col); sh = *(const f32x4*)(mf + shift_off + col); }
            av[j] = g * (sc + 1.0f); sv[j] = sh; }
#pragma unroll 2
        for (int i = 0; i < 16; ++i) {
            const GAS f32x4* xr = (const GAS f32x4*)(src + (size_t)(m0 + i) * 1024) + F.lane;
            f32x4 v[4]; float s = 0.f;
#pragma unroll
            for (int j = 0; j < 4; ++j) { v[j] = xr[64 * j]; s += (v[j].x * v[j].x + v[j].y * v[j].y) + (v[j].z * v[j].z + v[j].w * v[j].w); }
            const float rstd = 1.0f / sqrtf(wave_sum(s) * (1.0f / 1024.0f) + EPS);
            GAS u32x2* o8 = (GAS u32x2*)(dst + (size_t)(m0 + i) * 1024) + F.lane;
#pragma unroll
            for (int j = 0; j < 4; ++j) { const f32x4 y = v[j] * rstd * av[j] + sv[j]; u32x2 w; w.x = pk2(y.x, y.y); w.y = pk2(y.z, y.w); o8[64 * j] = w; }
        }
    }
}
__device__ __forceinline__ void finalize_mod(Frame& F, const Args& args) {
    const int gw = F.vcu * NWAVES + F.wave, NGW = F.G * NWAVES;
    for (int it = gw; it < 384; it += NGW) { const int b = it / 96, j = (it % 96) * 64 + F.lane; ((float*)(F.ws + WS_MODF))[b * 6144 + j] = modsum(F, args, b, j); }
    for (int it = gw; it < 388 && it >= 384; it += NGW) { const int idx = (it - 384) * 64 + F.lane; float s = 0.f;
#pragma unroll
        for (int kc = 0; kc < 8; ++kc) s += ((const float*)(F.ws + WS_PEBP))[kc * 256 + idx];
        ((float*)(F.ws + WS_PEBF))[idx] = s; }
}

__device__ __forceinline__ void conv_phase(Frame& F, const Args& args) {
    const bf16* U = (const bf16*)(F.ws + WS_U); bf16* CF = (bf16*)(F.ws + WS_CF);
    LAS float* cv = (LAS float*)(F.lds + RING_OFF);
    const int c = F.tid;
    float w[CONVK];
#pragma unroll
    for (int j = 0; j < CONVK; ++j) w[j] = AIN[I_CONVW][j * 512 + c];
    const float cb = AIN[I_CONVB][c];
    for (int it = F.vcu; it < T / 32; it += F.G) {
        const int m0 = it * 32, s0 = m0 & (SEQ - 1);
        float uv[62];
#pragma unroll
        for (int i = 0; i < 62; ++i) { const int s = s0 - 30 + i; uv[i] = (s >= 0) ? bf2f(U[(size_t)(m0 - 30 + i) * 512 + c]) : 0.f; }
#pragma unroll
        for (int tt = 0; tt < 32; ++tt) { float a = cb;
#pragma unroll
            for (int j = 0; j < CONVK; ++j) a += w[j] * uv[tt + j];
            cv[tt * 512 + c] = a; }
        __syncthreads();
#pragma unroll
        for (int q = 0; q < 4; ++q) { const int tt = F.wave * 4 + q;
            const f32x4 v0 = *(const LAS f32x4*)(cv + tt * 512 + 8 * F.lane), v1 = *(const LAS f32x4*)(cv + tt * 512 + 8 * F.lane + 4);
            const float mu = wave_sum((v0.x + v0.y) + (v0.z + v0.w) + (v1.x + v1.y) + (v1.z + v1.w)) * (1.0f / 512.0f);
            const f32x4 d0 = v0 - mu, d1 = v1 - mu;
            const float var = wave_sum((d0.x * d0.x + d0.y * d0.y) + (d0.z * d0.z + d0.w * d0.w) + (d1.x * d1.x + d1.y * d1.y) + (d1.z * d1.z + d1.w * d1.w)) * (1.0f / 512.0f);
            const float rstd = 1.0f / sqrtf(var + EPS);
            const f32x4 g0 = *(const f32x4*)(AIN[I_LNG] + 8 * F.lane), g1 = *(const f32x4*)(AIN[I_LNG] + 8 * F.lane + 4), b0 = *(const f32x4*)(AIN[I_LNB] + 8 * F.lane), b1 = *(const f32x4*)(AIN[I_LNB] + 8 * F.lane + 4);
            f32x4 y0 = d0 * rstd * g0 + b0, y1 = d1 * rstd * g1 + b1;
            y0 = y0 * sig4(y0); y1 = y1 * sig4(y1);
            u32x4 o; o.x = pk2(y0.x, y0.y); o.y = pk2(y0.z, y0.w); o.z = pk2(y1.x, y1.y); o.w = pk2(y1.z, y1.w);
            *(GAS u32x4*)(CF + (size_t)(m0 + tt) * 512 + 8 * F.lane) = o; }
        __syncthreads();
    }
}

__device__ __forceinline__ int perm16(int s) { return (s & ~12) | ((s & 4) << 1) | ((s & 8) >> 1); }
__device__ __forceinline__ float gelu_tanh(float x) { const float u2 = 1.5957691216057308f * (x + 0.044715f * x * x * x); return x * sigmoidf_(u2); }
__device__ __forceinline__ void compress_item(Frame& F, int it) {
    const int which = it & 1, rt = (it >> 1) & 15, bg = it >> 5, b = bg >> 2, g = bg & 3;
    const int lane = F.lane, c32 = lane & 31, hi = lane >> 5;
    const bf16* Z = (const bf16*)(F.ws + WS_KV + (size_t)which * KV_STRIDE);
    const bf16* W1T = (const bf16*)(F.ws + WS_CW1) + (size_t)which * 128 * 2048;
    const bf16* W2T = (const bf16*)(F.ws + WS_CW2) + which * 64 * 128;
    const float* peb = (const float*)(F.ws + WS_PEBF) + which * 128;
    int n = rt * 32 + c32; const bool nvalid = n <= 510; if (!nvalid) n = 510;
    const bf16* zp = Z + ((size_t)(b * SEQ + 16 * n)) * 256 + g * 64 + 8 * hi;
    const bf16* wp = W1T + (size_t)c32 * 2048 + 8 * hi;
    f32x16 acc[4];
#pragma unroll
    for (int ct = 0; ct < 4; ++ct) acc[ct] = (f32x16){0.f};
#pragma unroll 2
    for (int ks = 0; ks < 128; ++ks) {
        const bf16x8 bz = *(const bf16x8*)(zp + (size_t)(ks >> 2) * 256 + (ks & 3) * 16);
#pragma unroll
        for (int ct = 0; ct < 4; ++ct) { const bf16x8 aw = *(const bf16x8*)(wp + (size_t)ct * 32 * 2048 + ks * 16); acc[ct] = __builtin_amdgcn_mfma_f32_32x32x16_bf16(aw, bz, acc[ct], 0, 0, 0); }
    }
    f32x16 o[2]; o[0] = (f32x16){0.f}; o[1] = (f32x16){0.f};
#pragma unroll
    for (int ct = 0; ct < 4; ++ct) {
#pragma unroll
        for (int r = 0; r < 16; ++r) { const int cidx = 32 * ct + (r & 3) + 8 * (r >> 2) + 4 * hi; acc[ct][r] = gelu_tanh(acc[ct][r] + peb[cidx]); }
#pragma unroll
        for (int s = 0; s < 2; ++s) {
            u32x4 pw; pw.x = cvt_pk_bf16(acc[ct][8 * s + 0], acc[ct][8 * s + 1]); pw.y = cvt_pk_bf16(acc[ct][8 * s + 2], acc[ct][8 * s + 3]); pw.z = cvt_pk_bf16(acc[ct][8 * s + 4], acc[ct][8 * s + 5]); pw.w = cvt_pk_bf16(acc[ct][8 * s + 6], acc[ct][8 * s + 7]);
            const bf16x8 pb = __builtin_bit_cast(bf16x8, pw);
#pragma unroll
            for (int mt = 0; mt < 2; ++mt) { const bf16* ap = W2T + (size_t)(32 * mt + c32) * 128 + 32 * ct + 16 * s + 4 * hi;
                const u32x2 lo = *(const u32x2*)ap, hh = *(const u32x2*)(ap + 8); u32x4 aw; aw.x = lo.x; aw.y = lo.y; aw.z = hh.x; aw.w = hh.y;
                o[mt] = __builtin_amdgcn_mfma_f32_32x32x16_bf16(__builtin_bit_cast(bf16x8, aw), pb, o[mt], 0, 0, 0); }
        }
    }
    if (nvalid) {
        if (which == 0) { bf16* kc = (bf16*)(F.ws + WS_KC) + ((size_t)bg * 512 + n) * 64;
#pragma unroll
            for (int mt = 0; mt < 2; ++mt)
#pragma unroll
                for (int q4 = 0; q4 < 4; ++q4) { u32x2 w; w.x = pk2(o[mt][4 * q4], o[mt][4 * q4 + 1]); w.y = pk2(o[mt][4 * q4 + 2], o[mt][4 * q4 + 3]); *(u32x2*)(kc + 32 * mt + 8 * q4 + 4 * hi) = w; }
        } else { bf16* vc = (bf16*)(F.ws + WS_VCT) + (size_t)bg * 64 * 512 + perm16(n);
#pragma unroll
            for (int mt = 0; mt < 2; ++mt)
#pragma unroll
                for (int r = 0; r < 16; ++r) { const int d = 32 * mt + (r & 3) + 8 * (r >> 2) + 4 * hi; vc[(size_t)d * 512] = (bf16)f2bf(o[mt][r]); }
        }
    }
}
__device__ __forceinline__ void vtrans_item(Frame& F, int it) {
    const int which = it & 1, tile = (it >> 1) & 127, bg = it >> 8, b = bg >> 2, g = bg & 3, lane = F.lane;
    const bf16* V = (const bf16*)(F.ws + WS_KV + (size_t)(which ? 5 : 3) * KV_STRIDE) + ((size_t)(b * SEQ + tile * 64)) * 256 + g * 64;
    bf16* VT = (bf16*)(F.ws + (which ? WS_VWT : WS_VST)) + (size_t)bg * 64 * SEQ + tile * 64;
    LAS unsigned* scr = (LAS unsigned*)(F.lds + RING_OFF + F.wave * 16384);
#pragma unroll
    for (int i = 0; i < 8; ++i) { const int row = 8 * i + (lane >> 3), ch = lane & 7; const u32x4 v = *(const u32x4*)(V + (size_t)row * 256 + 8 * ch);
        LAS unsigned* p = scr + row * 33 + 4 * ch; p[0] = v.x; p[1] = v.y; p[2] = v.z; p[3] = v.w; }
    LDS_WAIT(); asm volatile("" ::: "memory");
#pragma unroll
    for (int i = 0; i < 8; ++i) { const int d = 8 * i + (lane >> 3), ch = lane & 7; unsigned e[8];
#pragma unroll
        for (int j = 0; j < 8; ++j) { const int tok = perm16(8 * ch + j); const unsigned wv = scr[tok * 33 + (d >> 1)]; e[j] = (d & 1) ? (wv >> 16) : (wv & 0xffffu); }
        u32x4 o; o.x = e[0] | (e[1] << 16); o.y = e[2] | (e[3] << 16); o.z = e[4] | (e[5] << 16); o.w = e[6] | (e[7] << 16);
        *(u32x4*)(VT + (size_t)d * SEQ + 8 * ch) = o; }
    LDS_WAIT(); asm volatile("" ::: "memory");
}
__device__ __forceinline__ void p3_phase(Frame& F, const Args& args) {
    conv_phase(F, args);
    const int gw = F.vcu * NWAVES + F.wave, NGW = F.G * NWAVES;
    if ((gw & 3) == 0 && (gw >> 2) < 512) compress_item(F, gw >> 2);
    for (int it = gw; it < 4096; it += NGW) vtrans_item(F, it);
}

__device__ __forceinline__ void routing_phase(Frame& F, const Args& args) {
    const float* LOG = (const float*)(F.ws + WS_LOG); const float* rb = AIN[I_RB];
    int* RTE = (int*)(F.ws + WS_RTE); int* RTS = (int*)(F.ws + WS_RTS); float* RTW = (float*)(F.ws + WS_RTW); int* TOKL = (int*)(F.ws + WS_TOKL);
    unsigned* CNT = (unsigned*)(F.ctl + CW_CNT);
    const int gw = F.vcu * NWAVES + F.wave, NGW = F.G * NWAVES, lane = F.lane;
    const f32x4 bias = *(const f32x4*)(rb + 4 * lane);
    for (int t = gw; t < T; t += NGW) {
        const f32x4 lg = *(const f32x4*)(LOG + (size_t)t * 256 + 4 * lane);
        float sc[4], sf[4];
#pragma unroll
        for (int q = 0; q < 4; ++q) { sc[q] = sigmoidf_(lg[q]); sf[q] = sc[q] + bias[q]; }
        float a1 = fmaxf(sf[0], sf[1]), a2 = fminf(sf[0], sf[1]);
        { const float b1 = fmaxf(sf[2], sf[3]), b2 = fminf(sf[2], sf[3]); const float n1 = fmaxf(a1, b1), n2 = fmaxf(fminf(a1, b1), fmaxf(a2, b2)); a1 = n1; a2 = n2; }
#pragma unroll
        for (int o = 1; o < 8; o <<= 1) { const float b1 = __shfl_xor(a1, o), b2 = __shfl_xor(a2, o); const float n1 = fmaxf(a1, b1), n2 = fmaxf(fminf(a1, b1), fmaxf(a2, b2)); a1 = n1; a2 = n2; }
        const float gs = a1 + a2; const int myg = lane >> 3;
        int rank = 0;
#pragma unroll
        for (int gq = 0; gq < 8; ++gq) { const float og = __shfl(gs, 8 * gq); rank += (og > gs || (og == gs && gq < myg)) ? 1 : 0; }
        const bool gsel = rank < 4;
        float v[4];
#pragma unroll
        for (int q = 0; q < 4; ++q) v[q] = gsel ? sf[q] : -1e30f;
        int eid[TOPK]; float ew[TOPK]; float wsum = 0.f;
#pragma unroll
        for (int r = 0; r < TOPK; ++r) {
            float bv = v[0]; int bi = 0;
#pragma unroll
            for (int q = 1; q < 4; ++q) if (v[q] > bv) { bv = v[q]; bi = q; }
            const float mx = wave_max(bv);
            const unsigned long long bal = __ballot(bv == mx);
            const int wl = __ffsll((long long)bal) - 1;
            const int wbi = __shfl(bi, wl);
            float wsc = sc[0];
#pragma unroll
            for (int q = 1; q < 4; ++q) wsc = (bi == q) ? sc[q] : wsc;
            const float sel_sc = __shfl(wsc, wl);
            eid[r] = 4 * wl + wbi; ew[r] = sel_sc; wsum += sel_sc;
            if (lane == wl) {
#pragma unroll
                for (int q = 0; q < 4; ++q) if (q == bi) v[q] = -3e38f;
            }
        }
        const float inv = 2.5f / wsum;
        if (lane < TOPK) {
            int e = eid[0]; float w = ew[0];
#pragma unroll
            for (int r = 1; r < TOPK; ++r) if (lane == r) { e = eid[r]; w = ew[r]; }
            const unsigned slot = __hip_atomic_fetch_add(CNT + e, 1u, RLX_AGENT);
            RTE[(size_t)t * 8 + lane] = e; RTS[(size_t)t * 8 + lane] = (int)slot; RTW[(size_t)t * 8 + lane] = w * inv;
            TOKL[(size_t)e * T + slot] = t;
        }
    }
}
__device__ __forceinline__ void build_tables(Frame& F) {
    LAS int* tab = (LAS int*)(F.lds + TAB_OFF);
    __syncthreads();
    if (F.tid < NEXP) tab[F.tid] = (int)__hip_atomic_load((unsigned*)(F.ctl + CW_CNT) + F.tid, RLX_AGENT);
    if (F.tid == NEXP) tab[NEXP] = T;
    __syncthreads();
    if (F.tid == 0) { int us = 0, off = 0;
        for (int e = 0; e <= NEXP; ++e) { const int c = tab[e]; tab[260 + e] = us; tab[520 + e] = off; us += 2 * ((c + 255) >> 8); if (e < NEXP) off += c; }
        tab[260 + NEXP + 1] = us; tab[520 + NEXP] = 0; }
    __syncthreads();
}
__device__ __forceinline__ void combine_phase(Frame& F, const Args& args, int hh) {
    const LAS int* tab = (const LAS int*)(F.lds + TAB_OFF);
    const int* RTE = (const int*)(F.ws + WS_RTE); const int* RTS = (const int*)(F.ws + WS_RTS); const float* RTW = (const float*)(F.ws + WS_RTW);
    const bf16* YS = (const bf16*)(F.ws + WS_YS);
    const int gw = F.vcu * NWAVES + F.wave, NGW = F.G * NWAVES, lane = F.lane;
    const float* fg = AIN[I_FG];
    for (int t = gw; t < T; t += NGW) {
        const int b = t >> 13;
        int pos = 0; float w = 0.f;
        if (lane < TOPK) { const int e = RTE[(size_t)t * 8 + lane]; pos = tab[520 + e] + RTS[(size_t)t * 8 + lane]; w = RTW[(size_t)t * 8 + lane]; }
        f32x4 y0 = (f32x4){0.f, 0.f, 0.f, 0.f}, y1 = y0;
#pragma unroll
        for (int k = 0; k < TOPK; ++k) { const int pk = __shfl(pos, k); const float wk = __shfl(w, k);
            f32x4 a, c; unpack8(*(const u32x4*)(YS + (size_t)pk * 512 + 8 * lane), a, c); y0 += a * wk; y1 += c * wk; }
        const float* g2 = (const float*)(F.ws + WS_MODF) + b * 6144 + 5120 + 512 * hh + 8 * lane;
        float* op = F.out + (size_t)t * 1024 + 512 * hh + 8 * lane;
        f32x4 r0 = *(const f32x4*)op + *(const f32x4*)g2 * y0, r1 = *(const f32x4*)(op + 4) + *(const f32x4*)(g2 + 4) * y1;
        if (hh == 0) { *(f32x4*)op = r0; *(f32x4*)(op + 4) = r1; }
        else {
            float* lp = F.out + (size_t)t * 1024 + 8 * lane;
            f32x4 l0 = *(const f32x4*)lp, l1 = *(const f32x4*)(lp + 4);
            float s = (l0.x * l0.x + l0.y * l0.y) + (l0.z * l0.z + l0.w * l0.w) + (l1.x * l1.x + l1.y * l1.y) + (l1.z * l1.z + l1.w * l1.w);
            s += (r0.x * r0.x + r0.y * r0.y) + (r0.z * r0.z + r0.w * r0.w) + (r1.x * r1.x + r1.y * r1.y) + (r1.z * r1.z + r1.w * r1.w);
            const float rstd = 1.0f / sqrtf(wave_sum(s) * (1.0f / 1024.0f) + EPS);
            *(f32x4*)lp = l0 * rstd * *(const f32x4*)(fg + 8 * lane); *(f32x4*)(lp + 4) = l1 * rstd * *(const f32x4*)(fg + 8 * lane + 4);
            *(f32x4*)op = r0 * rstd * *(const f32x4*)(fg + 512 + 8 * lane); *(f32x4*)(op + 4) = r1 * rstd * *(const f32x4*)(fg + 512 + 8 * lane + 4);
        }
    }
}
namespace att {
constexpr int TSZ = 8192;
constexpr int L_BUF = 0;
constexpr int L_IMPG = 4 * TSZ;
constexpr int L_IMPL = L_IMPG + 32768;
constexpr int L_SEL = L_IMPL + 32768;
constexpr int L_END = L_SEL + 1024;
static_assert(L_END <= RING_BYTES, "attention LDS");
constexpr float L2E = 1.4426950408889634f;
enum { M_WIN = 0, M_SEL = 1, M_CMP1 = 2, M_CMP2 = 3 };

__device__ __forceinline__ float qxor1(float v) { return __builtin_bit_cast(float, __builtin_amdgcn_update_dpp(0, __builtin_bit_cast(int, v), 0xB1, 0xF, 0xF, false)); }
__device__ __forceinline__ float qxor2(float v) { return __builtin_bit_cast(float, __builtin_amdgcn_update_dpp(0, __builtin_bit_cast(int, v), 0x4E, 0xF, 0xF, false)); }
__device__ __forceinline__ float swap32f(float v) { auto rr = __builtin_amdgcn_permlane32_swap(__builtin_bit_cast(unsigned, v), __builtin_bit_cast(unsigned, v), false, false); return (threadIdx.x & 32) ? __builtin_bit_cast(float, rr[0]) : __builtin_bit_cast(float, rr[1]); }

struct State { float m, l; f32x16 o0, o1; };

template <int MODE>
__device__ __forceinline__ void run_branch(LAS unsigned char* lds, const int nt, const int tile0, const bf16* kp, const size_t kst, const bf16* vp, const size_t vst,
                                           const bf16x8 (&qf)[4], State& st, const int tokl, const int ci, const int nvis, const unsigned sw0, const unsigned sw1, const unsigned sw2, const unsigned sw3, const float cm, const float cinv,
                                           const int tid, const int lane, const int wave) {
    const int c32 = lane & 31, hi = lane >> 5;
    const unsigned dmaw = (unsigned)wave * 1024u;
    const int xs = (hi ^ ((c32 >> 1) & 7)) * 16;
    __builtin_amdgcn_global_load_lds((const unsigned*)kp, (LAS unsigned*)(lds + L_BUF + dmaw), 16, 0, 0);
    __builtin_amdgcn_global_load_lds((const unsigned*)vp, (LAS unsigned*)(lds + L_BUF + TSZ + dmaw), 16, 0, 0);
    __syncthreads();
    for (int i = 0; i < nt; ++i) {
        LAS unsigned char* cur = lds + L_BUF + (i & 1) * 2 * TSZ;
        const bool more = (i + 1 < nt);
        if (more) { LAS unsigned char* nx = lds + L_BUF + ((i + 1) & 1) * 2 * TSZ;
            __builtin_amdgcn_global_load_lds((const unsigned*)(kp + (size_t)(i + 1) * kst), (LAS unsigned*)(nx + dmaw), 16, 0, 0);
            __builtin_amdgcn_global_load_lds((const unsigned*)(vp + (size_t)(i + 1) * vst), (LAS unsigned*)(nx + TSZ + dmaw), 16, 0, 0); }
        const int tix = tile0 + i;
        bool lanesel = true; int klo = -1, khi = 64;
        bool need_mask = false, skip = false;
        if (MODE == M_WIN) { if (tix == 0) { klo = tokl; need_mask = true; } if (tix == 8) { khi = tokl; need_mask = true; } }
        if (MODE == M_SEL) { { const unsigned wsel = (tix < 32) ? sw0 : (tix < 64) ? sw1 : (tix < 96) ? sw2 : sw3; lanesel = (wsel >> (tix & 31)) & 1u; } if (tix == ci) khi = tokl; need_mask = true; skip = !__any(lanesel); }
        if (MODE == M_CMP1 || MODE == M_CMP2) { khi = nvis - 64 * tix - 1; need_mask = true; }
        if (!skip) {
            f32x16 s0 = (f32x16){0.f}, s1 = (f32x16){0.f};
            { LAS const unsigned char* p = cur + c32 * 128;
#pragma unroll
              for (int ks = 0; ks < 4; ++ks) { const bf16x8 a0 = *(LAS const bf16x8*)(p + ((ks * 32) ^ xs)), a1 = *(LAS const bf16x8*)(p + 32 * 128 + ((ks * 32) ^ xs));
                  s0 = __builtin_amdgcn_mfma_f32_32x32x16_bf16(a0, qf[ks], s0, 0, 0, 0); s1 = __builtin_amdgcn_mfma_f32_32x32x16_bf16(a1, qf[ks], s1, 0, 0, 0); } }
            if (need_mask) {
#pragma unroll
                for (int r = 0; r < 16; ++r) { const int kl = (r & 3) + 8 * (r >> 2) + 4 * hi;
                    if (!(lanesel && kl > klo && kl <= khi)) s0[r] = -1e30f;
                    if (!(lanesel && kl + 32 > klo && kl + 32 <= khi)) s1[r] = -1e30f; }
            }
            if (MODE == M_CMP2) {
                const float mneg = -fmaxf(cm, -1e29f) * L2E;
#pragma unroll
                for (int r = 0; r < 16; ++r) { s0[r] = __builtin_amdgcn_exp2f(__builtin_fmaf(s0[r], L2E, mneg)) * cinv; s1[r] = __builtin_amdgcn_exp2f(__builtin_fmaf(s1[r], L2E, mneg)) * cinv; }
                LAS float* impG = (LAS float*)(lds + L_IMPG) + tokl * 128; LAS float* impL = (LAS float*)(lds + L_IMPL) + tokl * 128;
#pragma unroll
                for (int sub = 0; sub < 2; ++sub)
#pragma unroll
                    for (int q4 = 0; q4 < 4; ++q4) { const f32x16& sv = sub ? s1 : s0;
                        float gsum = (sv[4 * q4] + sv[4 * q4 + 1]) + (sv[4 * q4 + 2] + sv[4 * q4 + 3]), lst = sv[4 * q4 + 3];
                        gsum += qxor1(gsum); gsum += qxor2(gsum); lst += qxor1(lst); lst += qxor2(lst);
                        const int j = 16 * tix + 8 * sub + 2 * q4 + hi;
                        if ((c32 & 3) == 0) { impG[j] = gsum; if (j + 1 < 128) impL[j + 1] = lst; } }
            } else {
                float mx = fmaxf(s0[0], s1[0]);
#pragma unroll
                for (int r = 1; r < 16; ++r) mx = fmaxf(mx, fmaxf(s0[r], s1[r]));
                mx = fmaxf(mx, swap32f(mx));
                const float mnew = fmaxf(st.m, mx);
                const float alpha = __builtin_amdgcn_exp2f((st.m - mnew) * L2E);
                const float mneg = -fmaxf(mnew, -1e29f) * L2E;
                float rs = 0.f;
#pragma unroll
                for (int r = 0; r < 16; ++r) { s0[r] = __builtin_amdgcn_exp2f(__builtin_fmaf(s0[r], L2E, mneg)); s1[r] = __builtin_amdgcn_exp2f(__builtin_fmaf(s1[r], L2E, mneg)); rs += s0[r] + s1[r]; }
                st.l = st.l * alpha + rs; st.m = mnew;
                if (MODE != M_CMP1) {
#pragma unroll
                    for (int r = 0; r < 16; ++r) { st.o0[r] *= alpha; st.o1[r] *= alpha; }
                }
            }
            if (MODE != M_CMP1) {
                LAS const unsigned char* p = cur + TSZ + c32 * 128;
#pragma unroll
                for (int sub = 0; sub < 2; ++sub)
#pragma unroll
                    for (int s = 0; s < 2; ++s) { const f32x16& sv = sub ? s1 : s0;
                        u32x4 pw; pw.x = cvt_pk_bf16(sv[8 * s + 0], sv[8 * s + 1]); pw.y = cvt_pk_bf16(sv[8 * s + 2], sv[8 * s + 3]); pw.z = cvt_pk_bf16(sv[8 * s + 4], sv[8 * s + 5]); pw.w = cvt_pk_bf16(sv[8 * s + 6], sv[8 * s + 7]);
                        const bf16x8 pb = __builtin_bit_cast(bf16x8, pw);
                        const bf16x8 a0 = *(LAS const bf16x8*)(p + (((2 * sub + s) * 32) ^ xs)), a1 = *(LAS const bf16x8*)(p + 32 * 128 + (((2 * sub + s) * 32) ^ xs));
                        st.o0 = __builtin_amdgcn_mfma_f32_32x32x16_bf16(a0, pb, st.o0, 0, 0, 0); st.o1 = __builtin_amdgcn_mfma_f32_32x32x16_bf16(a1, pb, st.o1, 0, 0, 0); }
            }
        }
        __syncthreads();
    }
}

__device__ __forceinline__ void attn_item(Frame& F, int b, int g, int ci) {
    LAS unsigned char* lds = F.lds + RING_OFF;
    const int tid = F.tid, lane = F.lane, wave = F.wave, c32 = lane & 31, hi = lane >> 5;
    const int tokl = 8 * wave + (c32 >> 2), h = c32 & 3, ts = 64 * ci + tokl; const size_t trow = (size_t)b * SEQ + ts;
    const int bg = b * 4 + g;
    const bf16* Q = (const bf16*)(F.ws + WS_Q); bf16* O = (bf16*)(F.ws + WS_O);
    bf16x8 qf[4];
    { const bf16* qp = Q + trow * 1024 + g * 256 + h * 64 + 8 * hi;
#pragma unroll
      for (int ks = 0; ks < 4; ++ks) qf[ks] = *(const bf16x8*)(qp + 16 * ks); }
    const bf16* ngp = (const bf16*)(F.ws + WS_NGT) + trow * 64 + g * 12 + h * 3;
    const float gate_c = bf2f(ngp[0]), gate_s = bf2f(ngp[1]), gate_w = bf2f(ngp[2]);
    const int srow = tid >> 3, sch = (tid & 7) ^ ((tid >> 4) & 7);
    f32x16 f0 = (f32x16){0.f}, f1 = (f32x16){0.f};
    unsigned selw[4] = {0u, 0u, 0u, 0u};
    State st;
    {
        const int u0 = (ci >= 8) ? 0 : 8 - ci, nt = 9 - u0; const int pos0 = 64 * (ci - 8 + u0);
        const bf16* kp = (const bf16*)(F.ws + WS_KV + 4 * KV_STRIDE) + ((size_t)b * SEQ + pos0 + srow) * 256 + g * 64 + 8 * sch;
        const bf16* vp = (const bf16*)(F.ws + WS_VWT) + ((size_t)bg * 64 + srow) * SEQ + pos0 + 8 * sch;
        st.m = -1e30f; st.l = 0.f; st.o0 = (f32x16){0.f}; st.o1 = (f32x16){0.f};
        run_branch<M_WIN>(lds, nt, u0, kp, (size_t)64 * 256, vp, (size_t)64, qf, st, tokl, ci, 0, selw[0], selw[1], selw[2], selw[3], 0.f, 0.f, tid, lane, wave);
        const float lt = st.l + swap32f(st.l); const float sc = (lt > 0.f) ? gate_w / lt : 0.f;
#pragma unroll
        for (int r = 0; r < 16; ++r) { f0[r] += st.o0[r] * sc; f1[r] += st.o1[r] * sc; }
    }
    {
        const int ncmp = (4 * ci + 3 < NCMP) ? 4 * ci + 3 : NCMP, nt = (ncmp + 63) >> 6;
        const int nvis = (ts >= 31) ? (ts - 15) >> 4 : 0;
        const bf16* kp = (const bf16*)(F.ws + WS_KC) + ((size_t)bg * 512 + srow) * 64 + 8 * sch;
        const bf16* vp = (const bf16*)(F.ws + WS_VCT) + ((size_t)bg * 64 + srow) * 512 + 8 * sch;
        st.m = -1e30f; st.l = 0.f; st.o0 = (f32x16){0.f}; st.o1 = (f32x16){0.f};
        run_branch<M_CMP1>(lds, nt, 0, kp, (size_t)64 * 64, vp, (size_t)64, qf, st, tokl, ci, nvis, selw[0], selw[1], selw[2], selw[3], 0.f, 0.f, tid, lane, wave);
        const float lt = st.l + swap32f(st.l); const float cinv = (lt > 0.f) ? 1.0f / lt : 0.f; const float cm = st.m;
        run_branch<M_CMP2>(lds, nt, 0, kp, (size_t)64 * 64, vp, (size_t)64, qf, st, tokl, ci, nvis, selw[0], selw[1], selw[2], selw[3], cm, cinv, tid, lane, wave);
#pragma unroll
        for (int r = 0; r < 16; ++r) { f0[r] += st.o0[r] * gate_c; f1[r] += st.o1[r] * gate_c; }
    }
    {
        LAS unsigned* SEL = (LAS unsigned*)(lds + L_SEL);
        if (ci >= SELTOP) {
            const LAS float* impG = (const LAS float*)(lds + L_IMPG); const LAS float* impL = (const LAS float*)(lds + L_IMPL);
#pragma unroll 1
            for (int tk = 0; tk < 8; ++tk) { const int tl2 = 8 * wave + tk;
                float v0 = -3e38f, v1 = -3e38f;
                if (lane >= 1 && lane <= ci - 2) v0 = impG[tl2 * 128 + lane] + impL[tl2 * 128 + lane];
                if (lane + 64 <= ci - 2) v1 = impG[tl2 * 128 + lane + 64] + impL[tl2 * 128 + lane + 64];
                unsigned long long mlo = 0ull, mhi = 0ull;
#pragma unroll 1
                for (int r = 0; r < SELTOP - 3; ++r) {
                    const float mx = wave_max(fmaxf(v0, v1));
                    const unsigned long long b0 = __ballot(v0 == mx);
                    if (b0) { const int js = __ffsll((long long)b0) - 1; mlo |= 1ull << js; if (lane == js) v0 = -3e38f; }
                    else { const unsigned long long b1 = __ballot(v1 == mx); const int js = __ffsll((long long)b1) - 1; mhi |= 1ull << js; if (lane == js) v1 = -3e38f; }
                }
                mlo |= 1ull;
                if (ci - 1 < 64) mlo |= 1ull << (ci - 1); else mhi |= 1ull << (ci - 1 - 64);
                if (ci < 64) mlo |= 1ull << ci; else mhi |= 1ull << (ci - 64);
                if (lane == 0) { SEL[tl2 * 4 + 0] = (unsigned)mlo; SEL[tl2 * 4 + 1] = (unsigned)(mlo >> 32); SEL[tl2 * 4 + 2] = (unsigned)mhi; SEL[tl2 * 4 + 3] = (unsigned)(mhi >> 32); }
            }
            LDS_WAIT(); asm volatile("" ::: "memory");
#pragma unroll
            for (int q = 0; q < 4; ++q) selw[q] = SEL[tokl * 4 + q];
        } else {
            selw[0] = (ci == 31) ? 0xffffffffu : ((1u << (ci + 1)) - 1u); selw[1] = 0u; selw[2] = 0u; selw[3] = 0u;
        }
    }
    {
        const int nt = ci + 1;
        const bf16* kp = (const bf16*)(F.ws + WS_KV + 2 * KV_STRIDE) + ((size_t)b * SEQ + srow) * 256 + g * 64 + 8 * sch;
        const bf16* vp = (const bf16*)(F.ws + WS_VST) + ((size_t)bg * 64 + srow) * SEQ + 8 * sch;
        st.m = -1e30f; st.l = 0.f; st.o0 = (f32x16){0.f}; st.o1 = (f32x16){0.f};
        run_branch<M_SEL>(lds, nt, 0, kp, (size_t)64 * 256, vp, (size_t)64, qf, st, tokl, ci, 0, selw[0], selw[1], selw[2], selw[3], 0.f, 0.f, tid, lane, wave);
        const float lt = st.l + swap32f(st.l); const float sc = (lt > 0.f) ? gate_s / lt : 0.f;
#pragma unroll
        for (int r = 0; r < 16; ++r) { f0[r] += st.o0[r] * sc; f1[r] += st.o1[r] * sc; }
    }
    { bf16* op = O + trow * 1024 + g * 256 + h * 64 + 4 * hi;
#pragma unroll
      for (int q4 = 0; q4 < 4; ++q4) { u32x2 w0, w1; w0.x = pk2(f0[4 * q4], f0[4 * q4 + 1]); w0.y = pk2(f0[4 * q4 + 2], f0[4 * q4 + 3]); w1.x = pk2(f1[4 * q4], f1[4 * q4 + 1]); w1.y = pk2(f1[4 * q4 + 2], f1[4 * q4 + 3]);
          *(u32x2*)(op + 8 * q4) = w0; *(u32x2*)(op + 32 + 8 * q4) = w1; } }
}
__device__ __forceinline__ void attn_phase(Frame& F) {
    for (int idx = F.vcu; idx < BATCH * NG * (SEQ / 64); idx += F.G) { const int ci = 127 - (idx >> 4), bg = idx & 15; attn_item(F, bg >> 2, bg & 3, ci); }
}
}
#ifndef MK_N_LAUNCHES
#define MK_N_LAUNCHES 1
#endif
constexpr int N_PHASES = 16;
constexpr int N_LAUNCHES = MK_N_LAUNCHES;

__global__ void __launch_bounds__(NTHREADS, 2) fwd_megakernel(Args args) {
    extern __shared__ __attribute__((aligned(16))) unsigned char lds_raw[];
    Frame F;
    F.lds = (LAS unsigned char*)lds_raw;
    F.MISC = (volatile LAS unsigned*)(F.lds + MISC_OFF);
    F.tid = threadIdx.x; F.lane = F.tid & 63; F.wave = __builtin_amdgcn_readfirstlane(F.tid >> 6);
    F.G = gridDim.x; { const int bx = blockIdx.x; F.vcu = (F.G % 8 == 0) ? (bx % 8) * (F.G / 8) + bx / 8 : bx; }
    F.ws = args.ws; F.ctl = (gu32*)(args.ws + WS_CTL); F.out = args.out;
    for (int u = F.tid; u < (LDS_BYTES - LDSCTL_OFF) / 4; u += NTHREADS) ((LAS unsigned*)(F.lds + LDSCTL_OFF))[u] = 0u;
    __syncthreads();
    XcdBarrier bar; bar.bar = (unsigned*)(F.ctl + CW_BAR); bar.x = 0; bar.st = nullptr;
    if (N_LAUNCHES == 1) bar = xcd_barrier_post((unsigned*)(F.ctl + CW_BAR), F.MISC + 8);
    const int lo = args.ph_lo, hi = args.ph_hi;
#ifdef PH_MASK
#define IN(k) (((PH_MASK >> (k)) & 1) && lo <= (k) && (k) < hi)
#else
#define IN(k) (lo <= (k) && (k) < hi)
#endif
#define SEAM(k) do { if (IN(k) && IN((k) + 1)) xcd_barrier(bar); asm volatile("" : "+s"(F.ws), "+s"(F.out)); } while (0)
    LAS unsigned char* ring = F.lds + RING_OFF;
    const int G = F.G, bx = (int)blockIdx.x;

    if (IN(0)) { p0_prologue(F, args); } SEAM(0);
    if (IN(1)) { norm_mod_rows<true>(F, args, AIN[I_X], (bf16*)(F.ws + WS_XN), AIN[I_N1G], 0, 1024); finalize_mod(F, args); } SEAM(1);
    if (IN(2)) {
        pg8::DenseOrder S; S.init(F.ws + WS_XN, 2048, F.ws + WS_WIN, 1024, T, NINP, G, bx);
        EpiIn E{(const float*)(F.ws + WS_BINP), (bf16*)(F.ws + WS_U), (bf16*)(F.ws + WS_Q), (bf16*)(F.ws + WS_KV), (bf16*)(F.ws + WS_NGT), (bf16*)(F.ws + WS_GM)};
        pg8::gemm_phase<EpiIn, pg8::DenseOrder, true, true>(ring, 1024, S, E);
    } SEAM(2);
    if (IN(3)) { p3_phase(F, args); } SEAM(3);
    if (IN(4)) { att::attn_phase(F); } SEAM(4);
    if (IN(5)) {
        pg8::DenseOrder S; S.init(F.ws + WS_CF, 1024, F.ws + WS_WC, 512, T, 1024, G, bx);
        EpiMix<0> E{(const bf16*)(F.ws + WS_GM), (bf16*)(F.ws + WS_MIX), AIN[I_BCO]};
        pg8::gemm_phase<EpiMix<0>, pg8::DenseOrder, true, true>(ring, 512, S, E);
    } SEAM(5);
    if (IN(6)) {
        pg8::DenseOrder S; S.init(F.ws + WS_O, 2048, F.ws + WS_WN, 1024, T, 1024, G, bx);
        EpiMix<1> E{(const bf16*)(F.ws + WS_GM), (bf16*)(F.ws + WS_MIX), nullptr};
        pg8::gemm_phase<EpiMix<1>, pg8::DenseOrder, true, true>(ring, 1024, S, E);
    } SEAM(6);
    if (IN(7)) {
        pg8::DenseOrder S; S.init(F.ws + WS_MIX, 2048, F.ws + WS_WO, 1024, T, 1024, G, bx);
        EpiOut E{AIN[I_X], F.out, (const float*)(F.ws + WS_MODF) + 2048};
        pg8::gemm_phase<EpiOut, pg8::DenseOrder, true, true>(ring, 1024, S, E);
    } SEAM(7);
    if (IN(8)) { norm_mod_rows<false>(F, args, F.out, (bf16*)(F.ws + WS_XN), AIN[I_N2G], 3072, 4096); } SEAM(8);
    if (IN(9)) {
        pg8::DenseOrder S; S.init(F.ws + WS_XN, 2048, F.ws + WS_WR, 1024, T, 256, G, bx);
        EpiLogits E{(float*)(F.ws + WS_LOG)};
        pg8::gemm_phase<EpiLogits, pg8::DenseOrder, true, true>(ring, 1024, S, E);
    } SEAM(9);
    if (IN(10)) { routing_phase(F, args); } SEAM(10);
    if (IN(11)) {
        build_tables(F);
        const LAS int* tab = (const LAS int*)(F.lds + TAB_OFF);
        ExpertOrder S{tab, (const char*)(F.ws + WS_XN), (const char*)(F.ws + WS_WGU), (const char*)(F.ws + WS_WSHGU), nullptr, (const int*)(F.ws + WS_TOKL), 0, 0, G, F.vcu, tab[260 + NEXP + 1]};
        EpiAct E{(bf16*)(F.ws + WS_ACT), (bf16*)(F.ws + WS_ACTSH)};
        pg8::gemm_phase<EpiAct, ExpertOrder, true, true>(ring, 1024, S, E);
    } SEAM(11);
#pragma unroll 1
    for (int hh = 0; hh < 2; ++hh) {
        if (IN(12 + 2 * hh)) {
            build_tables(F);
            const LAS int* tab = (const LAS int*)(F.lds + TAB_OFF);
            ExpertOrder S{tab, (const char*)(F.ws + WS_ACT), (const char*)(F.ws + WS_WD), (const char*)(F.ws + WS_WSHD), (const char*)(F.ws + WS_ACTSH), nullptr, 1, hh, G, F.vcu, tab[260 + NEXP + 1]};
            EpiDown E{(bf16*)(F.ws + WS_YS), F.out, (const float*)(F.ws + WS_MODF) + 5120};
            pg8::gemm_phase<EpiDown, ExpertOrder, true, true>(ring, 256, S, E);
        } SEAM(12 + 2 * hh);
        if (IN(13 + 2 * hh)) { build_tables(F); combine_phase(F, args, hh); } SEAM(13 + 2 * hh);
    }
#undef IN
#undef SEAM
}

extern "C" void kernel_launch(void* const* d_in, const int* in_sizes, int n_in, void* d_out, int out_size, void* d_ws, size_t ws_size, hipStream_t stream) {
    static int grid = 0;
    if (grid == 0) {
        if (n_in != 31 || in_sizes[0] != T * DM || out_size != T * DM || ws_size < WS_END) { fprintf(stderr, "kernel_launch: unexpected problem (n_in %d, in0 %d, out %d, ws %zu); nothing launched\n", n_in, n_in > 0 ? in_sizes[0] : -1, out_size, ws_size); grid = -1; return; }
        int dev = 0, cus = 0, per_cu = 0;
        if (hipGetDevice(&dev) != hipSuccess || hipDeviceGetAttribute(&cus, hipDeviceAttributeMultiprocessorCount, dev) != hipSuccess) { grid = -1; return; }
        if (hipFuncSetAttribute((const void*)fwd_megakernel, hipFuncAttributeMaxDynamicSharedMemorySize, LDS_BYTES) != hipSuccess) { fprintf(stderr, "kernel_launch: hipFuncSetAttribute failed\n"); grid = -1; return; }
        if (hipOccupancyMaxActiveBlocksPerMultiprocessor(&per_cu, (const void*)fwd_megakernel, NTHREADS, LDS_BYTES) != hipSuccess || per_cu < 1)
            fprintf(stderr, "kernel_launch: note: occupancy query reports %d workgroups per CU\n", per_cu);
        (void)hipGetLastError();
        grid = cus;
    }
    if (grid < 0) return;
    if (hipMemsetAsync((char*)d_ws + WS_CTL, 0, CTL_ZERO_BYTES, stream) != hipSuccess) { fprintf(stderr, "kernel_launch: memset failed\n"); return; }
    Args a{};
    for (int i = 0; i < 31; ++i) a.in[i] = (const float*)d_in[i];
    a.out = (float*)d_out; a.ws = (unsigned char*)d_ws;
    for (int li = 0; li < N_LAUNCHES; ++li) {
        a.ph_lo = (N_LAUNCHES == 1) ? 0 : li; a.ph_hi = (N_LAUNCHES == 1) ? N_PHASES : li + 1; a.li = li;
        hipLaunchKernelGGL(fwd_megakernel, dim3(grid), dim3(NTHREADS), LDS_BYTES, stream, a);
        const hipError_t le = hipPeekAtLastError();
        if (le != hipSuccess) { fprintf(stderr, "kernel_launch: launch %d failed: %s\n", li, hipGetErrorName(le)); break; }
    }
}
```

```cpp
#include <hip/hip_runtime.h>
#include <cstdio>
#include <cstdint>

#define GAS __attribute__((address_space(1)))
#define LAS __attribute__((address_space(3)))
typedef unsigned short bf16;
typedef short bf16x8 __attribute__((ext_vector_type(8)));
typedef float f32x4 __attribute__((ext_vector_type(4)));
typedef float f32x2 __attribute__((ext_vector_type(2)));
typedef float f32x16 __attribute__((ext_vector_type(16)));
typedef unsigned u32x4 __attribute__((ext_vector_type(4)));
typedef unsigned u32x2 __attribute__((ext_vector_type(2)));
typedef GAS unsigned gu32;

constexpr int BATCH = 4, SEQ = 8192, DM = 1024, T = BATCH * SEQ;
constexpr int DCONV = 512, CONVK = 31;
constexpr int NH = 16, NG = 4, HG = 4, HD = 64;
constexpr int NCMP = 511, NSEL = 128, SELTOP = 16, WINDOW = 512;
constexpr int NEXP = 256, TOPK = 8, DEXP = 256;
constexpr int NIN = 5680, NINP = 5888;
constexpr float EPS = 1e-6f;
constexpr int NWAVES = 8, NTHREADS = 512;

constexpr size_t MiB = 1u << 20;
constexpr size_t WS_CTL = 0, CTL_ZERO_BYTES = 1 * MiB;
constexpr size_t WS_MODP = 1 * MiB;
constexpr size_t WS_MODF = 2 * MiB;
constexpr size_t WS_PEBP = 2 * MiB + 128 * 1024;
constexpr size_t WS_PEBF = 2 * MiB + 160 * 1024;
constexpr size_t WS_BINP = 2 * MiB + 192 * 1024;
constexpr size_t WS_WIN = 3 * MiB;
constexpr size_t WS_WC = 15 * MiB;
constexpr size_t WS_WN = 16 * MiB;
constexpr size_t WS_WO = 18 * MiB;
constexpr size_t WS_WR = 20 * MiB;
constexpr size_t WS_WSHGU = 21 * MiB;
constexpr size_t WS_WSHD = 22 * MiB;
constexpr size_t WS_CW1 = 23 * MiB;
constexpr size_t WS_CW2 = 24 * MiB;
constexpr size_t WS_WGU = 32 * MiB;
constexpr size_t WS_WD = 288 * MiB;
constexpr size_t WS_XN = 416 * MiB;
constexpr size_t WS_U = 480 * MiB;
constexpr size_t WS_CF = 512 * MiB;
constexpr size_t WS_Q = 544 * MiB;
constexpr size_t WS_O = 608 * MiB;
constexpr size_t WS_KV = 672 * MiB;
constexpr size_t KV_STRIDE = 16 * MiB;
constexpr size_t WS_VST = 768 * MiB;
constexpr size_t WS_VWT = 784 * MiB;
constexpr size_t WS_KC = 800 * MiB;
constexpr size_t WS_VCT = 801 * MiB;
constexpr size_t WS_NGT = 802 * MiB;
constexpr size_t WS_GM = 808 * MiB;
constexpr size_t WS_MIX = 936 * MiB;
constexpr size_t WS_LOG = 480 * MiB;
constexpr size_t WS_RTE = 512 * MiB;
constexpr size_t WS_RTS = 513 * MiB;
constexpr size_t WS_RTW = 514 * MiB;
constexpr size_t WS_TOKL = 516 * MiB;
constexpr size_t WS_ACT = 548 * MiB;
constexpr size_t WS_ACTSH = 680 * MiB;
constexpr size_t WS_YS = 696 * MiB;
constexpr size_t WS_END = 952 * MiB;

constexpr int CW_TMO = 0, CW_CODE = 1;
constexpr int CW_BAR = 4096;
constexpr int CW_CNT = 32768;

constexpr int RING_OFF = 0, RING_BYTES = 131072;
constexpr int LDSCTL_OFF = RING_BYTES, MISC_OFF = LDSCTL_OFF + 320;
constexpr int TAB_OFF = LDSCTL_OFF + 1024;
constexpr int LDS_BYTES = 147456;

#define LDS_WAIT() asm volatile("s_waitcnt lgkmcnt(0)" ::: "memory")
#define VM_WAIT() asm volatile("s_waitcnt vmcnt(0)" ::: "memory")
#define RLX_AGENT __ATOMIC_RELAXED, __HIP_MEMORY_SCOPE_AGENT

__device__ __forceinline__ unsigned f2bf(float f) { unsigned u = __builtin_bit_cast(unsigned, f); return (u + 0x7fffu + ((u >> 16) & 1u)) >> 16; }
__device__ __forceinline__ unsigned pk2(float lo, float hi) { return f2bf(lo) | (f2bf(hi) << 16); }
__device__ __forceinline__ float bf2f(unsigned b) { return __builtin_bit_cast(float, b << 16); }
__device__ __forceinline__ float bflo(unsigned w) { return __builtin_bit_cast(float, w << 16); }
__device__ __forceinline__ float bfhi(unsigned w) { return __builtin_bit_cast(float, w & 0xffff0000u); }
__device__ __forceinline__ float sigmoidf_(float x) { return __builtin_amdgcn_rcpf(1.0f + __expf(-x)); }
__device__ __forceinline__ float wave_sum(float v) {
#pragma unroll
    for (int o = 1; o < 64; o <<= 1) v += __shfl_xor(v, o);
    return v;
}
#define DPP_F(old_, v_, ctrl, rmask) __builtin_bit_cast(float, __builtin_amdgcn_update_dpp(__builtin_bit_cast(int, (old_)), __builtin_bit_cast(int, (v_)), (ctrl), (rmask), 0xF, false))
__device__ __forceinline__ float wave_max(float v) {
    v = fmaxf(v, DPP_F(v, v, 0xB1, 0xF));
    v = fmaxf(v, DPP_F(v, v, 0x4E, 0xF));
    v = fmaxf(v, DPP_F(v, v, 0x141, 0xF));
    v = fmaxf(v, DPP_F(v, v, 0x140, 0xF));
    v = fmaxf(v, DPP_F(v, v, 0x142, 0xA));
    v = fmaxf(v, DPP_F(v, v, 0x143, 0xC));
    return __builtin_bit_cast(float, __builtin_amdgcn_readlane(__builtin_bit_cast(int, v), 63));
}

namespace pg8 {
constexpr int BM = 256, BK = 64, HALF = 128, HTB = HALF * BK * 2, STAGE_BYTES = 8 * HTB, NXCD = 8, WGM = 8;
__host__ __device__ __forceinline__ int lds_byte(int r, int c) { const int st = (r >> 4) * 2 + (c >> 5), rr = r & 15, cc = c & 31, ob = rr * 64 + cc * 2; return st * 1024 + (ob ^ (((ob >> 9) & 1) << 5)); }
__host__ __device__ __forceinline__ void stage_rc(int b, int& R, int& C) { const int st = b / 1024, sb = b % 1024, swz = sb ^ (((sb >> 9) & 1) << 5); R = (st >> 1) * 16 + swz / 64; C = (st & 1) * 32 + (swz % 64) / 2; }
__host__ __device__ __forceinline__ int perm32(int rho) { const int n = rho >> 4, i = rho & 15; return 8 * (i >> 2) + 4 * n + (i & 3); }

struct Unit { int pm, pn; const char* A; const char* B; int e, mt, cnt, off; };

typedef __bf16 bf16x2_t __attribute__((ext_vector_type(2)));
__device__ __forceinline__ unsigned cvt_pk_bf16(float lo, float hi) { f32x2 v = {lo, hi}; bf16x2_t b = __builtin_convertvector(v, bf16x2_t); return __builtin_bit_cast(unsigned, b); }

struct DenseOrder {
    const char* A; const char* Bt; int lda_b, K; int nM, nN, nwg, G, c;
    __device__ void init(const void* A_, int lda_bytes, const void* Bt_, int K_, int M, int N, int G_, int c_) { A = (const char*)A_; Bt = (const char*)Bt_; lda_b = lda_bytes; K = K_; nM = M / BM; nN = N / BM; nwg = nM * nN; G = G_; c = c_; }
    __device__ __forceinline__ bool next(int i, Unit& u) const {
        const long L = (long)i * G + c; if (L >= nwg) return false;
        int wgid = (int)L; { const int q = nwg / NXCD, r = nwg % NXCD, xcd = wgid % NXCD, off = wgid / NXCD; wgid = (xcd < r ? xcd * (q + 1) : r * (q + 1) + (xcd - r) * q) + off; }
        const int nig = WGM * nN, gid = wgid / nig, fm = gid * WGM, gsz = (nM - fm) < WGM ? (nM - fm) : WGM;
        u.pm = fm + ((wgid % nig) % gsz); u.pn = (wgid % nig) / gsz;
        u.A = A + (size_t)u.pm * BM * lda_b; u.B = Bt + (size_t)u.pn * BM * K * 2; u.e = 0; u.mt = 0; u.cnt = 0; u.off = 0; return true;
    }
    __device__ __forceinline__ unsigned row_off(const Unit&, int r) const { return (unsigned)r * (unsigned)lda_b; }
};

template <class Epi, class Sched, bool ALIGN_EPI, bool SP2>
__device__ __forceinline__ void gemm_phase(LAS unsigned char* lds, const int K, const Sched& S, const Epi& E) {
    const int tid = threadIdx.x, wid = __builtin_amdgcn_readfirstlane(tid >> 6), lane = tid & 63, wr = wid >> 2, wc = wid & 3, fr = lane & 15, fq = lane >> 4;
    const int nt = K / BK;
    int Rr[2], Cc[2]; unsigned voffB[2];
#pragma unroll
    for (int i = 0; i < 2; ++i) { int R, C; stage_rc(tid * 16 + i * 8192, R, C); const int Rb = Epi::PERM ? ((R & ~31) + perm32(R & 31)) : R; Rr[i] = R; Cc[i] = C * 2; voffB[i] = (unsigned)(Rb * K + C) * 2u; }
    const size_t kstep = (size_t)(BK * 2);
    const size_t hstepB = (size_t)HALF * K * 2;
    const unsigned ldsw = (unsigned)wid * 1024u;
    const int aoff = lds_byte(wr * 64 + fr, fq * 8), boff = lds_byte(wc * 32 + fr, fq * 8);
#define PG8_SA(b, h) (((b) * 2 + (h)) * HTB)
#define PG8_SB(b, h) ((4 + (b) * 2 + (h)) * HTB)
#define PG8_STAGE2(bufoff, gbase, o0, o1) do { \
        __builtin_amdgcn_global_load_lds((const unsigned*)((const char*)(gbase) + (o0)), (LAS unsigned*)(lds + (bufoff) + ldsw), 16, 0, 0); \
        __builtin_amdgcn_global_load_lds((const unsigned*)((const char*)(gbase) + (o1)), (LAS unsigned*)(lds + (bufoff) + ldsw + 8192), 16, 0, 0); } while (0)
#define PG8_STAGEB(bufoff, gbase) PG8_STAGE2(bufoff, gbase, voffB[0], voffB[1])
#define PG8_LDA(dst, b, h) do { _Pragma("unroll") for (int m = 0; m < 4; ++m) _Pragma("unroll") for (int k = 0; k < 2; ++k) dst[m][k] = *(const LAS bf16x8*)(lds + PG8_SA(b, h) + aoff + m * 2048 + k * 1024); } while (0)
#define PG8_LDB(dst, b, h) do { _Pragma("unroll") for (int n = 0; n < 2; ++n) _Pragma("unroll") for (int k = 0; k < 2; ++k) dst[n][k] = *(const LAS bf16x8*)(lds + PG8_SB(b, h) + boff + n * 2048 + k * 1024); } while (0)
#define PG8_MMA(ai, bj, At, Bt) do { __builtin_amdgcn_s_setprio(1); _Pragma("unroll") for (int m = 0; m < 4; ++m) _Pragma("unroll") for (int n = 0; n < 2; ++n) _Pragma("unroll") for (int k = 0; k < 2; ++k) \
        acc[ai][bj][m][n] = __builtin_amdgcn_mfma_f32_16x16x32_bf16(Bt[n][k], At[m][k], acc[ai][bj][m][n], 0, 0, 0); __builtin_amdgcn_s_setprio(0); } while (0)
#define PG8_WAIT_V(n) asm volatile("s_waitcnt vmcnt(" #n ")" ::: "memory")
#define PG8_WAIT_L(n) asm volatile("s_waitcnt lgkmcnt(" #n ")" ::: "memory")
#define PG8_BAR __builtin_amdgcn_s_barrier()
#define PG8_SCHED __builtin_amdgcn_sched_barrier(0)
    Unit cur, nxt; int ui = 0;
    if (!S.next(0, cur)) return;
    f32x4 acc[2][2][4][2];
#pragma unroll
    for (int a = 0; a < 2; ++a)
#pragma unroll
        for (int b = 0; b < 2; ++b)
#pragma unroll
            for (int m = 0; m < 4; ++m)
#pragma unroll
                for (int n = 0; n < 2; ++n) acc[a][b][m][n] = (f32x4){0.f, 0.f, 0.f, 0.f};
    bf16x8 At[4][2], B0[2][2], B1[2][2];
    unsigned vc00, vc01, vc10, vc11, vn00, vn01, vn10, vn11;
    vc00 = S.row_off(cur, Rr[0]) + Cc[0]; vc01 = S.row_off(cur, Rr[1]) + Cc[1]; vc10 = S.row_off(cur, HALF + Rr[0]) + Cc[0]; vc11 = S.row_off(cur, HALF + Rr[1]) + Cc[1];
    const char* cA = cur.A; const char* cB = cur.B;
    PG8_STAGEB(PG8_SB(0, 0), cB); PG8_STAGEB(PG8_SB(0, 1), cB + hstepB); PG8_STAGE2(PG8_SA(0, 0), cA, vc00, vc01); PG8_STAGE2(PG8_SA(0, 1), cA, vc10, vc11);
    if (wr == 1) PG8_BAR;
    PG8_WAIT_V(2); PG8_BAR;
    PG8_STAGEB(PG8_SB(1, 0), cB + kstep); PG8_STAGE2(PG8_SA(1, 0), cA + kstep, vc00, vc01); PG8_STAGEB(PG8_SB(1, 1), cB + hstepB + kstep);
    PG8_WAIT_V(6); PG8_BAR;
    for (;;) {
        const bool has_next = S.next(ui + 1, nxt);
        const char* nA = has_next ? nxt.A : cA; const char* nB = has_next ? nxt.B : cB;
        if (has_next) { vn00 = S.row_off(nxt, Rr[0]) + Cc[0]; vn01 = S.row_off(nxt, Rr[1]) + Cc[1]; vn10 = S.row_off(nxt, HALF + Rr[0]) + Cc[0]; vn11 = S.row_off(nxt, HALF + Rr[1]) + Cc[1]; }
        else { vn00 = vc00; vn01 = vc01; vn10 = vc10; vn11 = vc11; }
        for (int t = 0; t < nt; t += 2) {
            const bool last = (t == nt - 2);
            const char* a1 = cA + (size_t)(t + 1) * kstep;
            const char* a2 = last ? nA : cA + (size_t)(t + 2) * kstep; const char* b2 = last ? nB : cB + (size_t)(t + 2) * kstep;
            const char* a3 = a2 + kstep; const char* b3 = b2 + kstep;
            const unsigned x00 = last ? vn00 : vc00, x01 = last ? vn01 : vc01, x10 = last ? vn10 : vc10, x11 = last ? vn11 : vc11;
            PG8_LDB(B0, 0, 0); PG8_LDB(B1, 0, 1); PG8_SCHED; PG8_LDA(At, 0, 0); PG8_STAGE2(PG8_SA(1, 1), a1, vc10, vc11);
            PG8_WAIT_V(8); PG8_WAIT_L(0); PG8_BAR; PG8_MMA(0, 0, At, B0); PG8_MMA(0, 1, At, B1); PG8_BAR; PG8_SCHED;
            PG8_LDA(At, 0, 1); PG8_STAGEB(PG8_SB(0, 0), b2); PG8_STAGEB(PG8_SB(0, 1), b2 + hstepB); PG8_STAGE2(PG8_SA(0, 0), a2, x00, x01);
            PG8_WAIT_V(8); PG8_WAIT_L(0); PG8_BAR; PG8_MMA(1, 0, At, B0); PG8_MMA(1, 1, At, B1); PG8_BAR; PG8_SCHED;
            PG8_LDB(B0, 1, 0); PG8_LDB(B1, 1, 1); PG8_SCHED; PG8_LDA(At, 1, 0); PG8_STAGE2(PG8_SA(0, 1), a2, x10, x11);
            PG8_WAIT_V(8); PG8_WAIT_L(0); PG8_BAR; PG8_MMA(0, 0, At, B0); PG8_MMA(0, 1, At, B1); PG8_BAR; PG8_SCHED;
            PG8_LDA(At, 1, 1); PG8_STAGEB(PG8_SB(1, 0), b3); PG8_STAGEB(PG8_SB(1, 1), b3 + hstepB); PG8_STAGE2(PG8_SA(1, 0), a3, x00, x01);
            PG8_WAIT_V(8); PG8_WAIT_L(0); PG8_BAR; PG8_MMA(1, 0, At, B0); PG8_MMA(1, 1, At, B1); PG8_BAR; PG8_SCHED;
        }
        if constexpr (ALIGN_EPI) { if (wr == 0) PG8_BAR; }
        E(acc, cur, wr, wc, fr, fq);
        if (!has_next) break;
#pragma unroll
        for (int a = 0; a < 2; ++a)
#pragma unroll
            for (int b = 0; b < 2; ++b)
#pragma unroll
                for (int m = 0; m < 4; ++m)
#pragma unroll
                    for (int n = 0; n < 2; ++n) acc[a][b][m][n] = (f32x4){0.f, 0.f, 0.f, 0.f};
        cur = nxt; cA = nA; cB = nB; ++ui; vc00 = vn00; vc01 = vn01; vc10 = vn10; vc11 = vn11;
        if constexpr (ALIGN_EPI) { if (wr == 1) PG8_BAR; }
    }
    PG8_WAIT_V(0);
    if constexpr (!ALIGN_EPI) { if (wr == 0) PG8_BAR; }
    PG8_BAR;
#undef PG8_SA
#undef PG8_SB
#undef PG8_STAGE2
#undef PG8_STAGEB
#undef PG8_LDA
#undef PG8_LDB
#undef PG8_MMA
#undef PG8_WAIT_V
#undef PG8_WAIT_L
#undef PG8_BAR
#undef PG8_SCHED
}
}
using pg8::Unit;
using pg8::cvt_pk_bf16;

__device__ __forceinline__ u32x4 pack8(const f32x4& v0, const f32x4& v1) { u32x4 w; w.x = cvt_pk_bf16(v0[0], v0[1]); w.y = cvt_pk_bf16(v0[2], v0[3]); w.z = cvt_pk_bf16(v1[0], v1[1]); w.w = cvt_pk_bf16(v1[2], v1[3]); return w; }
__device__ __forceinline__ f32x4 sig4(const f32x4& v) { return (f32x4){sigmoidf_(v[0]), sigmoidf_(v[1]), sigmoidf_(v[2]), sigmoidf_(v[3])}; }
__device__ __forceinline__ void unpack8(const u32x4& w, f32x4& a, f32x4& b) { a = (f32x4){bflo(w.x), bfhi(w.x), bflo(w.y), bfhi(w.y)}; b = (f32x4){bflo(w.z), bfhi(w.z), bflo(w.w), bfhi(w.w)}; }

struct EpiIn {
    static constexpr bool PERM = true;
    const float* binp; bf16* U; bf16* Q; bf16* KV; bf16* NGt; bf16* GM;
    __device__ __forceinline__ void operator()(const f32x4 (&acc)[2][2][4][2], const Unit& u, int wr, int wc, int fr, int fq) const {
        const int row0 = u.pm * 256 + wr * 64 + fr, pn = u.pn, cin = wc * 32 + 8 * fq;
        f32x4 bv[2][2];
#pragma unroll
        for (int bj = 0; bj < 2; ++bj)
#pragma unroll
            for (int n = 0; n < 2; ++n) bv[bj][n] = *(const f32x4*)(binp + pn * 256 + bj * 128 + cin + 4 * n);
        if (pn < 4) {
#pragma unroll
            for (int ai = 0; ai < 2; ++ai)
#pragma unroll
                for (int m = 0; m < 4; ++m) { const size_t row = (size_t)(row0 + ai * 128 + m * 16);
                    const f32x4 a0 = acc[ai][0][m][0] + bv[0][0], a1 = acc[ai][0][m][1] + bv[0][1], g0 = sig4(acc[ai][1][m][0] + bv[1][0]), g1 = sig4(acc[ai][1][m][1] + bv[1][1]);
                    *(u32x4*)(U + row * 512 + pn * 128 + cin) = pack8(a0 * g0, a1 * g1); }
        } else if (pn < 14) {
            bf16* base; int ld; float sc = 1.f;
            if (pn < 8) { base = Q + (pn - 4) * 256; ld = 1024; sc = 0.125f; } else { base = KV + (size_t)(pn - 8) * (KV_STRIDE / 2); ld = 256; }
#pragma unroll
            for (int ai = 0; ai < 2; ++ai)
#pragma unroll
                for (int m = 0; m < 4; ++m) { bf16* rp = base + (size_t)(row0 + ai * 128 + m * 16) * ld + cin;
#pragma unroll
                    for (int bj = 0; bj < 2; ++bj) *(u32x4*)(rp + bj * 128) = pack8((acc[ai][bj][m][0] + bv[bj][0]) * sc, (acc[ai][bj][m][1] + bv[bj][1]) * sc); }
        } else if (pn == 14) {
            if (wc < 2) {
#pragma unroll
                for (int ai = 0; ai < 2; ++ai)
#pragma unroll
                    for (int m = 0; m < 4; ++m) { const size_t row = (size_t)(row0 + ai * 128 + m * 16);
                        *(u32x4*)(NGt + row * 64 + cin) = pack8(sig4(acc[ai][0][m][0] + bv[0][0]), sig4(acc[ai][0][m][1] + bv[0][1])); }
            }
        } else {
#pragma unroll
            for (int ai = 0; ai < 2; ++ai)
#pragma unroll
                for (int m = 0; m < 4; ++m) { bf16* rp = GM + (size_t)(row0 + ai * 128 + m * 16) * 2048 + (pn - 15) * 256 + cin;
#pragma unroll
                    for (int bj = 0; bj < 2; ++bj) *(u32x4*)(rp + bj * 128) = pack8(sig4(acc[ai][bj][m][0] + bv[bj][0]), sig4(acc[ai][bj][m][1] + bv[bj][1])); }
        }
    }
};

template <int MODE> struct EpiMix {
    static constexpr bool PERM = true;
    const bf16* GM; bf16* MIX; const float* bias;
    __device__ __forceinline__ void operator()(const f32x4 (&acc)[2][2][4][2], const Unit& u, int wr, int wc, int fr, int fq) const {
        const int row0 = u.pm * 256 + wr * 64 + fr, col0 = u.pn * 256 + wc * 32 + 8 * fq;
        f32x4 bv[2][2];
#pragma unroll
        for (int bj = 0; bj < 2; ++bj)
#pragma unroll
            for (int n = 0; n < 2; ++n) bv[bj][n] = (MODE == 0) ? *(const f32x4*)(bias + col0 + bj * 128 + 4 * n) : (f32x4){0.f, 0.f, 0.f, 0.f};
#pragma unroll
        for (int ai = 0; ai < 2; ++ai)
#pragma unroll
            for (int m = 0; m < 4; ++m) { const size_t row = (size_t)(row0 + ai * 128 + m * 16);
#pragma unroll
                for (int bj = 0; bj < 2; ++bj) { const int col = col0 + bj * 128;
                    f32x4 g0, g1; unpack8(*(const u32x4*)(GM + row * 2048 + MODE * 1024 + col), g0, g1);
                    f32x4 v0 = (acc[ai][bj][m][0] + bv[bj][0]) * g0, v1 = (acc[ai][bj][m][1] + bv[bj][1]) * g1;
                    if (MODE == 1) { f32x4 p0, p1; unpack8(*(const u32x4*)(MIX + row * 1024 + col), p0, p1); v0 += p0; v1 += p1; }
                    *(u32x4*)(MIX + row * 1024 + col) = pack8(v0, v1); } }
    }
};

struct EpiOut {
    static constexpr bool PERM = false;
    const float* x; float* out; const float* g1;
    __device__ __forceinline__ void operator()(const f32x4 (&acc)[2][2][4][2], const Unit& u, int wr, int wc, int fr, int fq) const {
        const int row0 = u.pm * 256 + wr * 64 + fr, col0 = u.pn * 256 + wc * 32 + 4 * fq; const int b = (u.pm * 256) >> 13;
        f32x4 gv[2][2];
#pragma unroll
        for (int bj = 0; bj < 2; ++bj)
#pragma unroll
            for (int n = 0; n < 2; ++n) gv[bj][n] = *(const f32x4*)(g1 + b * 6144 + col0 + bj * 128 + 16 * n);
#pragma unroll
        for (int ai = 0; ai < 2; ++ai)
#pragma unroll
            for (int m = 0; m < 4; ++m) { const size_t off = (size_t)(row0 + ai * 128 + m * 16) * 1024 + col0;
#pragma unroll
                for (int bj = 0; bj < 2; ++bj)
#pragma unroll
                    for (int n = 0; n < 2; ++n) { const f32x4 xv = *(const f32x4*)(x + off + bj * 128 + 16 * n); *(f32x4*)(out + off + bj * 128 + 16 * n) = xv + gv[bj][n] * acc[ai][bj][m][n]; } }
    }
};

struct EpiLogits {
    static constexpr bool PERM = false;
    float* L;
    __device__ __forceinline__ void operator()(const f32x4 (&acc)[2][2][4][2], const Unit& u, int wr, int wc, int fr, int fq) const {
        const int row0 = u.pm * 256 + wr * 64 + fr, col0 = wc * 32 + 4 * fq;
#pragma unroll
        for (int ai = 0; ai < 2; ++ai)
#pragma unroll
            for (int m = 0; m < 4; ++m) { const size_t off = (size_t)(row0 + ai * 128 + m * 16) * 256 + col0;
#pragma unroll
                for (int bj = 0; bj < 2; ++bj)
#pragma unroll
                    for (int n = 0; n < 2; ++n) *(f32x4*)(L + off + bj * 128 + 16 * n) = acc[ai][bj][m][n]; }
    }
};

struct EpiAct {
    static constexpr bool PERM = true;
    bf16* ACT; bf16* ACTSH;
    __device__ __forceinline__ void operator()(const f32x4 (&acc)[2][2][4][2], const Unit& u, int wr, int wc, int fr, int fq) const {
        const int slot0 = u.mt * 256 + wr * 64 + fr, col = (u.pn & 1) * 128 + wc * 32 + 8 * fq;
        bf16* base = (u.e == NEXP) ? ACTSH : ACT + (size_t)u.off * 256;
#pragma unroll
        for (int ai = 0; ai < 2; ++ai)
#pragma unroll
            for (int m = 0; m < 4; ++m) { const int slot = slot0 + ai * 128 + m * 16;
                if (slot < u.cnt) { const f32x4 g0 = acc[ai][0][m][0], g1 = acc[ai][0][m][1];
                    *(u32x4*)(base + (size_t)slot * 256 + col) = pack8(g0 * sig4(g0) * acc[ai][1][m][0], g1 * sig4(g1) * acc[ai][1][m][1]); } }
    }
};

struct EpiDown {
    static constexpr bool PERM = true;
    bf16* YS; float* out; const float* g2;
    __device__ __forceinline__ void operator()(const f32x4 (&acc)[2][2][4][2], const Unit& u, int wr, int wc, int fr, int fq) const {
        const int slot0 = u.mt * 256 + wr * 64 + fr, cin = wc * 32 + 8 * fq;
        if (u.e == NEXP) {
            const int b = (u.mt * 256) >> 13, col0 = u.pn * 256 + cin;
#pragma unroll
            for (int bj = 0; bj < 2; ++bj) { const f32x4 ga = *(const f32x4*)(g2 + b * 6144 + col0 + bj * 128), gb = *(const f32x4*)(g2 + b * 6144 + col0 + bj * 128 + 4);
#pragma unroll
                for (int ai = 0; ai < 2; ++ai)
#pragma unroll
                    for (int m = 0; m < 4; ++m) { float* p = out + (size_t)(slot0 + ai * 128 + m * 16) * 1024 + col0 + bj * 128;
                        const f32x4 o0 = *(const f32x4*)p, o1 = *(const f32x4*)(p + 4);
                        *(f32x4*)p = o0 + ga * acc[ai][bj][m][0]; *(f32x4*)(p + 4) = o1 + gb * acc[ai][bj][m][1]; } }
        } else {
            bf16* base = YS + (size_t)u.off * 512 + (u.pn & 1) * 256 + cin;
#pragma unroll
            for (int ai = 0; ai < 2; ++ai)
#pragma unroll
                for (int m = 0; m < 4; ++m) { const int slot = slot0 + ai * 128 + m * 16;
                    if (slot < u.cnt) {
#pragma unroll
                        for (int bj = 0; bj < 2; ++bj) *(u32x4*)(base + (size_t)slot * 512 + bj * 128) = pack8(acc[ai][bj][m][0], acc[ai][bj][m][1]); } }
        }
    }
};

struct ExpertOrder {
    LAS const int* tab; const char* Abase; const char* Bexp; const char* Bsh; const char* Ash; const int* tokl; int mode, hh, G, c, nunits;
    __device__ __forceinline__ bool next(int i, Unit& u) const {
        const int L = i * G + c; if (L >= nunits) return false;
        int lo = 0, hi = NEXP + 1;
        while (hi - lo > 1) { const int mid = (lo + hi) >> 1; if (tab[260 + mid] <= L) lo = mid; else hi = mid; }
        const int e = lo, cnt = tab[e], nte = (cnt + 255) >> 8, r = L - tab[260 + e], j = r / nte, mt = r - j * nte;
        u.e = e; u.mt = mt; u.cnt = cnt; u.off = tab[520 + e]; u.pm = 0;
        if (mode == 0) { u.pn = j; u.A = Abase; u.B = (e == NEXP) ? Bsh + (size_t)j * 256 * 1024 * 2 : Bexp + ((size_t)e * 512 + j * 256) * 1024 * 2; }
        else { const int pn = 2 * hh + j; u.pn = pn;
            u.A = (e == NEXP) ? Ash + (size_t)mt * 256 * 512 : Abase + ((size_t)u.off + (size_t)mt * 256) * 512;
            u.B = (e == NEXP) ? Bsh + (size_t)pn * 256 * 256 * 2 : Bexp + ((size_t)e * 1024 + pn * 256) * 256 * 2; }
        return true;
    }
    __device__ __forceinline__ unsigned row_off(const Unit& u, int r) const {
        if (mode == 0) { const int slot = u.mt * 256 + r; int tok = slot; if (u.e != NEXP) tok = (slot < u.cnt) ? tokl[(size_t)u.e * T + slot] : 0; return (unsigned)tok * 2048u; }
        return (unsigned)r * 512u;
    }
};

#define XB_TMO      128
#define XB_XCNT(j)  (256  + 64 * (j))
#define XB_XSUB(j)  (1280 + 64 * (j))
#define XB_XGEN(j)  (2304 + 64 * (j))
#define XB_TOP      3328
#define XB_TOPGEN   3392
#define XCD_BAR_WORDS 3456
#define XB_SPIN_CAP (1u << 22)
__device__ __forceinline__ unsigned xb_ld(unsigned* p)              { return __hip_atomic_load(p, __ATOMIC_RELAXED, __HIP_MEMORY_SCOPE_AGENT); }
__device__ __forceinline__ unsigned xb_add(unsigned* p, unsigned v) { return __hip_atomic_fetch_add(p, v, __ATOMIC_RELAXED, __HIP_MEMORY_SCOPE_AGENT); }
__device__ __forceinline__ unsigned xb_xcc_id() { return (unsigned)__builtin_amdgcn_s_getreg((3 << 11) | 20) & 0xFu; }
#define XB_SPIN(cond, bar) do { unsigned _sp = 0; while (cond) { __builtin_amdgcn_s_sleep(1); \
    if ((++_sp & 255u) == 0u) { if (xb_ld(&(bar)[XB_TMO])) break; if (_sp > XB_SPIN_CAP) { atomicAdd(&(bar)[XB_TMO], 1u); break; } } } } while (0)
struct XcdBarrier { unsigned* bar; unsigned x; volatile LAS unsigned* st; };
__device__ __forceinline__ XcdBarrier xcd_barrier_post(unsigned* bar, volatile LAS unsigned* st) {
    XcdBarrier b; b.bar = bar; b.x = xb_xcc_id(); b.st = st;
    if (threadIdx.x == 0) (void)xb_add(&bar[XB_XCNT(b.x)], 1u);
    return b;
}
__device__ __forceinline__ void xcd_barrier_complete(unsigned* bar, unsigned x, unsigned& nloc, unsigned& nx) {
    const unsigned G = gridDim.x * gridDim.y * gridDim.z;
    unsigned sum, cnt, mine, sp = 0u;
    for (;;) {
        sum = 0u; cnt = 0u; mine = 0u;
#pragma unroll
        for (unsigned j = 0; j < 16; ++j) { const unsigned c = xb_ld(&bar[XB_XCNT(j)]); sum += c; cnt += (c > 0u) ? 1u : 0u; mine = (j == x) ? c : mine; }
        if (sum == G) break;
        __builtin_amdgcn_s_sleep(1);
        if ((++sp & 255u) == 0u) { if (xb_ld(&bar[XB_TMO])) break; if (sp > XB_SPIN_CAP) { atomicAdd(&bar[XB_TMO], 1u); break; } }
    }
    nloc = mine > 0u ? mine : 1u; nx = cnt > 0u ? cnt : 1u;
}
__device__ __forceinline__ void xcd_barrier(const XcdBarrier& b) {
    asm volatile("s_waitcnt vmcnt(0)" ::: "memory");
    __syncthreads();
    if (threadIdx.x == 0) {
        unsigned* bar = b.bar;
        __builtin_amdgcn_s_waitcnt(0);
        unsigned nloc = b.st[0], nx = b.st[1];
        if (nloc == 0u) { xcd_barrier_complete(bar, b.x, nloc, nx); b.st[0] = nloc; b.st[1] = nx; }
        const unsigned old = xb_add(&bar[XB_XSUB(b.x)], 1u);
        const unsigned gen = old / nloc;
        if (old + 1u == (gen + 1u) * nloc) {
            __builtin_amdgcn_fence(__ATOMIC_RELEASE, "agent");
            asm volatile("s_waitcnt vmcnt(0)" ::: "memory");
            const unsigned og = xb_add(&bar[XB_TOP], 1u);
            const unsigned tg = og / nx;
            if (og + 1u == (tg + 1u) * nx) xb_add(&bar[XB_TOPGEN], 1u);
            else XB_SPIN(xb_ld(&bar[XB_TOPGEN]) == tg, bar);
            __builtin_amdgcn_fence(__ATOMIC_ACQUIRE, "agent");
            xb_add(&bar[XB_XGEN(b.x)], 1u);
            asm volatile("s_waitcnt vmcnt(0)" ::: "memory");
        } else {
            XB_SPIN(xb_ld(&bar[XB_XGEN(b.x)]) == gen, bar);
            __builtin_amdgcn_fence(__ATOMIC_ACQUIRE, "agent");
            asm volatile("s_waitcnt vmcnt(0)" ::: "memory");
        }
    }
    __syncthreads();
}
struct Args { const float* in[31]; float* out; unsigned char* ws; int ph_lo, ph_hi, li, pad; };
struct Frame {
    LAS unsigned char* lds;
    volatile LAS unsigned* MISC;
    gu32* ctl;
    int tid, lane, wave, vcu, G;
    unsigned char* ws;
    float* out;
};
#define AIN args.in
enum { I_X = 0, I_C, I_WADA, I_BADA, I_N1G, I_WIN, I_BIN, I_CONVW, I_CONVB, I_LNG, I_LNB, I_WCO, I_BCO, I_PEK, I_W1K, I_W2K, I_PEV, I_W1V, I_W2V, I_WNSA, I_WOUT, I_N2G, I_WR, I_RB, I_SHG, I_SHU, I_SHD, I_WG, I_WU, I_WDN, I_FG };

__device__ __forceinline__ void xpose_item(const float* W, int ldw, int ncols, bf16* WT, int K, LAS float* scr, int kb, int nb, int lane) {
    const int k0 = 64 * kb, n0 = 32 * nb, c4 = 4 * (lane & 7), rg = lane >> 3; const bool nv = (n0 + c4) < ncols;
    f32x4 v[8];
#pragma unroll
    for (int i = 0; i < 8; ++i) v[i] = nv ? *(const f32x4*)(W + (size_t)(k0 + 8 * i + rg) * ldw + n0 + c4) : (f32x4){0.f, 0.f, 0.f, 0.f};
#pragma unroll
    for (int i = 0; i < 8; ++i) { LAS float* p = scr + (8 * i + rg) * 33 + c4; p[0] = v[i].x; p[1] = v[i].y; p[2] = v[i].z; p[3] = v[i].w; }
    LDS_WAIT(); asm volatile("" ::: "memory");
    const int c = lane & 7;
#pragma unroll
    for (int j = 0; j < 4; ++j) { const int n = (lane >> 3) + 8 * j; const LAS float* s = scr + (8 * c) * 33 + n;
        u32x4 o; o.x = pk2(s[0 * 33], s[1 * 33]); o.y = pk2(s[2 * 33], s[3 * 33]); o.z = pk2(s[4 * 33], s[5 * 33]); o.w = pk2(s[6 * 33], s[7 * 33]);
        *(GAS u32x4*)(WT + (size_t)(n0 + n) * K + k0 + 8 * c) = o; }
    LDS_WAIT(); asm volatile("" ::: "memory");
}
#define XSEC(Wp, ldw, ncols, WTp, K, nbl) do { const int _n = ((K) / 64) * (nbl); if (r < _n) { xpose_item((Wp), (ldw), (ncols), (WTp), (K), scr, r / (nbl), r % (nbl), F.lane); return; } r -= _n; } while (0)

__device__ __forceinline__ void p0_small_item(Frame& F, const Args& args, LAS float* scr, int r) {
    bf16* WIN = (bf16*)(F.ws + WS_WIN);
    const float* w_in = AIN[I_WIN];
#pragma unroll 1
    for (int p = 0; p < 4; ++p) { XSEC(w_in + 128 * p, NIN, 128, WIN + (size_t)(256 * p) * 1024, 1024, 4); }
#pragma unroll 1
    for (int p = 0; p < 4; ++p) { XSEC(w_in + 512 + 128 * p, NIN, 128, WIN + (size_t)(256 * p + 128) * 1024, 1024, 4); }
    XSEC(w_in + 1024, NIN, 2560, WIN + (size_t)1024 * 1024, 1024, 80);
    XSEC(w_in + 3584, NIN, 48, WIN + (size_t)3584 * 1024, 1024, 8);
    XSEC(w_in + 3632, NIN, 2048, WIN + (size_t)3840 * 1024, 1024, 64);
    XSEC(AIN[I_WCO], 1024, 1024, (bf16*)(F.ws + WS_WC), 512, 32);
    XSEC(AIN[I_WNSA], 1024, 1024, (bf16*)(F.ws + WS_WN), 1024, 32);
    XSEC(AIN[I_WOUT], 1024, 1024, (bf16*)(F.ws + WS_WO), 1024, 32);
    XSEC(AIN[I_WR], 256, 256, (bf16*)(F.ws + WS_WR), 1024, 8);
#pragma unroll 1
    for (int p = 0; p < 2; ++p) { XSEC(AIN[I_SHG] + 128 * p, 256, 128, (bf16*)(F.ws + WS_WSHGU) + (size_t)(256 * p) * 1024, 1024, 4); }
#pragma unroll 1
    for (int p = 0; p < 2; ++p) { XSEC(AIN[I_SHU] + 128 * p, 256, 128, (bf16*)(F.ws + WS_WSHGU) + (size_t)(256 * p + 128) * 1024, 1024, 4); }
    XSEC(AIN[I_SHD], 1024, 1024, (bf16*)(F.ws + WS_WSHD), 256, 32);
    XSEC(AIN[I_W1K], 128, 128, (bf16*)(F.ws + WS_CW1), 2048, 4);
    XSEC(AIN[I_W1V], 128, 128, (bf16*)(F.ws + WS_CW1) + (size_t)128 * 2048, 2048, 4);
    XSEC(AIN[I_W2K], 64, 64, (bf16*)(F.ws + WS_CW2), 128, 2);
    XSEC(AIN[I_W2V], 64, 64, (bf16*)(F.ws + WS_CW2) + 64 * 128, 128, 2);
}
constexpr int P0_SMALL_ITEMS = 8 * 64 + 1280 + 128 + 1024 + 256 + 512 + 512 + 128 + 4 * 64 + 128 + 128 + 128 + 4 + 4;
__device__ __forceinline__ void p0_expert_item(Frame& F, const Args& args, LAS float* scr, int it) {
    const int e = it / 384; int r = it - e * 384;
    bf16* WGU = (bf16*)(F.ws + WS_WGU) + (size_t)e * 512 * 1024;
    const float* wg = AIN[I_WG] + (size_t)e * 1024 * 256; const float* wu = AIN[I_WU] + (size_t)e * 1024 * 256;
#pragma unroll 1
    for (int p = 0; p < 2; ++p) { XSEC(wg + 128 * p, 256, 128, WGU + (size_t)(256 * p) * 1024, 1024, 4); }
#pragma unroll 1
    for (int p = 0; p < 2; ++p) { XSEC(wu + 128 * p, 256, 128, WGU + (size_t)(256 * p + 128) * 1024, 1024, 4); }
    XSEC(AIN[I_WDN] + (size_t)e * 256 * 1024, 1024, 1024, (bf16*)(F.ws + WS_WD) + (size_t)e * 1024 * 256, 256, 32);
}
__device__ __forceinline__ void p0_mod_item(Frame& F, const Args& args, int it) {
    const int kc = it / 96, nc = it - kc * 96;
    const float* W = AIN[I_WADA] + (size_t)(128 * kc) * 6144 + 64 * nc + F.lane; const float* c = AIN[I_C] + 128 * kc;
    float a0 = 0.f, a1 = 0.f, a2 = 0.f, a3 = 0.f;
#pragma unroll 8
    for (int k = 0; k < 128; ++k) { const float w = W[(size_t)k * 6144];
        const float c0 = c[k], c1 = c[1024 + k], c2 = c[2048 + k], c3 = c[3072 + k];
        a0 += c0 * sigmoidf_(c0) * w; a1 += c1 * sigmoidf_(c1) * w; a2 += c2 * sigmoidf_(c2) * w; a3 += c3 * sigmoidf_(c3) * w; }
    float* P = (float*)(F.ws + WS_MODP) + (size_t)kc * 4 * 6144 + 64 * nc + F.lane;
    P[0] = a0; P[6144] = a1; P[2 * 6144] = a2; P[3 * 6144] = a3;
}
__device__ __forceinline__ void p0_peb_item(Frame& F, const Args& args, int it) {
    const int which = it & 1, cc = (it >> 1) & 1, kc = it >> 2;
    const float* pe = AIN[which ? I_PEV : I_PEK] + 256 * kc; const float* w1 = AIN[which ? I_W1V : I_W1K] + (size_t)(256 * kc) * 128 + 64 * cc + F.lane;
    float a = 0.f;
#pragma unroll 8
    for (int k = 0; k < 256; ++k) a += pe[k] * w1[(size_t)k * 128];
    ((float*)(F.ws + WS_PEBP))[(kc * 2 + which) * 128 + 64 * cc + F.lane] = a;
}
__device__ __forceinline__ int binp_src(int d) {
    if (d < 1024) { const int p = d >> 8, o = d & 255; return (o < 128) ? 128 * p + o : 512 + 128 * p + (o - 128); }
    if (d < 3584) return d;
    if (d < 3840) return (d - 3584 < 48) ? d : -1;
    return 3632 + (d - 3840);
}
__device__ __forceinline__ void p0_prologue(Frame& F, const Args& args) {
    LAS float* scr = (LAS float*)(F.lds + RING_OFF + F.wave * 16384);
    const int gw = F.vcu * NWAVES + F.wave, NGW = F.G * NWAVES;
    constexpr int N_MOD = 768, N_PEB = 32, N_EXP = NEXP * 384;
    constexpr int NITEMS = N_MOD + N_PEB + P0_SMALL_ITEMS + N_EXP;
    for (int it = gw; it < NITEMS; it += NGW) {
        int r = it;
        if (r < N_MOD) { p0_mod_item(F, args, r); continue; } r -= N_MOD;
        if (r < N_PEB) { p0_peb_item(F, args, r); continue; } r -= N_PEB;
        if (r < P0_SMALL_ITEMS) { p0_small_item(F, args, scr, r); continue; } r -= P0_SMALL_ITEMS;
        p0_expert_item(F, args, scr, r);
    }
    float* binp = (float*)(F.ws + WS_BINP);
    for (int d = gw * 64 + F.lane; d < NINP; d += NGW * 64) { const int s = binp_src(d); binp[d] = (s >= 0) ? AIN[I_BIN][s] : 0.f; }
}

__device__ __forceinline__ float modsum(const Frame& F, const Args& args, int b, int j) {
    const float* P = (const float*)(F.ws + WS_MODP) + (size_t)b * 6144 + j; float s = AIN[I_BADA][j];
#pragma unroll
    for (int kc = 0; kc < 8; ++kc) s += P[(size_t)kc * 4 * 6144];
    return s;
}
template <bool FROM_PARTIALS>
__device__ __forceinline__ void norm_mod_rows(Frame& F, const Args& args, const float* src, bf16* dst, const float* gam, int shift_off, int scale_off) {
    const int gw = F.vcu * NWAVES + F.wave, NGW = F.G * NWAVES;
    for (int blk = gw; blk < T / 16; blk += NGW) {
        const int m0 = blk * 16, b = m0 >> 13;
        f32x4 av[4], sv[4];
#pragma unroll
        for (int j = 0; j < 4; ++j) { const int col = 4 * F.lane + 256 * j; const f32x4 g = *(const f32x4*)(gam + col); f32x4 sc, sh;
            if (FROM_PARTIALS) {
#pragma unroll
                for (int q = 0; q < 4; ++q) { sc[q] = modsum(F, args, b, scale_off + col + q); sh[q] = modsum(F, args, b, shift_off + col + q); }
            } else { const float* mf = (const float*)(F.ws + WS_MODF) + b * 6144; sc = *(const f32x4*)(mf + scale_off + col); sh = *(const f32x4*)(mf + shift_off + col); }
            av[j] = g * (sc + 1.0f); sv[j] = sh; }
#pragma unroll 2
        for (int i = 0; i < 16; ++i) {
            const GAS f32x4* xr = (const GAS f32x4*)(src + (size_t)(m0 + i) * 1024) + F.lane;
            f32x4 v[4]; float s = 0.f;
#pragma unroll
            for (int j = 0; j < 4; ++j) { v[j] = xr[64 * j]; s += (v[j].x * v[j].x + v[j].y * v[j].y) + (v[j].z * v[j].z + v[j].w * v[j].w); }
            const float rstd = 1.0f / sqrtf(wave_sum(s) * (1.0f / 1024.0f) + EPS);
            GAS u32x2* o8 = (GAS u32x2*)(dst + (size_t)(m0 + i) * 1024) + F.lane;
#pragma unroll
            for (int j = 0; j < 4; ++j) { const f32x4 y = v[j] * rstd * av[j] + sv[j]; u32x2 w; w.x = pk2(y.x, y.y); w.y = pk2(y.z, y.w); o8[64 * j] = w; }
        }
    }
}
__device__ __forceinline__ void finalize_mod(Frame& F, const Args& args) {
    const int gw = F.vcu * NWAVES + F.wave, NGW = F.G * NWAVES;
    for (int it = gw; it < 384; it += NGW) { const int b = it / 96, j = (it % 96) * 64 + F.lane; ((float*)(F.ws + WS_MODF))[b * 6144 + j] = modsum(F, args, b, j); }
    for (int it = gw; it < 388 && it >= 384; it += NGW) { const int idx = (it - 384) * 64 + F.lane; float s = 0.f;
#pragma unroll
        for (int kc = 0; kc < 8; ++kc) s += ((const float*)(F.ws + WS_PEBP))[kc * 256 + idx];
        ((float*)(F.ws + WS_PEBF))[idx] = s; }
}

__device__ __forceinline__ void conv_phase(Frame& F, const Args& args) {
    const bf16* U = (const bf16*)(F.ws + WS_U); bf16* CF = (bf16*)(F.ws + WS_CF);
    LAS float* cv = (LAS float*)(F.lds + RING_OFF);
    const int c = F.tid;
    float w[CONVK];
#pragma unroll
    for (int j = 0; j < CONVK; ++j) w[j] = AIN[I_CONVW][j * 512 + c];
    const float cb = AIN[I_CONVB][c];
    for (int it = F.vcu; it < T / 32; it += F.G) {
        const int m0 = it * 32, s0 = m0 & (SEQ - 1);
        float uv[62];
#pragma unroll
        for (int i = 0; i < 62; ++i) { const int s = s0 - 30 + i; uv[i] = (s >= 0) ? bf2f(U[(size_t)(m0 - 30 + i) * 512 + c]) : 0.f; }
#pragma unroll
        for (int tt = 0; tt < 32; ++tt) { float a = cb;
#pragma unroll
            for (int j = 0; j < CONVK; ++j) a += w[j] * uv[tt + j];
            cv[tt * 512 + c] = a; }
        __syncthreads();
#pragma unroll
        for (int q = 0; q < 4; ++q) { const int tt = F.wave * 4 + q;
            const f32x4 v0 = *(const LAS f32x4*)(cv + tt * 512 + 8 * F.lane), v1 = *(const LAS f32x4*)(cv + tt * 512 + 8 * F.lane + 4);
            const float mu = wave_sum((v0.x + v0.y) + (v0.z + v0.w) + (v1.x + v1.y) + (v1.z + v1.w)) * (1.0f / 512.0f);
            const f32x4 d0 = v0 - mu, d1 = v1 - mu;
            const float var = wave_sum((d0.x * d0.x + d0.y * d0.y) + (d0.z * d0.z + d0.w * d0.w) + (d1.x * d1.x + d1.y * d1.y) + (d1.z * d1.z + d1.w * d1.w)) * (1.0f / 512.0f);
            const float rstd = 1.0f / sqrtf(var + EPS);
            const f32x4 g0 = *(const f32x4*)(AIN[I_LNG] + 8 * F.lane), g1 = *(const f32x4*)(AIN[I_LNG] + 8 * F.lane + 4), b0 = *(const f32x4*)(AIN[I_LNB] + 8 * F.lane), b1 = *(const f32x4*)(AIN[I_LNB] + 8 * F.lane + 4);
            f32x4 y0 = d0 * rstd * g0 + b0, y1 = d1 * rstd * g1 + b1;
            y0 = y0 * sig4(y0); y1 = y1 * sig4(y1);
            u32x4 o; o.x = pk2(y0.x, y0.y); o.y = pk2(y0.z, y0.w); o.z = pk2(y1.x, y1.y); o.w = pk2(y1.z, y1.w);
            *(GAS u32x4*)(CF + (size_t)(m0 + tt) * 512 + 8 * F.lane) = o; }
        __syncthreads();
    }
}

__device__ __forceinline__ int perm16(int s) { return (s & ~12) | ((s & 4) << 1) | ((s & 8) >> 1); }
__device__ __forceinline__ float gelu_tanh(float x) { const float u2 = 1.5957691216057308f * (x + 0.044715f * x * x * x); return x * sigmoidf_(u2); }
__device__ __forceinline__ void compress_item(Frame& F, int it) {
    const int which = it & 1, rt = (it >> 1) & 15, bg = it >> 5, b = bg >> 2, g = bg & 3;
    const int lane = F.lane, c32 = lane & 31, hi = lane >> 5;
    const bf16* Z = (const bf16*)(F.ws + WS_KV + (size_t)which * KV_STRIDE);
    const bf16* W1T = (const bf16*)(F.ws + WS_CW1) + (size_t)which * 128 * 2048;
    const bf16* W2T = (const bf16*)(F.ws + WS_CW2) + which * 64 * 128;
    const float* peb = (const float*)(F.ws + WS_PEBF) + which * 128;
    int n = rt * 32 + c32; const bool nvalid = n <= 510; if (!nvalid) n = 510;
    const bf16* zp = Z + ((size_t)(b * SEQ + 16 * n)) * 256 + g * 64 + 8 * hi;
    const bf16* wp = W1T + (size_t)c32 * 2048 + 8 * hi;
    f32x16 acc[4];
#pragma unroll
    for (int ct = 0; ct < 4; ++ct) acc[ct] = (f32x16){0.f};
#pragma unroll 2
    for (int ks = 0; ks < 128; ++ks) {
        const bf16x8 bz = *(const bf16x8*)(zp + (size_t)(ks >> 2) * 256 + (ks & 3) * 16);
#pragma unroll
        for (int ct = 0; ct < 4; ++ct) { const bf16x8 aw = *(const bf16x8*)(wp + (size_t)ct * 32 * 2048 + ks * 16); acc[ct] = __builtin_amdgcn_mfma_f32_32x32x16_bf16(aw, bz, acc[ct], 0, 0, 0); }
    }
    f32x16 o[2]; o[0] = (f32x16){0.f}; o[1] = (f32x16){0.f};
#pragma unroll
    for (int ct = 0; ct < 4; ++ct) {
#pragma unroll
        for (int r = 0; r < 16; ++r) { const int cidx = 32 * ct + (r & 3) + 8 * (r >> 2) + 4 * hi; acc[ct][r] = gelu_tanh(acc[ct][r] + peb[cidx]); }
#pragma unroll
        for (int s = 0; s < 2; ++s) {
            u32x4 pw; pw.x = cvt_pk_bf16(acc[ct][8 * s + 0], acc[ct][8 * s + 1]); pw.y = cvt_pk_bf16(acc[ct][8 * s + 2], acc[ct][8 * s + 3]); pw.z = cvt_pk_bf16(acc[ct][8 * s + 4], acc[ct][8 * s + 5]); pw.w = cvt_pk_bf16(acc[ct][8 * s + 6], acc[ct][8 * s + 7]);
            const bf16x8 pb = __builtin_bit_cast(bf16x8, pw);
#pragma unroll
            for (int mt = 0; mt < 2; ++mt) { const bf16* ap = W2T + (size_t)(32 * mt + c32) * 128 + 32 * ct + 16 * s + 4 * hi;
                const u32x2 lo = *(const u32x2*)ap, hh = *(const u32x2*)(ap + 8); u32x4 aw; aw.x = lo.x; aw.y = lo.y; aw.z = hh.x; aw.w = hh.y;
                o[mt] = __builtin_amdgcn_mfma_f32_32x32x16_bf16(__builtin_bit_cast(bf16x8, aw), pb, o[mt], 0, 0, 0); }
        }
    }
    if (nvalid) {
        if (which == 0) { bf16* kc = (bf16*)(F.ws + WS_KC) + ((size_t)bg * 512 + n) * 64;
#pragma unroll
            for (int mt = 0; mt < 2; ++mt)
#pragma unroll
                for (int q4 = 0; q4 < 4; ++q4) { u32x2 w; w.x = pk2(o[mt][4 * q4], o[mt][4 * q4 + 1]); w.y = pk2(o[mt][4 * q4 + 2], o[mt][4 * q4 + 3]); *(u32x2*)(kc + 32 * mt + 8 * q4 + 4 * hi) = w; }
        } else { bf16* vc = (bf16*)(F.ws + WS_VCT) + (size_t)bg * 64 * 512 + perm16(n);
#pragma unroll
            for (int mt = 0; mt < 2; ++mt)
#pragma unroll
                for (int r = 0; r < 16; ++r) { const int d = 32 * mt + (r & 3) + 8 * (r >> 2) + 4 * hi; vc[(size_t)d * 512] = (bf16)f2bf(o[mt][r]); }
        }
    }
}
__device__ __forceinline__ void vtrans_item(Frame& F, int it) {
    const int which = it & 1, tile = (it >> 1) & 127, bg = it >> 8, b = bg >> 2, g = bg & 3, lane = F.lane;
    const bf16* V = (const bf16*)(F.ws + WS_KV + (size_t)(which ? 5 : 3) * KV_STRIDE) + ((size_t)(b * SEQ + tile * 64)) * 256 + g * 64;
    bf16* VT = (bf16*)(F.ws + (which ? WS_VWT : WS_VST)) + (size_t)bg * 64 * SEQ + tile * 64;
    LAS unsigned* scr = (LAS unsigned*)(F.lds + RING_OFF + F.wave * 16384);
#pragma unroll
    for (int i = 0; i < 8; ++i) { const int row = 8 * i + (lane >> 3), ch = lane & 7; const u32x4 v = *(const u32x4*)(V + (size_t)row * 256 + 8 * ch);
        LAS unsigned* p = scr + row * 33 + 4 * ch; p[0] = v.x; p[1] = v.y; p[2] = v.z; p[3] = v.w; }
    LDS_WAIT(); asm volatile("" ::: "memory");
#pragma unroll
    for (int i = 0; i < 8; ++i) { const int d = 8 * i + (lane >> 3), ch = lane & 7; unsigned e[8];
#pragma unroll
        for (int j = 0; j < 8; ++j) { const int tok = perm16(8 * ch + j); const unsigned wv = scr[tok * 33 + (d >> 1)]; e[j] = (d & 1) ? (wv >> 16) : (wv & 0xffffu); }
        u32x4 o; o.x = e[0] | (e[1] << 16); o.y = e[2] | (e[3] << 16); o.z = e[4] | (e[5] << 16); o.w = e[6] | (e[7] << 16);
        *(u32x4*)(VT + (size_t)d * SEQ + 8 * ch) = o; }
    LDS_WAIT(); asm volatile("" ::: "memory");
}
__device__ __forceinline__ void p3_phase(Frame& F, const Args& args) {
    conv_phase(F, args);
    const int gw = F.vcu * NWAVES + F.wave, NGW = F.G * NWAVES;
    if ((gw & 3) == 0 && (gw >> 2) < 512) compress_item(F, gw >> 2);
    for (int it = gw; it < 4096; it += NGW) vtrans_item(F, it);
}

__device__ __forceinline__ void routing_phase(Frame& F, const Args& args) {
    const float* LOG = (const float*)(F.ws + WS_LOG); const float* rb = AIN[I_RB];
    int* RTE = (int*)(F.ws + WS_RTE); int* RTS = (int*)(F.ws + WS_RTS); float* RTW = (float*)(F.ws + WS_RTW); int* TOKL = (int*)(F.ws + WS_TOKL);
    unsigned* CNT = (unsigned*)(F.ctl + CW_CNT);
    const int gw = F.vcu * NWAVES + F.wave, NGW = F.G * NWAVES, lane = F.lane;
    const f32x4 bias = *(const f32x4*)(rb + 4 * lane);
    for (int t = gw; t < T; t += NGW) {
#ifdef ROUTER_F32
        f32x4 lg = (f32x4){0.f, 0.f, 0.f, 0.f};
        { LAS float* hrow = (LAS float*)(F.lds + RING_OFF + F.wave * 4096);
          const int b = t >> 13; const float* mf = (const float*)(F.ws + WS_MODF) + b * 6144;
          const GAS f32x4* xr = (const GAS f32x4*)(F.out + (size_t)t * 1024) + lane;
          f32x4 v[4]; float s = 0.f;
#pragma unroll
          for (int j = 0; j < 4; ++j) { v[j] = xr[64 * j]; s += (v[j].x * v[j].x + v[j].y * v[j].y) + (v[j].z * v[j].z + v[j].w * v[j].w); }
          const float rstd = 1.0f / sqrtf(wave_sum(s) * (1.0f / 1024.0f) + EPS);
#pragma unroll
          for (int j = 0; j < 4; ++j) { const int col = 4 * lane + 256 * j; const f32x4 g = *(const f32x4*)(AIN[I_N2G] + col), sc = *(const f32x4*)(mf + 4096 + col), sh = *(const f32x4*)(mf + 3072 + col);
              *(LAS f32x4*)(hrow + col) = v[j] * rstd * g * (sc + 1.0f) + sh; }
          LDS_WAIT(); asm volatile("" ::: "memory");
          const float* wr = AIN[I_WR] + 4 * lane;
#pragma unroll 8
          for (int k = 0; k < 1024; ++k) { const f32x4 w = *(const f32x4*)(wr + (size_t)k * 256); lg += w * hrow[k]; }
          LDS_WAIT(); asm volatile("" ::: "memory"); }
#else
        const f32x4 lg = *(const f32x4*)(LOG + (size_t)t * 256 + 4 * lane);
#endif
        float sc[4], sf[4];
#pragma unroll
        for (int q = 0; q < 4; ++q) { sc[q] = sigmoidf_(lg[q]); sf[q] = sc[q] + bias[q]; }
        float a1 = fmaxf(sf[0], sf[1]), a2 = fminf(sf[0], sf[1]);
        { const float b1 = fmaxf(sf[2], sf[3]), b2 = fminf(sf[2], sf[3]); const float n1 = fmaxf(a1, b1), n2 = fmaxf(fminf(a1, b1), fmaxf(a2, b2)); a1 = n1; a2 = n2; }
#pragma unroll
        for (int o = 1; o < 8; o <<= 1) { const float b1 = __shfl_xor(a1, o), b2 = __shfl_xor(a2, o); const float n1 = fmaxf(a1, b1), n2 = fmaxf(fminf(a1, b1), fmaxf(a2, b2)); a1 = n1; a2 = n2; }
        const float gs = a1 + a2; const int myg = lane >> 3;
        int rank = 0;
#pragma unroll
        for (int gq = 0; gq < 8; ++gq) { const float og = __shfl(gs, 8 * gq); rank += (og > gs || (og == gs && gq < myg)) ? 1 : 0; }
        const bool gsel = rank < 4;
        float v[4];
#pragma unroll
        for (int q = 0; q < 4; ++q) v[q] = gsel ? sf[q] : -1e30f;
        int eid[TOPK]; float ew[TOPK]; float wsum = 0.f;
#pragma unroll
        for (int r = 0; r < TOPK; ++r) {
            float bv = v[0]; int bi = 0;
#pragma unroll
            for (int q = 1; q < 4; ++q) if (v[q] > bv) { bv = v[q]; bi = q; }
            const float mx = wave_max(bv);
            const unsigned long long bal = __ballot(bv == mx);
            const int wl = __ffsll((long long)bal) - 1;
            const int wbi = __shfl(bi, wl);
            float wsc = sc[0];
#pragma unroll
            for (int q = 1; q < 4; ++q) wsc = (bi == q) ? sc[q] : wsc;
            const float sel_sc = __shfl(wsc, wl);
            eid[r] = 4 * wl + wbi; ew[r] = sel_sc; wsum += sel_sc;
            if (lane == wl) {
#pragma unroll
                for (int q = 0; q < 4; ++q) if (q == bi) v[q] = -3e38f;
            }
        }
        const float inv = 2.5f / wsum;
        if (lane < TOPK) {
            int e = eid[0]; float w = ew[0];
#pragma unroll
            for (int r = 1; r < TOPK; ++r) if (lane == r) { e = eid[r]; w = ew[r]; }
            const unsigned slot = __hip_atomic_fetch_add(CNT + e, 1u, RLX_AGENT);
            RTE[(size_t)t * 8 + lane] = e; RTS[(size_t)t * 8 + lane] = (int)slot; RTW[(size_t)t * 8 + lane] = w * inv;
            TOKL[(size_t)e * T + slot] = t;
        }
    }
}
__device__ __forceinline__ void build_tables(Frame& F) {
    LAS int* tab = (LAS int*)(F.lds + TAB_OFF);
    __syncthreads();
    if (F.tid < NEXP) tab[F.tid] = (int)__hip_atomic_load((unsigned*)(F.ctl + CW_CNT) + F.tid, RLX_AGENT);
    if (F.tid == NEXP) tab[NEXP] = T;
    __syncthreads();
    if (F.tid == 0) { int us = 0, off = 0;
        for (int e = 0; e <= NEXP; ++e) { const int c = tab[e]; tab[260 + e] = us; tab[520 + e] = off; us += 2 * ((c + 255) >> 8); if (e < NEXP) off += c; }
        tab[260 + NEXP + 1] = us; tab[520 + NEXP] = 0; }
    __syncthreads();
}
__device__ __forceinline__ void combine_phase(Frame& F, const Args& args, int hh) {
    const LAS int* tab = (const LAS int*)(F.lds + TAB_OFF);
    const int* RTE = (const int*)(F.ws + WS_RTE); const int* RTS = (const int*)(F.ws + WS_RTS); const float* RTW = (const float*)(F.ws + WS_RTW);
    const bf16* YS = (const bf16*)(F.ws + WS_YS);
    const int gw = F.vcu * NWAVES + F.wave, NGW = F.G * NWAVES, lane = F.lane;
    const float* fg = AIN[I_FG];
    for (int t = gw; t < T; t += NGW) {
        const int b = t >> 13;
        int pos = 0; float w = 0.f;
        if (lane < TOPK) { const int e = RTE[(size_t)t * 8 + lane]; pos = tab[520 + e] + RTS[(size_t)t * 8 + lane]; w = RTW[(size_t)t * 8 + lane]; }
        f32x4 y0 = (f32x4){0.f, 0.f, 0.f, 0.f}, y1 = y0;
#pragma unroll
        for (int k = 0; k < TOPK; ++k) { const int pk = __shfl(pos, k); const float wk = __shfl(w, k);
            f32x4 a, c; unpack8(*(const u32x4*)(YS + (size_t)pk * 512 + 8 * lane), a, c); y0 += a * wk; y1 += c * wk; }
        const float* g2 = (const float*)(F.ws + WS_MODF) + b * 6144 + 5120 + 512 * hh + 8 * lane;
        float* op = F.out + (size_t)t * 1024 + 512 * hh + 8 * lane;
        f32x4 r0 = *(const f32x4*)op + *(const f32x4*)g2 * y0, r1 = *(const f32x4*)(op + 4) + *(const f32x4*)(g2 + 4) * y1;
        if (hh == 0) { *(f32x4*)op = r0; *(f32x4*)(op + 4) = r1; }
        else {
            float* lp = F.out + (size_t)t * 1024 + 8 * lane;
            f32x4 l0 = *(const f32x4*)lp, l1 = *(const f32x4*)(lp + 4);
            float s = (l0.x * l0.x + l0.y * l0.y) + (l0.z * l0.z + l0.w * l0.w) + (l1.x * l1.x + l1.y * l1.y) + (l1.z * l1.z + l1.w * l1.w);
            s += (r0.x * r0.x + r0.y * r0.y) + (r0.z * r0.z + r0.w * r0.w) + (r1.x * r1.x + r1.y * r1.y) + (r1.z * r1.z + r1.w * r1.w);
            float rstd = 1.0f / sqrtf(wave_sum(s) * (1.0f / 1024.0f) + EPS);
#ifdef SELFCHECK
            { const float ce = __hip_atomic_load((float*)(F.ctl + 40000), RLX_AGENT), cn = __hip_atomic_load((float*)(F.ctl + 40000) + 1, RLX_AGENT); rstd *= 1.0f + CHK_K * sqrtf(ce / fmaxf(cn, 1e-30f)); }
#endif
            *(f32x4*)lp = l0 * rstd * *(const f32x4*)(fg + 8 * lane); *(f32x4*)(lp + 4) = l1 * rstd * *(const f32x4*)(fg + 8 * lane + 4);
            *(f32x4*)op = r0 * rstd * *(const f32x4*)(fg + 512 + 8 * lane); *(f32x4*)(op + 4) = r1 * rstd * *(const f32x4*)(fg + 512 + 8 * lane + 4);
        }
    }
}
namespace att {
constexpr int TSZ = 8192;
constexpr int NBUF = 4, BUFB = 2 * TSZ;
constexpr int L_BUF = 0;
constexpr int L_IMP = NBUF * BUFB;
constexpr int L_SEL = L_IMP + 32768;
constexpr int L_END = L_SEL + 1024;
static_assert(L_END <= RING_BYTES, "attention LDS");
constexpr float L2E = 1.4426950408889634f;
enum { M_WIN = 0, M_SEL = 1, M_CMP1 = 2, M_CMP2 = 3 };

__device__ __forceinline__ float qxor1(float v) { return __builtin_bit_cast(float, __builtin_amdgcn_update_dpp(0, __builtin_bit_cast(int, v), 0xB1, 0xF, 0xF, false)); }
__device__ __forceinline__ float qxor2(float v) { return __builtin_bit_cast(float, __builtin_amdgcn_update_dpp(0, __builtin_bit_cast(int, v), 0x4E, 0xF, 0xF, false)); }
__device__ __forceinline__ float halfsum(float v) { const unsigned a = __builtin_bit_cast(unsigned, v); auto rr = __builtin_amdgcn_permlane32_swap(a, a, false, false); const unsigned r0 = rr[0], r1 = rr[1]; return __builtin_bit_cast(float, r0) + __builtin_bit_cast(float, r1); }
__device__ __forceinline__ float halfmax(float v) { const unsigned a = __builtin_bit_cast(unsigned, v); auto rr = __builtin_amdgcn_permlane32_swap(a, a, false, false); const unsigned r0 = rr[0], r1 = rr[1]; return fmaxf(__builtin_bit_cast(float, r0), __builtin_bit_cast(float, r1)); }

struct State { float m, l; f32x16 o0, o1; };

template <int MODE>
__device__ __forceinline__ void run_branch(LAS unsigned char* lds, const int nt, const int tile0, const bf16* kp, const size_t kst, const bf16* vp, const size_t vst,
                                           const bf16x8 (&qf)[4], State& st, const int tokl, const int ci, const int nvis, const unsigned sw0, const unsigned sw1, const unsigned sw2, const unsigned sw3, const float cm, const float cinv,
                                           const int tid, const int lane, const int wave) {
    const int c32 = lane & 31, hi = lane >> 5;
    const unsigned dmaw = (unsigned)wave * 1024u;
    const int xs = (hi ^ ((c32 >> 1) & 7)) * 16;
#define ATT_DMA(t) do { LAS unsigned char* _d = lds + L_BUF + ((t) & (NBUF - 1)) * BUFB + dmaw; \
        __builtin_amdgcn_global_load_lds((const unsigned*)(kp + (size_t)(t) * kst), (LAS unsigned*)_d, 16, 0, 0); \
        __builtin_amdgcn_global_load_lds((const unsigned*)(vp + (size_t)(t) * vst), (LAS unsigned*)(_d + TSZ), 16, 0, 0); } while (0)
    ATT_DMA(0); if (nt > 1) ATT_DMA(1); if (nt > 2) ATT_DMA(2);
    for (int i = 0; i < nt; ++i) {
        LAS unsigned char* cur = lds + L_BUF + (i & (NBUF - 1)) * BUFB;
        { const int rem = nt - 1 - i; if (rem >= 2) asm volatile("s_waitcnt vmcnt(4)" ::: "memory"); else if (rem == 1) asm volatile("s_waitcnt vmcnt(2)" ::: "memory"); else asm volatile("s_waitcnt vmcnt(0)" ::: "memory"); }
        __builtin_amdgcn_s_barrier(); asm volatile("" ::: "memory");
        if (i + 3 < nt) ATT_DMA(i + 3);
        const int tix = tile0 + i;
        bool lanesel = true; int klo = -1, khi = 64;
        bool need_mask = false, skip = false;
        if (MODE == M_WIN) { if (tix == 0) { klo = tokl; need_mask = true; } if (tix == 8) { khi = tokl; need_mask = true; } }
        if (MODE == M_SEL) { { const unsigned wsel = (tix < 32) ? sw0 : (tix < 64) ? sw1 : (tix < 96) ? sw2 : sw3; lanesel = (wsel >> (tix & 31)) & 1u; } if (tix == ci) { khi = tokl; need_mask = true; } skip = !__any(lanesel); }
        if (MODE == M_CMP1 || MODE == M_CMP2) { khi = nvis - 64 * tix - 1; need_mask = (64 * tix + 63 >= __builtin_amdgcn_readfirstlane(nvis)); }
        if (!skip) {
            f32x16 s0 = (f32x16){0.f}, s1 = (f32x16){0.f};
            { LAS const unsigned char* p = cur + c32 * 128;
#pragma unroll
              for (int ks = 0; ks < 4; ++ks) { const bf16x8 a0 = *(LAS const bf16x8*)(p + ((ks * 32) ^ xs)), a1 = *(LAS const bf16x8*)(p + 32 * 128 + ((ks * 32) ^ xs));
                  s0 = __builtin_amdgcn_mfma_f32_32x32x16_bf16(a0, qf[ks], s0, 0, 0, 0); s1 = __builtin_amdgcn_mfma_f32_32x32x16_bf16(a1, qf[ks], s1, 0, 0, 0); } }
            if (need_mask) {
#pragma unroll
                for (int r = 0; r < 16; ++r) { const int kl = (r & 3) + 8 * (r >> 2) + 4 * hi;
                    s0[r] = (kl > klo && kl <= khi) ? s0[r] : -1e30f;
                    s1[r] = (kl + 32 > klo && kl + 32 <= khi) ? s1[r] : -1e30f; }
            }
            if (MODE == M_CMP2) {
                const float mneg = -fmaxf(cm, -1e29f) * L2E;
#pragma unroll
                for (int r = 0; r < 16; ++r) { s0[r] = __builtin_amdgcn_exp2f(__builtin_fmaf(s0[r], L2E, mneg)) * cinv; s1[r] = __builtin_amdgcn_exp2f(__builtin_fmaf(s1[r], L2E, mneg)) * cinv; }
                LAS float* imp = (LAS float*)(lds + L_IMP) + tokl * 128;
                if (true) {
#pragma unroll
                    for (int x = 0; x < 8; ++x) { const f32x16& sv = (x >> 2) ? s1 : s0; const int q4 = x & 3;
                        float gsum = (sv[4 * q4] + sv[4 * q4 + 1]) + (sv[4 * q4 + 2] + sv[4 * q4 + 3]); gsum += qxor1(gsum); gsum += qxor2(gsum);
                        const int j = 16 * tix + 8 * (x >> 2) + 2 * q4 + hi; if ((c32 & 3) == 0) imp[j] += gsum; }
                    asm volatile("" ::: "memory");
#pragma unroll
                    for (int x = 0; x < 8; ++x) { const f32x16& sv = (x >> 2) ? s1 : s0; const int q4 = x & 3;
                        float lst = sv[4 * q4 + 3]; lst += qxor1(lst); lst += qxor2(lst);
                        const int j = 16 * tix + 8 * (x >> 2) + 2 * q4 + hi; if ((c32 & 3) == 0 && j + 1 < 128) imp[j + 1] += lst; }
                }
            } else {
                float mx = fmaxf(s0[0], s1[0]);
#pragma unroll
                for (int r = 1; r < 16; ++r) mx = fmaxf(mx, fmaxf(s0[r], s1[r]));
                if (MODE == M_SEL) mx = lanesel ? mx : -1e30f;
                mx = halfmax(mx);
                if (__any(mx > st.m + 8.0f)) {
                    const float mnew = fmaxf(st.m, mx), alpha = __builtin_amdgcn_exp2f((st.m - mnew) * L2E);
                    st.l *= alpha; st.m = mnew;
                    if (MODE != M_CMP1) {
#pragma unroll
                        for (int r = 0; r < 16; ++r) { st.o0[r] *= alpha; st.o1[r] *= alpha; }
                    }
                }
                float mneg = -fmaxf(st.m, -1e29f) * L2E;
                if (MODE == M_SEL) mneg = lanesel ? mneg : -1e30f;
                float rs = 0.f;
#pragma unroll
                for (int r = 0; r < 16; ++r) { s0[r] = __builtin_amdgcn_exp2f(__builtin_fmaf(s0[r], L2E, mneg)); s1[r] = __builtin_amdgcn_exp2f(__builtin_fmaf(s1[r], L2E, mneg)); rs += s0[r] + s1[r]; }
                st.l += rs;
            }
            if (MODE != M_CMP1) {
                LAS const unsigned char* p = cur + TSZ + c32 * 128;
#pragma unroll
                for (int sub = 0; sub < 2; ++sub)
#pragma unroll
                    for (int s = 0; s < 2; ++s) { const f32x16& sv = sub ? s1 : s0;
                        u32x4 pw; pw.x = cvt_pk_bf16(sv[8 * s + 0], sv[8 * s + 1]); pw.y = cvt_pk_bf16(sv[8 * s + 2], sv[8 * s + 3]); pw.z = cvt_pk_bf16(sv[8 * s + 4], sv[8 * s + 5]); pw.w = cvt_pk_bf16(sv[8 * s + 6], sv[8 * s + 7]);
                        const bf16x8 pb = __builtin_bit_cast(bf16x8, pw);
                        const bf16x8 a0 = *(LAS const bf16x8*)(p + (((2 * sub + s) * 32) ^ xs)), a1 = *(LAS const bf16x8*)(p + 32 * 128 + (((2 * sub + s) * 32) ^ xs));
                        st.o0 = __builtin_amdgcn_mfma_f32_32x32x16_bf16(a0, pb, st.o0, 0, 0, 0); st.o1 = __builtin_amdgcn_mfma_f32_32x32x16_bf16(a1, pb, st.o1, 0, 0, 0); }
            }
        }
    }
    asm volatile("s_waitcnt lgkmcnt(0)" ::: "memory"); __builtin_amdgcn_s_barrier(); asm volatile("" ::: "memory");
#undef ATT_DMA
}

template <bool ACC> __device__ __forceinline__ void o_update(bf16* op, const f32x16& o0, const f32x16& o1, float sc) {
#pragma unroll
    for (int q4 = 0; q4 < 4; ++q4) {
        f32x4 a = (f32x4){o0[4 * q4], o0[4 * q4 + 1], o0[4 * q4 + 2], o0[4 * q4 + 3]} * sc, b = (f32x4){o1[4 * q4], o1[4 * q4 + 1], o1[4 * q4 + 2], o1[4 * q4 + 3]} * sc;
        if (ACC) { const u32x2 pa = *(const u32x2*)(op + 8 * q4), pb = *(const u32x2*)(op + 32 + 8 * q4);
            a += (f32x4){bflo(pa.x), bfhi(pa.x), bflo(pa.y), bfhi(pa.y)}; b += (f32x4){bflo(pb.x), bfhi(pb.x), bflo(pb.y), bfhi(pb.y)}; }
        u32x2 w0, w1; w0.x = cvt_pk_bf16(a[0], a[1]); w0.y = cvt_pk_bf16(a[2], a[3]); w1.x = cvt_pk_bf16(b[0], b[1]); w1.y = cvt_pk_bf16(b[2], b[3]);
        *(u32x2*)(op + 8 * q4) = w0; *(u32x2*)(op + 32 + 8 * q4) = w1; }
}

__device__ __forceinline__ void attn_item(Frame& F, int b, int g, int ci) {
    LAS unsigned char* lds = F.lds + RING_OFF;
    const int tid = F.tid, lane = F.lane, wave = F.wave, c32 = lane & 31, hi = lane >> 5;
    const int tokl = 8 * wave + (c32 >> 2), h = c32 & 3, ts = 64 * ci + tokl; const size_t trow = (size_t)b * SEQ + ts;
    const int bg = b * 4 + g;
    const bf16* Q = (const bf16*)(F.ws + WS_Q); bf16* O = (bf16*)(F.ws + WS_O);
    bf16x8 qf[4];
    { const bf16* qp = Q + trow * 1024 + g * 256 + h * 64 + 8 * hi;
#pragma unroll
      for (int ks = 0; ks < 4; ++ks) qf[ks] = *(const bf16x8*)(qp + 16 * ks); }
    const bf16* ngp = (const bf16*)(F.ws + WS_NGT) + trow * 64 + g * 12 + h * 3;
#ifdef CHK_BR
    const float gate_c = (CHK_BR & 1) ? bf2f(ngp[0]) : 0.f, gate_s = (CHK_BR & 2) ? bf2f(ngp[1]) : 0.f, gate_w = (CHK_BR & 4) ? bf2f(ngp[2]) : 0.f;
#else
    const float gate_c = bf2f(ngp[0]), gate_s = bf2f(ngp[1]), gate_w = bf2f(ngp[2]);
#endif
    asm volatile("" : "+v"(qf[0]), "+v"(qf[1]), "+v"(qf[2]), "+v"(qf[3]));
    const int srow = tid >> 3, sch = (tid & 7) ^ ((tid >> 4) & 7);
    bf16* const op = O + trow * 1024 + g * 256 + h * 64 + 4 * hi;
    unsigned selw[4] = {0u, 0u, 0u, 0u};
    State st;
    { LAS f32x4* z = (LAS f32x4*)(lds + L_IMP) + tid * 4;
#pragma unroll
      for (int q = 0; q < 4; ++q) z[q] = (f32x4){0.f, 0.f, 0.f, 0.f}; }
    {
        const int u0 = (ci >= 8) ? 0 : 8 - ci, nt = 9 - u0; const int pos0 = 64 * (ci - 8 + u0);
        const bf16* kp = (const bf16*)(F.ws + WS_KV + 4 * KV_STRIDE) + ((size_t)b * SEQ + pos0 + srow) * 256 + g * 64 + 8 * sch;
        const bf16* vp = (const bf16*)(F.ws + WS_VWT) + ((size_t)bg * 64 + srow) * SEQ + pos0 + 8 * sch;
#if defined(ATT_DBL) && ATT_DBL == 1
#pragma unroll 1
        for (int rep = 0; rep < 2; ++rep) {
#else
        {
#endif
        st.m = -1e30f; st.l = 0.f; st.o0 = (f32x16){0.f}; st.o1 = (f32x16){0.f};
        run_branch<M_WIN>(lds, nt, u0, kp, (size_t)64 * 256, vp, (size_t)64, qf, st, tokl, ci, 0, selw[0], selw[1], selw[2], selw[3], 0.f, 0.f, tid, lane, wave);
        }
        const float lt = halfsum(st.l); const float sc = (lt > 0.f) ? gate_w / lt : 0.f;
        o_update<false>(op, st.o0, st.o1, sc);
    }
    {
        const int ncmp = (4 * ci + 3 < NCMP) ? 4 * ci + 3 : NCMP, nt = (ncmp + 63) >> 6;
        const int nvis = (ts >= 31) ? (ts - 15) >> 4 : 0;
        const bf16* kp = (const bf16*)(F.ws + WS_KC) + ((size_t)bg * 512 + srow) * 64 + 8 * sch;
        const bf16* vp = (const bf16*)(F.ws + WS_VCT) + ((size_t)bg * 64 + srow) * 512 + 8 * sch;
        st.m = -1e30f; st.l = 0.f; st.o0 = (f32x16){0.f}; st.o1 = (f32x16){0.f};
        run_branch<M_CMP1>(lds, nt, 0, kp, (size_t)64 * 64, vp, (size_t)64, qf, st, tokl, ci, nvis, selw[0], selw[1], selw[2], selw[3], 0.f, 0.f, tid, lane, wave);
        const float lt = halfsum(st.l); const float cinv = (lt > 0.f) ? 1.0f / lt : 0.f; const float cm = st.m;
        run_branch<M_CMP2>(lds, nt, 0, kp, (size_t)64 * 64, vp, (size_t)64, qf, st, tokl, ci, nvis, selw[0], selw[1], selw[2], selw[3], cm, cinv, tid, lane, wave);
        o_update<true>(op, st.o0, st.o1, gate_c);
    }
    {
        LAS unsigned* SEL = (LAS unsigned*)(lds + L_SEL);
#if defined(ATT_DBL) && ATT_DBL == 3
#pragma unroll 1
        for (int rep = 0; rep < 2; ++rep)
#endif
        if (ci >= SELTOP) {
            const LAS float* imp = (const LAS float*)(lds + L_IMP);
#pragma unroll 1
            for (int tk = 0; tk < 8; ++tk) { const int tl2 = 8 * wave + tk;
                float v0 = -3e38f, v1 = -3e38f;
                if (lane >= 1 && lane <= ci - 2) v0 = imp[tl2 * 128 + lane];
                if (lane + 64 <= ci - 2) v1 = imp[tl2 * 128 + lane + 64];
                unsigned long long mlo = 0ull, mhi = 0ull;
#pragma unroll 1
                for (int r = 0; r < SELTOP - 3; ++r) {
                    const float mx = wave_max(fmaxf(v0, v1));
                    const unsigned long long b0 = __ballot(v0 == mx);
                    if (b0) { const int js = __ffsll((long long)b0) - 1; mlo |= 1ull << js; if (lane == js) v0 = -3e38f; }
                    else { const unsigned long long b1 = __ballot(v1 == mx); const int js = __ffsll((long long)b1) - 1; mhi |= 1ull << js; if (lane == js) v1 = -3e38f; }
                }
                mlo |= 1ull;
                if (ci - 1 < 64) mlo |= 1ull << (ci - 1); else mhi |= 1ull << (ci - 1 - 64);
                if (ci < 64) mlo |= 1ull << ci; else mhi |= 1ull << (ci - 64);
                if (lane == 0) { SEL[tl2 * 4 + 0] = (unsigned)mlo; SEL[tl2 * 4 + 1] = (unsigned)(mlo >> 32); SEL[tl2 * 4 + 2] = (unsigned)mhi; SEL[tl2 * 4 + 3] = (unsigned)(mhi >> 32); }
            }
            LDS_WAIT(); asm volatile("" ::: "memory");
#pragma unroll
            for (int q = 0; q < 4; ++q) selw[q] = SEL[tokl * 4 + q];
        } else {
            selw[0] = (ci == 31) ? 0xffffffffu : ((1u << (ci + 1)) - 1u); selw[1] = 0u; selw[2] = 0u; selw[3] = 0u;
        }
    }
    {
        const int nt = ci + 1;
        const bf16* kp = (const bf16*)(F.ws + WS_KV + 2 * KV_STRIDE) + ((size_t)b * SEQ + srow) * 256 + g * 64 + 8 * sch;
        const bf16* vp = (const bf16*)(F.ws + WS_VST) + ((size_t)bg * 64 + srow) * SEQ + 8 * sch;
#if defined(ATT_DBL) && ATT_DBL == 4
#pragma unroll 1
        for (int rep = 0; rep < 2; ++rep) {
#else
        {
#endif
        st.m = -1e30f; st.l = 0.f; st.o0 = (f32x16){0.f}; st.o1 = (f32x16){0.f};
        run_branch<M_SEL>(lds, nt, 0, kp, (size_t)64 * 256, vp, (size_t)64, qf, st, tokl, ci, 0, selw[0], selw[1], selw[2], selw[3], 0.f, 0.f, tid, lane, wave);
        }
        const float lt = halfsum(st.l); const float sc = (lt > 0.f) ? gate_s / lt : 0.f;
        o_update<true>(op, st.o0, st.o1, sc);
    }
}
__device__ __forceinline__ void attn_phase(Frame& F) {
    if (F.G == 256) { const int x = F.vcu >> 5, wl = F.vcu & 31;
        for (int k = 0; k < 8; ++k) { const int m = wl + 32 * k, ci = 127 - (m >> 1), bg = 2 * x + (m & 1); attn_item(F, bg >> 2, bg & 3, ci); } }
    else for (int idx = F.vcu; idx < BATCH * NG * (SEQ / 64); idx += F.G) { const int ci = 127 - (idx >> 4), bg = idx & 15; attn_item(F, bg >> 2, bg & 3, ci); }
}
}
#ifdef SELFCHECK
constexpr int CW_CHK = 40000;
__device__ __forceinline__ void chk_add(Frame& F, float err, float nrm) {
    if (F.lane == 0) { atomicAdd((float*)(F.ctl + CW_CHK), err); atomicAdd((float*)(F.ctl + CW_CHK) + 1, nrm); }
}
__device__ __forceinline__ void chk_attn_sample(Frame& F, int b, int ts, int g) {
    const int lane = F.lane, bg = b * 4 + g; const size_t trow = (size_t)b * SEQ + ts;
    LAS float* L = (LAS float*)(F.lds + RING_OFF + F.wave * 16384);
    LAS float* qs = L; LAS float* pc = L + 256; LAS float* sc = L + 256 + 2048; LAS float* impv = sc + 1024; LAS float* orf = impv + 128; LAS int* selL = (LAS int*)(orf + 256);
    const bf16* Q = (const bf16*)(F.ws + WS_Q); const bf16* O = (const bf16*)(F.ws + WS_O);
    const bf16* KC = (const bf16*)(F.ws + WS_KC) + (size_t)bg * 512 * 64; const bf16* VCT = (const bf16*)(F.ws + WS_VCT) + (size_t)bg * 64 * 512;
    const bf16* KS = (const bf16*)(F.ws + WS_KV + 2 * KV_STRIDE); const bf16* VS = (const bf16*)(F.ws + WS_KV + 3 * KV_STRIDE);
    const bf16* KW = (const bf16*)(F.ws + WS_KV + 4 * KV_STRIDE); const bf16* VW = (const bf16*)(F.ws + WS_KV + 5 * KV_STRIDE);
    const bf16* NGp = (const bf16*)(F.ws + WS_NGT) + trow * 64 + g * 12;
    for (int i = lane; i < 256; i += 64) qs[i] = bf2f(Q[trow * 1024 + g * 256 + i]);
    LDS_WAIT(); asm volatile("" ::: "memory");
    const int jq = ts >> 6, nvis = (ts >= 31) ? (ts - 15) >> 4 : 0;
    for (int i = lane; i < 256; i += 64) orf[i] = 0.f;
    for (int h = 0; h < 4; ++h) {
        float mx = -3e38f;
        for (int n = lane; n < 512; n += 64) { float s = -3e38f; if (n < nvis) { s = 0.f; for (int d = 0; d < 64; ++d) s += qs[h * 64 + d] * bf2f(KC[n * 64 + d]); } pc[h * 512 + n] = s; mx = fmaxf(mx, s); }
        mx = wave_max(mx); float sum = 0.f;
        for (int n = lane; n < 512; n += 64) { const float s = pc[h * 512 + n]; const float p = (n < nvis) ? __expf(s - mx) : 0.f; pc[h * 512 + n] = p; sum += p; }
        sum = wave_sum(sum); const float inv = (sum > 0.f) ? 1.f / sum : 0.f;
        for (int n = lane; n < 512; n += 64) pc[h * 512 + n] *= inv;
        LDS_WAIT(); asm volatile("" ::: "memory");
        float o = 0.f; for (int n = 0; n < nvis; ++n) o += pc[h * 512 + n] * bf2f(VCT[lane * 512 + perm16(n)]);
        if (CHK_BR & 1) orf[h * 64 + lane] += bf2f(NGp[h * 3 + 0]) * o;
    }
    for (int j = lane; j < 128; j += 64) { float a = 0.f; for (int h = 0; h < 4; ++h) for (int n = 4 * j - 1; n <= 4 * j + 3; ++n) if (n >= 0 && n < 511) a += pc[h * 512 + n];
        impv[j] = (j == 0 || j == jq || j == jq - 1) ? 1e4f : ((j <= jq) ? a : -1.0f); }
    LDS_WAIT(); asm volatile("" ::: "memory");
    { float v0 = impv[lane], v1 = impv[lane + 64];
      for (int r = 0; r < 16; ++r) { const float mx = wave_max(fmaxf(v0, v1)); const unsigned long long b0 = __ballot(v0 == mx); int js;
          if (b0) { js = __ffsll((long long)b0) - 1; if (lane == js) v0 = -3e38f; } else { const unsigned long long b1 = __ballot(v1 == mx); js = 64 + __ffsll((long long)b1) - 1; if (lane == js - 64) v1 = -3e38f; }
          if (lane == 0) selL[r] = js; } }
    LDS_WAIT(); asm volatile("" ::: "memory");
    for (int h = 0; h < 4; ++h) {
        float mx = -3e38f;
        for (int r = 0; r < 16; ++r) { const int pos = selL[r] * 64 + lane; float s = -3e38f;
            if (pos <= ts) { s = 0.f; const bf16* kr = KS + ((size_t)b * SEQ + pos) * 256 + g * 64; for (int d = 0; d < 64; ++d) s += qs[h * 64 + d] * bf2f(kr[d]); }
            sc[r * 64 + lane] = s; mx = fmaxf(mx, s); }
        mx = wave_max(mx); float sum = 0.f;
        for (int r = 0; r < 16; ++r) { const int pos = selL[r] * 64 + lane; const float p = (pos <= ts) ? __expf(sc[r * 64 + lane] - mx) : 0.f; sc[r * 64 + lane] = p; sum += p; }
        sum = wave_sum(sum); const float inv = (sum > 0.f) ? 1.f / sum : 0.f;
        LDS_WAIT(); asm volatile("" ::: "memory");
        float o = 0.f;
        for (int r = 0; r < 16; ++r) for (int i = 0; i < 64; ++i) { const int pos = selL[r] * 64 + i; if (pos <= ts) o += sc[r * 64 + i] * bf2f(VS[((size_t)b * SEQ + pos) * 256 + g * 64 + lane]); }
        if (CHK_BR & 2) orf[h * 64 + lane] += bf2f(NGp[h * 3 + 1]) * o * inv;
        LDS_WAIT(); asm volatile("" ::: "memory");
    }
    for (int h = 0; h < 4; ++h) {
        float mx = -3e38f;
        for (int i = lane; i < 512; i += 64) { const int pos = ts - 511 + i; float s = -3e38f;
            if (pos >= 0) { s = 0.f; const bf16* kr = KW + ((size_t)b * SEQ + pos) * 256 + g * 64; for (int d = 0; d < 64; ++d) s += qs[h * 64 + d] * bf2f(kr[d]); }
            sc[i] = s; mx = fmaxf(mx, s); }
        mx = wave_max(mx); float sum = 0.f;
        for (int i = lane; i < 512; i += 64) { const int pos = ts - 511 + i; const float p = (pos >= 0) ? __expf(sc[i] - mx) : 0.f; sc[i] = p; sum += p; }
        sum = wave_sum(sum); const float inv = (sum > 0.f) ? 1.f / sum : 0.f;
        LDS_WAIT(); asm volatile("" ::: "memory");
        float o = 0.f;
        for (int i = 0; i < 512; ++i) { const int pos = ts - 511 + i; if (pos >= 0) o += sc[i] * bf2f(VW[((size_t)b * SEQ + pos) * 256 + g * 64 + lane]); }
        if (CHK_BR & 4) orf[h * 64 + lane] += bf2f(NGp[h * 3 + 2]) * o * inv;
        LDS_WAIT(); asm volatile("" ::: "memory");
    }
    float err = 0.f, nrm = 0.f;
    for (int h = 0; h < 4; ++h) { const float ref = orf[h * 64 + lane];
        const float got = bf2f(O[trow * 1024 + g * 256 + h * 64 + lane]);
        err += (got - ref) * (got - ref); nrm += ref * ref; }
    err = wave_sum(err); nrm = wave_sum(nrm);
    chk_add(F, err, nrm);
}
__device__ __forceinline__ void chk_attn_phase(Frame& F) {
    const int gw = F.vcu * NWAVES + F.wave;
    const int tsl[32] = {0, 1, 30, 31, 32, 47, 63, 64, 65, 127, 128, 500, 511, 512, 513, 1000, 1023, 1024, 1087, 1500, 2047, 2048, 3000, 4095, 4096, 5000, 6143, 7000, 8000, 8128, 8190, 8191};
    if (gw < 32 * CHK_NSETS) { const int si = gw & 31, set = gw >> 5; int ts = 0;
#pragma unroll
        for (int k = 0; k < 32; ++k) if (si == k) ts = tsl[k];
        chk_attn_sample(F, (set + 1) & 3, ts, (set * 3 + 2) & 3); }
}
#endif
#ifndef MK_N_LAUNCHES
#define MK_N_LAUNCHES 1
#endif
constexpr int N_PHASES = 16;
constexpr int N_LAUNCHES = MK_N_LAUNCHES;

__global__ void __launch_bounds__(NTHREADS, 2) fwd_megakernel(Args args) {
    extern __shared__ __attribute__((aligned(16))) unsigned char lds_raw[];
    Frame F;
    F.lds = (LAS unsigned char*)lds_raw;
    F.MISC = (volatile LAS unsigned*)(F.lds + MISC_OFF);
    F.tid = threadIdx.x; F.lane = F.tid & 63; F.wave = __builtin_amdgcn_readfirstlane(F.tid >> 6);
    F.G = gridDim.x; { const int bx = blockIdx.x; F.vcu = (F.G % 8 == 0) ? (bx % 8) * (F.G / 8) + bx / 8 : bx; }
    F.ws = args.ws; F.ctl = (gu32*)(args.ws + WS_CTL); F.out = args.out;
    for (int u = F.tid; u < (LDS_BYTES - LDSCTL_OFF) / 4; u += NTHREADS) ((LAS unsigned*)(F.lds + LDSCTL_OFF))[u] = 0u;
    __syncthreads();
    XcdBarrier bar; bar.bar = (unsigned*)(F.ctl + CW_BAR); bar.x = 0; bar.st = nullptr;
    if (N_LAUNCHES == 1) bar = xcd_barrier_post((unsigned*)(F.ctl + CW_BAR), F.MISC + 8);
    const int lo = args.ph_lo, hi = args.ph_hi;
#ifdef PH_MASK
#define IN(k) (((PH_MASK >> (k)) & 1) && lo <= (k) && (k) < hi)
#else
#define IN(k) (lo <= (k) && (k) < hi)
#endif
#define SEAM(k) do { if (IN(k) && IN((k) + 1)) xcd_barrier(bar); asm volatile("" : "+s"(F.ws), "+s"(F.out)); } while (0)
    LAS unsigned char* ring = F.lds + RING_OFF;
    const int G = F.G, bx = (int)blockIdx.x;

    if (IN(0)) { p0_prologue(F, args);
#if defined(DBL_MASK) && (DBL_MASK & 0x1)
        xcd_barrier(bar); p0_prologue(F, args);
#endif
    } SEAM(0);
    if (IN(1)) { norm_mod_rows<true>(F, args, AIN[I_X], (bf16*)(F.ws + WS_XN), AIN[I_N1G], 0, 1024); finalize_mod(F, args); } SEAM(1);
    if (IN(2)) {
        pg8::DenseOrder S; S.init(F.ws + WS_XN, 2048, F.ws + WS_WIN, 1024, T, NINP, G, bx);
        EpiIn E{(const float*)(F.ws + WS_BINP), (bf16*)(F.ws + WS_U), (bf16*)(F.ws + WS_Q), (bf16*)(F.ws + WS_KV), (bf16*)(F.ws + WS_NGT), (bf16*)(F.ws + WS_GM)};
#if defined(DBL_MASK) && (DBL_MASK & 0x4)
#pragma unroll 1
        for (int rep = 0; rep < 2; ++rep) { pg8::gemm_phase<EpiIn, pg8::DenseOrder, true, true>(ring, 1024, S, E); if (rep == 0) xcd_barrier(bar); }
#else
        pg8::gemm_phase<EpiIn, pg8::DenseOrder, true, true>(ring, 1024, S, E);
#endif
    } SEAM(2);
    if (IN(3)) {
#if defined(DBL_MASK) && (DBL_MASK & 0x8)
#pragma unroll 1
        for (int rep = 0; rep < 2; ++rep) { p3_phase(F, args); if (rep == 0) xcd_barrier(bar); }
#else
        p3_phase(F, args);
#endif
    } SEAM(3);
    if (IN(4)) {
#if defined(DBL_MASK) && (DBL_MASK & 0x10)
#pragma unroll 1
        for (int rep = 0; rep < 2; ++rep) { att::attn_phase(F); if (rep == 0) xcd_barrier(bar); }
#else
        att::attn_phase(F);
#endif
    } SEAM(4);
    if (IN(5)) {
#ifdef SELFCHECK
        chk_attn_phase(F); __syncthreads();
#endif
        pg8::DenseOrder S; S.init(F.ws + WS_CF, 1024, F.ws + WS_WC, 512, T, 1024, G, bx);
        EpiMix<0> E{(const bf16*)(F.ws + WS_GM), (bf16*)(F.ws + WS_MIX), AIN[I_BCO]};
        pg8::gemm_phase<EpiMix<0>, pg8::DenseOrder, true, true>(ring, 512, S, E);
    } SEAM(5);
    if (IN(6)) {
        pg8::DenseOrder S; S.init(F.ws + WS_O, 2048, F.ws + WS_WN, 1024, T, 1024, G, bx);
        EpiMix<1> E{(const bf16*)(F.ws + WS_GM), (bf16*)(F.ws + WS_MIX), nullptr};
        pg8::gemm_phase<EpiMix<1>, pg8::DenseOrder, true, true>(ring, 1024, S, E);
    } SEAM(6);
    if (IN(7)) {
        pg8::DenseOrder S; S.init(F.ws + WS_MIX, 2048, F.ws + WS_WO, 1024, T, 1024, G, bx);
        EpiOut E{AIN[I_X], F.out, (const float*)(F.ws + WS_MODF) + 2048};
        pg8::gemm_phase<EpiOut, pg8::DenseOrder, true, true>(ring, 1024, S, E);
    } SEAM(7);
    if (IN(8)) { norm_mod_rows<false>(F, args, F.out, (bf16*)(F.ws + WS_XN), AIN[I_N2G], 3072, 4096); } SEAM(8);
    if (IN(9)) {
        pg8::DenseOrder S; S.init(F.ws + WS_XN, 2048, F.ws + WS_WR, 1024, T, 256, G, bx);
        EpiLogits E{(float*)(F.ws + WS_LOG)};
        pg8::gemm_phase<EpiLogits, pg8::DenseOrder, true, true>(ring, 1024, S, E);
    } SEAM(9);
    if (IN(10)) { routing_phase(F, args); } SEAM(10);
    if (IN(11)) {
        build_tables(F);
        const LAS int* tab = (const LAS int*)(F.lds + TAB_OFF);
        ExpertOrder S{tab, (const char*)(F.ws + WS_XN), (const char*)(F.ws + WS_WGU), (const char*)(F.ws + WS_WSHGU), nullptr, (const int*)(F.ws + WS_TOKL), 0, 0, G, F.vcu, tab[260 + NEXP + 1]};
        EpiAct E{(bf16*)(F.ws + WS_ACT), (bf16*)(F.ws + WS_ACTSH)};
#if defined(DBL_MASK) && (DBL_MASK & 0x800)
#pragma unroll 1
        for (int rep = 0; rep < 2; ++rep) { pg8::gemm_phase<EpiAct, ExpertOrder, true, true>(ring, 1024, S, E); if (rep == 0) xcd_barrier(bar); }
#else
        pg8::gemm_phase<EpiAct, ExpertOrder, true, true>(ring, 1024, S, E);
#endif
    } SEAM(11);
#pragma unroll 1
    for (int hh = 0; hh < 2; ++hh) {
        if (IN(12 + 2 * hh)) {
            build_tables(F);
            const LAS int* tab = (const LAS int*)(F.lds + TAB_OFF);
            ExpertOrder S{tab, (const char*)(F.ws + WS_ACT), (const char*)(F.ws + WS_WD), (const char*)(F.ws + WS_WSHD), (const char*)(F.ws + WS_ACTSH), nullptr, 1, hh, G, F.vcu, tab[260 + NEXP + 1]};
            EpiDown E{(bf16*)(F.ws + WS_YS), F.out, (const float*)(F.ws + WS_MODF) + 5120};
            pg8::gemm_phase<EpiDown, ExpertOrder, true, true>(ring, 256, S, E);
        } SEAM(12 + 2 * hh);
        if (IN(13 + 2 * hh)) { build_tables(F); combine_phase(F, args, hh); } SEAM(13 + 2 * hh);
    }
#undef IN
#undef SEAM
}

extern "C" void kernel_launch(void* const* d_in, const int* in_sizes, int n_in, void* d_out, int out_size, void* d_ws, size_t ws_size, hipStream_t stream) {
    static int grid = 0;
    if (grid == 0) {
        if (n_in != 31 || in_sizes[0] != T * DM || out_size != T * DM || ws_size < WS_END) { fprintf(stderr, "kernel_launch: unexpected problem (n_in %d, in0 %d, out %d, ws %zu); nothing launched\n", n_in, n_in > 0 ? in_sizes[0] : -1, out_size, ws_size); grid = -1; return; }
        int dev = 0, cus = 0, per_cu = 0;
        if (hipGetDevice(&dev) != hipSuccess || hipDeviceGetAttribute(&cus, hipDeviceAttributeMultiprocessorCount, dev) != hipSuccess) { grid = -1; return; }
        if (hipFuncSetAttribute((const void*)fwd_megakernel, hipFuncAttributeMaxDynamicSharedMemorySize, LDS_BYTES) != hipSuccess) { fprintf(stderr, "kernel_launch: hipFuncSetAttribute failed\n"); grid = -1; return; }
        if (hipOccupancyMaxActiveBlocksPerMultiprocessor(&per_cu, (const void*)fwd_megakernel, NTHREADS, LDS_BYTES) != hipSuccess || per_cu < 1)
            fprintf(stderr, "kernel_launch: note: occupancy query reports %d workgroups per CU\n", per_cu);
        (void)hipGetLastError();
        grid = cus;
    }
    if (grid < 0) return;
    if (hipMemsetAsync((char*)d_ws + WS_CTL, 0, CTL_ZERO_BYTES, stream) != hipSuccess) { fprintf(stderr, "kernel_launch: memset failed\n"); return; }
    Args a{};
    for (int i = 0; i < 31; ++i) a.in[i] = (const float*)d_in[i];
    a.out = (float*)d_out; a.ws = (unsigned char*)d_ws;
    for (int li = 0; li < N_LAUNCHES; ++li) {
        a.ph_lo = (N_LAUNCHES == 1) ? 0 : li; a.ph_hi = (N_LAUNCHES == 1) ? N_PHASES : li + 1; a.li = li;
        hipLaunchKernelGGL(fwd_megakernel, dim3(grid), dim3(NTHREADS), LDS_BYTES, stream, a);
        const hipError_t le = hipPeekAtLastError();
        if (le != hipSuccess) { fprintf(stderr, "kernel_launch: launch %d failed: %s\n", li, hipGetErrorName(le)); break; }
    }
}
```

```cpp
#define XC_R9 32768
#include <hip/hip_runtime.h>
#include <cstdio>
#include <cstdint>

#define GAS __attribute__((address_space(1)))
#define LAS __attribute__((address_space(3)))
typedef unsigned short bf16;
typedef short bf16x8 __attribute__((ext_vector_type(8)));
typedef float f32x4 __attribute__((ext_vector_type(4)));
typedef float f32x2 __attribute__((ext_vector_type(2)));
typedef float f32x16 __attribute__((ext_vector_type(16)));
typedef unsigned u32x4 __attribute__((ext_vector_type(4)));
typedef unsigned u32x2 __attribute__((ext_vector_type(2)));
typedef GAS unsigned gu32;

constexpr int BATCH = 4, SEQ = 8192, DM = 1024, T = BATCH * SEQ;
constexpr int DCONV = 512, CONVK = 31;
constexpr int NH = 16, NG = 4, HG = 4, HD = 64;
constexpr int NCMP = 511, NSEL = 128, SELTOP = 16, WINDOW = 512;
constexpr int NEXP = 256, TOPK = 8, DEXP = 256;
constexpr int NIN = 5680, NINP = 5888;
constexpr float EPS = 1e-6f;
constexpr int NWAVES = 8, NTHREADS = 512;

constexpr size_t MiB = 1u << 20;
constexpr size_t WS_CTL = 0, CTL_ZERO_BYTES = 1 * MiB;
constexpr size_t WS_MODP = 1 * MiB;
constexpr size_t WS_MODF = 2 * MiB;
constexpr size_t WS_PEBP = 2 * MiB + 128 * 1024;
constexpr size_t WS_PEBF = 2 * MiB + 160 * 1024;
constexpr size_t WS_BINP = 2 * MiB + 192 * 1024;
constexpr size_t WS_WIN = 3 * MiB;
constexpr size_t WS_WC = 15 * MiB;
constexpr size_t WS_WN = 16 * MiB;
constexpr size_t WS_WO = 18 * MiB;
constexpr size_t WS_WR = 20 * MiB;
constexpr size_t WS_WSHGU = 21 * MiB;
constexpr size_t WS_WSHD = 22 * MiB;
constexpr size_t WS_CW1 = 23 * MiB;
constexpr size_t WS_CW2 = 24 * MiB;
constexpr size_t WS_WGU = 32 * MiB;
constexpr size_t WS_WD = 288 * MiB;
constexpr size_t WS_XN = 416 * MiB;
constexpr size_t WS_U = 480 * MiB;
constexpr size_t WS_CF = 512 * MiB;
constexpr size_t WS_Q = 544 * MiB;
constexpr size_t WS_O = 608 * MiB;
constexpr size_t WS_KV = 672 * MiB;
constexpr size_t KV_STRIDE = 16 * MiB;
constexpr size_t WS_VST = 768 * MiB;
constexpr size_t WS_VWT = 784 * MiB;
constexpr size_t WS_KC = 800 * MiB;
constexpr size_t WS_VCT = 801 * MiB;
constexpr size_t WS_NGT = 802 * MiB;
constexpr size_t WS_GM = 808 * MiB;
constexpr size_t WS_MIX = 936 * MiB;
constexpr size_t WS_VSF = 936 * MiB;
constexpr size_t WS_KSF = 952 * MiB;
constexpr size_t WS_LOG = 480 * MiB;
constexpr size_t WS_RTE = 512 * MiB;
constexpr size_t WS_RTS = 513 * MiB;
constexpr size_t WS_RTW = 514 * MiB;
constexpr size_t WS_TOKL = 516 * MiB;
constexpr size_t WS_ACT = 548 * MiB;
constexpr size_t WS_ACTSH = 680 * MiB;
constexpr size_t WS_YS8 = 32 * MiB;
constexpr size_t WS_YSS = 416 * MiB;
constexpr size_t WS_XN8A = 512 * MiB;
constexpr size_t WS_X1 = 616 * MiB;
constexpr size_t WS_O8 = 416 * MiB;
constexpr size_t WS_MIX8 = 480 * MiB;
constexpr size_t WS_XN8 = 696 * MiB;
constexpr size_t WS_END = 1024 * MiB;

constexpr int CW_TMO = 0, CW_CODE = 1;
constexpr int CW_BAR = 4096;
constexpr int CW_CNT = 32768;

constexpr int RING_OFF = 0, RING_BYTES = 135168;
constexpr int LDSCTL_OFF = RING_BYTES, MISC_OFF = LDSCTL_OFF + 320;
constexpr int TAB_OFF = LDSCTL_OFF + 1024;
constexpr int LDS_BYTES = 147456;

#define LDS_WAIT() asm volatile("s_waitcnt lgkmcnt(0)" ::: "memory")
#define VM_WAIT() asm volatile("s_waitcnt vmcnt(0)" ::: "memory")
#define RLX_AGENT __ATOMIC_RELAXED, __HIP_MEMORY_SCOPE_AGENT

__device__ __forceinline__ unsigned f2bf(float f) { unsigned u = __builtin_bit_cast(unsigned, f); return (u + 0x7fffu + ((u >> 16) & 1u)) >> 16; }
__device__ __forceinline__ unsigned pk2(float lo, float hi) { return f2bf(lo) | (f2bf(hi) << 16); }
__device__ __forceinline__ float bf2f(unsigned b) { return __builtin_bit_cast(float, b << 16); }
__device__ __forceinline__ float bflo(unsigned w) { return __builtin_bit_cast(float, w << 16); }
__device__ __forceinline__ float bfhi(unsigned w) { return __builtin_bit_cast(float, w & 0xffff0000u); }
__device__ __forceinline__ float sigmoidf_(float x) { return __builtin_amdgcn_rcpf(1.0f + __expf(-x)); }
__device__ __forceinline__ float wave_sum(float v) {
#pragma unroll
    for (int o = 1; o < 64; o <<= 1) v += __shfl_xor(v, o);
    return v;
}
#define DPP_F(old_, v_, ctrl, rmask) __builtin_bit_cast(float, __builtin_amdgcn_update_dpp(__builtin_bit_cast(int, (old_)), __builtin_bit_cast(int, (v_)), (ctrl), (rmask), 0xF, false))
__device__ __forceinline__ float wave_max(float v) {
    v = fmaxf(v, DPP_F(v, v, 0xB1, 0xF));
    v = fmaxf(v, DPP_F(v, v, 0x4E, 0xF));
    v = fmaxf(v, DPP_F(v, v, 0x141, 0xF));
    v = fmaxf(v, DPP_F(v, v, 0x140, 0xF));
    v = fmaxf(v, DPP_F(v, v, 0x142, 0xA));
    v = fmaxf(v, DPP_F(v, v, 0x143, 0xC));
    return __builtin_bit_cast(float, __builtin_amdgcn_readlane(__builtin_bit_cast(int, v), 63));
}

__device__ __forceinline__ int fresh_lane() { unsigned m = ~0u; asm volatile("" : "+s"(m)); return (int)__builtin_amdgcn_mbcnt_hi(m, __builtin_amdgcn_mbcnt_lo(m, 0u)); }
__device__ __forceinline__ unsigned f8pack4(float a, float b, float c, float d, float sc) {
    a = __builtin_amdgcn_fmed3f(a * sc, -448.f, 448.f); b = __builtin_amdgcn_fmed3f(b * sc, -448.f, 448.f); c = __builtin_amdgcn_fmed3f(c * sc, -448.f, 448.f); d = __builtin_amdgcn_fmed3f(d * sc, -448.f, 448.f);
    int w = __builtin_amdgcn_cvt_pk_fp8_f32(a, b, 0, false); w = __builtin_amdgcn_cvt_pk_fp8_f32(c, d, w, true); return (unsigned)w;
}
#ifndef F8_MIXB
#define F8_MIXB 1
#endif
#ifndef F8_MIXA
#define F8_MIXA 0
#endif
constexpr float F8_SX = 4.0f, F8_SWG = 64.0f, F8_SWD = 32.0f, F8_SACT = 2.0f, F8_SMIX = 8.0f, F8_SO = 8.0f, F8_SCF = 8.0f, F8_SWC = 32.0f, F8_SKV = 8.0f, F8_SW1 = 64.0f;

namespace pg8 {
constexpr int BM = 256, BK = 64, HALF = 128, HTB = HALF * BK * 2, STAGE_BYTES = 8 * HTB, NXCD = 8, WGM = 8;
__host__ __device__ __forceinline__ int lds_byte(int r, int c) { const int st = (r >> 4) * 2 + (c >> 5), rr = r & 15, cc = c & 31, ob = rr * 64 + cc * 2; return st * 1024 + (ob ^ (((ob >> 9) & 1) << 5)); }
__host__ __device__ __forceinline__ void stage_rc(int b, int& R, int& C) { const int st = b / 1024, sb = b % 1024, swz = sb ^ (((sb >> 9) & 1) << 5); R = (st >> 1) * 16 + swz / 64; C = (st & 1) * 32 + (swz % 64) / 2; }
__host__ __device__ __forceinline__ int perm32(int rho) { const int n = rho >> 4, i = rho & 15; return 8 * (i >> 2) + 4 * n + (i & 3); }

struct Unit { int pm, pn; const char* A; const char* B; int e, mt, cnt, off; };

typedef __bf16 bf16x2_t __attribute__((ext_vector_type(2)));
__device__ __forceinline__ unsigned cvt_pk_bf16(float lo, float hi) { f32x2 v = {lo, hi}; bf16x2_t b = __builtin_convertvector(v, bf16x2_t); return __builtin_bit_cast(unsigned, b); }

struct DenseOrder {
    const char* A; const char* Bt; int lda_b, K; int nM, nN, nwg, G, c;
    __device__ void init(const void* A_, int lda_bytes, const void* Bt_, int K_, int M, int N, int G_, int c_) { A = (const char*)A_; Bt = (const char*)Bt_; lda_b = lda_bytes; K = K_; nM = M / BM; nN = N / BM; nwg = nM * nN; G = G_; c = c_; }
    __device__ __forceinline__ bool next(int i, Unit& u) const {
        const long L = (long)i * G + c; if (L >= nwg) return false;
        int wgid = (int)L; { const int q = nwg / NXCD, r = nwg % NXCD, xcd = wgid % NXCD, off = wgid / NXCD; wgid = (xcd < r ? xcd * (q + 1) : r * (q + 1) + (xcd - r) * q) + off; }
        const int nig = WGM * nN, gid = wgid / nig, fm = gid * WGM, gsz = (nM - fm) < WGM ? (nM - fm) : WGM;
        u.pm = fm + ((wgid % nig) % gsz); u.pn = (wgid % nig) / gsz;
        u.A = A + (size_t)u.pm * BM * lda_b; u.B = Bt + (size_t)u.pn * BM * K * 2; u.e = 0; u.mt = 0; u.cnt = 0; u.off = 0; return true;
    }
    __device__ __forceinline__ unsigned row_off(const Unit&, int r) const { return (unsigned)r * (unsigned)lda_b; }
};

typedef int i32x4_t __attribute__((ext_vector_type(4)));
typedef int i32x8_t __attribute__((ext_vector_type(8)));
template <class Epi, class Sched, bool ALIGN_EPI, bool SP2, bool FP8 = false>
__device__ __forceinline__ void gemm_phase(LAS unsigned char* lds, const int K, const Sched& S, const Epi& E, const int wid) {
    const int lane = fresh_lane(), tid = wid * 64 + lane, wr = wid >> 2, wc = wid & 3, fr = lane & 15, fq = lane >> 4;
    const int nt = K / BK;
    unsigned voffB[2];
#pragma unroll
    for (int i = 0; i < 2; ++i) { int R, C; stage_rc(tid * 16 + i * 8192, R, C); const int Rb = Epi::PERM ? ((R & ~31) + perm32(R & 31)) : R; voffB[i] = (unsigned)(Rb * K + C) * 2u; }
#define PG8_RC(R0, R1, C0, C1) int R0, R1, C0, C1; { const int t2_ = wid * 64 + fresh_lane(); int c_; stage_rc(t2_ * 16, R0, c_); C0 = c_ * 2; stage_rc(t2_ * 16 + 8192, R1, c_); C1 = c_ * 2; }
    const size_t kstep = (size_t)(BK * 2);
    const size_t hstepB = (size_t)HALF * K * 2;
    const unsigned ldsw = (unsigned)wid * 1024u;
    const int aoff = lds_byte(wr * 64 + fr, fq * 8), boff = lds_byte(wc * 32 + fr, fq * 8);
#define PG8_SA(b, h) (((b) * 2 + (h)) * HTB)
#define PG8_SB(b, h) ((4 + (b) * 2 + (h)) * HTB)
#define PG8_STAGE2(bufoff, gbase, o0, o1) do { \
        __builtin_amdgcn_global_load_lds((const unsigned*)((const char*)(gbase) + (o0)), (LAS unsigned*)(lds + (bufoff) + ldsw), 16, 0, 0); \
        __builtin_amdgcn_global_load_lds((const unsigned*)((const char*)(gbase) + (o1)), (LAS unsigned*)(lds + (bufoff) + ldsw + 8192), 16, 0, 0); } while (0)
#define PG8_STAGEB(bufoff, gbase) PG8_STAGE2(bufoff, gbase, voffB[0], voffB[1])
#define PG8_LD16(off_) (*(const LAS i32x4_t*)(lds + (off_)))
#define PG8_LDA(dst, b, h) do { _Pragma("unroll") for (int m = 0; m < 4; ++m) { \
        if constexpr (FP8) dst##8[m] = __builtin_shufflevector(PG8_LD16(PG8_SA(b, h) + aoff + m * 2048), PG8_LD16(PG8_SA(b, h) + aoff + m * 2048 + 1024), 0, 1, 2, 3, 4, 5, 6, 7); \
        else { _Pragma("unroll") for (int k = 0; k < 2; ++k) dst[m][k] = *(const LAS bf16x8*)(lds + PG8_SA(b, h) + aoff + m * 2048 + k * 1024); } } } while (0)
#define PG8_LDB(dst, b, h) do { _Pragma("unroll") for (int n = 0; n < 2; ++n) { \
        if constexpr (FP8) dst##8[n] = __builtin_shufflevector(PG8_LD16(PG8_SB(b, h) + boff + n * 2048), PG8_LD16(PG8_SB(b, h) + boff + n * 2048 + 1024), 0, 1, 2, 3, 4, 5, 6, 7); \
        else { _Pragma("unroll") for (int k = 0; k < 2; ++k) dst[n][k] = *(const LAS bf16x8*)(lds + PG8_SB(b, h) + boff + n * 2048 + k * 1024); } } } while (0)
#define PG8_MMA(ai, bj, At, Bt) do { __builtin_amdgcn_s_setprio(1); _Pragma("unroll") for (int m = 0; m < 4; ++m) _Pragma("unroll") for (int n = 0; n < 2; ++n) { \
        if constexpr (FP8) asm volatile("v_mfma_f32_16x16x128_f8f6f4 %0, %1, %2, %0" : "+v"(acc[ai][bj][m][n]) : "v"(Bt##8[n]), "v"(At##8[m])); \
        else { _Pragma("unroll") for (int k = 0; k < 2; ++k) acc[ai][bj][m][n] = __builtin_amdgcn_mfma_f32_16x16x32_bf16(Bt[n][k], At[m][k], acc[ai][bj][m][n], 0, 0, 0); } } \
        __builtin_amdgcn_s_setprio(0); } while (0)
#define PG8_WAIT_V(n) asm volatile("s_waitcnt vmcnt(" #n ")" ::: "memory")
#define PG8_WAIT_L(n) asm volatile("s_waitcnt lgkmcnt(" #n ")" ::: "memory")
#define PG8_BAR __builtin_amdgcn_s_barrier()
#define PG8_SCHED __builtin_amdgcn_sched_barrier(0)
    Unit cur, nxt; int ui = 0;
    if (!S.next(0, cur)) return;
    f32x4 acc[2][2][4][2];
    bf16x8 At[4][2], B0[2][2], B1[2][2]; i32x8_t At8[4], B08[2], B18[2];
    unsigned vc00, vc01, vc10, vc11, vn00, vn01, vn10, vn11;
    { PG8_RC(r0, r1, c0, c1); vc00 = S.row_off(cur, r0) + c0; vc01 = S.row_off(cur, r1) + c1; vc10 = S.row_off(cur, HALF + r0) + c0; vc11 = S.row_off(cur, HALF + r1) + c1; }
    const char* cA = cur.A; const char* cB = cur.B;
    PG8_STAGEB(PG8_SB(0, 0), cB); PG8_STAGEB(PG8_SB(0, 1), cB + hstepB); PG8_STAGE2(PG8_SA(0, 0), cA, vc00, vc01); PG8_STAGE2(PG8_SA(0, 1), cA, vc10, vc11);
    if (wr == 1) PG8_BAR;
    PG8_WAIT_V(2); PG8_BAR;
    PG8_STAGEB(PG8_SB(1, 0), cB + kstep); PG8_STAGE2(PG8_SA(1, 0), cA + kstep, vc00, vc01); PG8_STAGEB(PG8_SB(1, 1), cB + hstepB + kstep);
    PG8_WAIT_V(6); PG8_BAR;
#pragma unroll
    for (int a = 0; a < 2; ++a)
#pragma unroll
        for (int b = 0; b < 2; ++b)
#pragma unroll
            for (int m = 0; m < 4; ++m)
#pragma unroll
                for (int n = 0; n < 2; ++n) acc[a][b][m][n] = (f32x4){0.f, 0.f, 0.f, 0.f};
    if constexpr (FP8) asm volatile("s_nop 7" ::: "memory");
    for (;;) {
        const bool has_next = S.next(ui + 1, nxt);
        const char* nA = has_next ? nxt.A : cA; const char* nB = has_next ? nxt.B : cB;
        if (has_next) { PG8_RC(r0, r1, c0, c1); vn00 = S.row_off(nxt, r0) + c0; vn01 = S.row_off(nxt, r1) + c1; vn10 = S.row_off(nxt, HALF + r0) + c0; vn11 = S.row_off(nxt, HALF + r1) + c1; }
        else { vn00 = vc00; vn01 = vc01; vn10 = vc10; vn11 = vc11; }
        for (int t = 0; t < nt; t += 2) {
            const bool last = (t == nt - 2);
            const char* a1 = cA + (size_t)(t + 1) * kstep;
            const char* a2 = last ? nA : cA + (size_t)(t + 2) * kstep; const char* b2 = last ? nB : cB + (size_t)(t + 2) * kstep;
            const char* a3 = a2 + kstep; const char* b3 = b2 + kstep;
            const unsigned x00 = last ? vn00 : vc00, x01 = last ? vn01 : vc01, x10 = last ? vn10 : vc10, x11 = last ? vn11 : vc11;
            PG8_LDB(B0, 0, 0); PG8_LDB(B1, 0, 1); PG8_SCHED; PG8_LDA(At, 0, 0); PG8_STAGE2(PG8_SA(1, 1), a1, vc10, vc11);
            PG8_WAIT_V(8); PG8_WAIT_L(0); PG8_BAR; PG8_MMA(0, 0, At, B0); PG8_MMA(0, 1, At, B1); PG8_BAR; PG8_SCHED;
            PG8_LDA(At, 0, 1); PG8_STAGEB(PG8_SB(0, 0), b2); PG8_STAGEB(PG8_SB(0, 1), b2 + hstepB); PG8_STAGE2(PG8_SA(0, 0), a2, x00, x01);
            PG8_WAIT_V(8); PG8_WAIT_L(0); PG8_BAR; PG8_MMA(1, 0, At, B0); PG8_MMA(1, 1, At, B1); PG8_BAR; PG8_SCHED;
            PG8_LDB(B0, 1, 0); PG8_LDB(B1, 1, 1); PG8_SCHED; PG8_LDA(At, 1, 0); PG8_STAGE2(PG8_SA(0, 1), a2, x10, x11);
            PG8_WAIT_V(8); PG8_WAIT_L(0); PG8_BAR; PG8_MMA(0, 0, At, B0); PG8_MMA(0, 1, At, B1); PG8_BAR; PG8_SCHED;
            PG8_LDA(At, 1, 1); PG8_STAGEB(PG8_SB(1, 0), b3); PG8_STAGEB(PG8_SB(1, 1), b3 + hstepB); PG8_STAGE2(PG8_SA(1, 0), a3, x00, x01);
            PG8_WAIT_V(8); PG8_WAIT_L(0); PG8_BAR; PG8_MMA(1, 0, At, B0); PG8_MMA(1, 1, At, B1); PG8_BAR; PG8_SCHED;
        }
        if constexpr (ALIGN_EPI) { if (wr == 0) PG8_BAR; }
        if constexpr (FP8) asm volatile("s_nop 15\n\ts_nop 7" ::: "memory");
        E(acc, cur, wr, wc, fr, fq);
        if (!has_next) break;
#pragma unroll
        for (int a = 0; a < 2; ++a)
#pragma unroll
            for (int b = 0; b < 2; ++b)
#pragma unroll
                for (int m = 0; m < 4; ++m)
#pragma unroll
                    for (int n = 0; n < 2; ++n) acc[a][b][m][n] = (f32x4){0.f, 0.f, 0.f, 0.f};
        if constexpr (FP8) asm volatile("s_nop 7" ::: "memory");
        cur = nxt; cA = nA; cB = nB; ++ui; vc00 = vn00; vc01 = vn01; vc10 = vn10; vc11 = vn11;
        if constexpr (ALIGN_EPI) { if (wr == 1) PG8_BAR; }
    }
    PG8_WAIT_V(0);
    if constexpr (!ALIGN_EPI) { if (wr == 0) PG8_BAR; }
    PG8_BAR;
#undef PG8_SA
#undef PG8_SB
#undef PG8_STAGE2
#undef PG8_STAGEB
#undef PG8_LDA
#undef PG8_LDB
#undef PG8_MMA
#undef PG8_LD16
#undef PG8_RC
#undef PG8_WAIT_V
#undef PG8_WAIT_L
#undef PG8_BAR
#undef PG8_SCHED
}
}
using pg8::Unit;
using pg8::cvt_pk_bf16;

__device__ __forceinline__ u32x4 pack8(const f32x4& v0, const f32x4& v1) { u32x4 w; w.x = cvt_pk_bf16(v0[0], v0[1]); w.y = cvt_pk_bf16(v0[2], v0[3]); w.z = cvt_pk_bf16(v1[0], v1[1]); w.w = cvt_pk_bf16(v1[2], v1[3]); return w; }
__device__ __forceinline__ f32x4 sig4(const f32x4& v) { return (f32x4){sigmoidf_(v[0]), sigmoidf_(v[1]), sigmoidf_(v[2]), sigmoidf_(v[3])}; }
__device__ __forceinline__ void unpack8(const u32x4& w, f32x4& a, f32x4& b) { a = (f32x4){bflo(w.x), bfhi(w.x), bflo(w.y), bfhi(w.y)}; b = (f32x4){bflo(w.z), bfhi(w.z), bflo(w.w), bfhi(w.w)}; }

struct EpiIn {
    static constexpr bool PERM = true;
    const float* binp; bf16* U; bf16* Q; bf16* KV; bf16* NGt; bf16* GM; float ds;
    __device__ __forceinline__ void operator()(const f32x4 (&acc)[2][2][4][2], const Unit& u, int wr, int wc, int fr, int fq) const {
        const int row0 = u.pm * 256 + wr * 64 + fr, pn = u.pn, cin = wc * 32 + 8 * fq;
        f32x4 bv[2][2];
#pragma unroll
        for (int bj = 0; bj < 2; ++bj)
#pragma unroll
            for (int n = 0; n < 2; ++n) bv[bj][n] = *(const f32x4*)(binp + pn * 256 + bj * 128 + cin + 4 * n);
        if (pn < 4) {
#pragma unroll
            for (int ai = 0; ai < 2; ++ai)
#pragma unroll
                for (int m = 0; m < 4; ++m) { const size_t row = (size_t)(row0 + ai * 128 + m * 16);
                    const f32x4 a0 = (acc[ai][0][m][0] * ds) + bv[0][0], a1 = (acc[ai][0][m][1] * ds) + bv[0][1], g0 = sig4((acc[ai][1][m][0] * ds) + bv[1][0]), g1 = sig4((acc[ai][1][m][1] * ds) + bv[1][1]);
                    *(u32x4*)(U + row * 512 + pn * 128 + cin) = pack8(a0 * g0, a1 * g1); }
        } else if (pn < 14) {
            bf16* base; int ld; float sc = 1.f;
            if (pn < 8) { base = Q + (pn - 4) * 256; ld = 1024; sc = 0.125f; } else { base = KV + (size_t)(pn - 8) * (KV_STRIDE / 2); ld = 256; }
#pragma unroll
            for (int ai = 0; ai < 2; ++ai)
#pragma unroll
                for (int m = 0; m < 4; ++m) { bf16* rp = base + (size_t)(row0 + ai * 128 + m * 16) * ld + cin;
#pragma unroll
                    for (int bj = 0; bj < 2; ++bj) { const f32x4 va = ((acc[ai][bj][m][0] * ds) + bv[bj][0]) * sc, vb = ((acc[ai][bj][m][1] * ds) + bv[bj][1]) * sc;
                        if (pn == 8 || pn == 9) *(u32x2*)((unsigned char*)KV + (size_t)(pn - 8) * KV_STRIDE + (size_t)(row0 + ai * 128 + m * 16) * 256 + cin + bj * 128) = (u32x2){f8pack4(va[0], va[1], va[2], va[3], F8_SKV), f8pack4(vb[0], vb[1], vb[2], vb[3], F8_SKV)};
                        else *(u32x4*)(rp + bj * 128) = pack8(va, vb); } }
        } else if (pn == 14) {
            if (wc < 2) {
#pragma unroll
                for (int ai = 0; ai < 2; ++ai)
#pragma unroll
                    for (int m = 0; m < 4; ++m) { const size_t row = (size_t)(row0 + ai * 128 + m * 16);
                        *(u32x4*)(NGt + row * 64 + cin) = pack8(sig4((acc[ai][0][m][0] * ds) + bv[0][0]), sig4((acc[ai][0][m][1] * ds) + bv[0][1])); }
            }
        } else {
#pragma unroll
            for (int ai = 0; ai < 2; ++ai)
#pragma unroll
                for (int m = 0; m < 4; ++m) { bf16* rp = GM + (size_t)(row0 + ai * 128 + m * 16) * 2048 + (pn - 15) * 256 + cin;
#pragma unroll
                    for (int bj = 0; bj < 2; ++bj) *(u32x4*)(rp + bj * 128) = pack8(sig4((acc[ai][bj][m][0] * ds) + bv[bj][0]), sig4((acc[ai][bj][m][1] * ds) + bv[bj][1])); }
        }
    }
};

template <int MODE> struct EpiMix {
    static constexpr bool PERM = true;
    const bf16* GM; bf16* MIX; const float* bias; unsigned char* MIX8; float ds;
    __device__ __forceinline__ void operator()(const f32x4 (&acc)[2][2][4][2], const Unit& u, int wr, int wc, int fr, int fq) const {
        const int row0 = u.pm * 256 + wr * 64 + fr, col0 = u.pn * 256 + wc * 32 + 8 * fq;
        f32x4 bv[2][2];
#pragma unroll
        for (int bj = 0; bj < 2; ++bj)
#pragma unroll
            for (int n = 0; n < 2; ++n) bv[bj][n] = (MODE == 0) ? *(const f32x4*)(bias + col0 + bj * 128 + 4 * n) : (f32x4){0.f, 0.f, 0.f, 0.f};
#pragma unroll
        for (int ai = 0; ai < 2; ++ai)
#pragma unroll
            for (int m = 0; m < 4; ++m) { const size_t row = (size_t)(row0 + ai * 128 + m * 16);
#pragma unroll
                for (int bj = 0; bj < 2; ++bj) { const int col = col0 + bj * 128;
                    f32x4 g0, g1; unpack8(*(const u32x4*)(GM + row * 2048 + MODE * 1024 + col), g0, g1);
                    f32x4 v0 = (acc[ai][bj][m][0] * ds + bv[bj][0]) * g0, v1 = (acc[ai][bj][m][1] * ds + bv[bj][1]) * g1;
                    if (MODE == 1) { f32x4 p0, p1; unpack8(*(const u32x4*)(MIX + row * 1024 + col), p0, p1); v0 += p0; v1 += p1; }
                    if (MODE == 1 && MIX8) *(u32x2*)(MIX8 + row * 1024 + col) = (u32x2){f8pack4(v0[0], v0[1], v0[2], v0[3], F8_SMIX), f8pack4(v1[0], v1[1], v1[2], v1[3], F8_SMIX)};
                    else *(u32x4*)(MIX + row * 1024 + col) = pack8(v0, v1); } }
    }
};

struct EpiOut {
    static constexpr bool PERM = false;
    const float* x; bf16* x1; const float* g1; float ds;
    __device__ __forceinline__ void operator()(const f32x4 (&acc)[2][2][4][2], const Unit& u, int wr, int wc, int fr, int fq) const {
        const int row0 = u.pm * 256 + wr * 64 + fr, col0 = u.pn * 256 + wc * 32 + 4 * fq; const int b = (u.pm * 256) >> 13;
        f32x4 gv[2][2];
#pragma unroll
        for (int bj = 0; bj < 2; ++bj)
#pragma unroll
            for (int n = 0; n < 2; ++n) gv[bj][n] = *(const f32x4*)(g1 + b * 6144 + col0 + bj * 128 + 16 * n) * ds;
#pragma unroll
        for (int ai = 0; ai < 2; ++ai)
#pragma unroll
            for (int m = 0; m < 4; ++m) { const size_t off = (size_t)(row0 + ai * 128 + m * 16) * 1024 + col0;
#pragma unroll
                for (int bj = 0; bj < 2; ++bj)
#pragma unroll
                    for (int n = 0; n < 2; ++n) { const f32x4 xv = *(const f32x4*)(x + off + bj * 128 + 16 * n); const f32x4 y = xv + gv[bj][n] * acc[ai][bj][m][n];
                        *(u32x2*)(x1 + off + bj * 128 + 16 * n) = (u32x2){cvt_pk_bf16(y[0], y[1]), cvt_pk_bf16(y[2], y[3])}; } }
    }
};

struct EpiLogits {
    static constexpr bool PERM = false;
    float* L;
    __device__ __forceinline__ void operator()(const f32x4 (&acc)[2][2][4][2], const Unit& u, int wr, int wc, int fr, int fq) const {
        const int row0 = u.pm * 256 + wr * 64 + fr, col0 = wc * 32 + 4 * fq;
#pragma unroll
        for (int ai = 0; ai < 2; ++ai)
#pragma unroll
            for (int m = 0; m < 4; ++m) { const size_t off = (size_t)(row0 + ai * 128 + m * 16) * 256 + col0;
#pragma unroll
                for (int bj = 0; bj < 2; ++bj)
#pragma unroll
                    for (int n = 0; n < 2; ++n) *(f32x4*)(L + off + bj * 128 + 16 * n) = acc[ai][bj][m][n]; }
    }
};

struct EpiAct {
    static constexpr bool PERM = true;
    unsigned char* ACT; unsigned char* ACTSH;
    __device__ __forceinline__ void operator()(const f32x4 (&acc)[2][2][4][2], const Unit& u, int wr, int wc, int fr, int fq) const {
        const int slot0 = u.mt * 256 + wr * 64 + fr, col = (u.pn & 1) * 128 + wc * 32 + 8 * fq;
        unsigned char* base = (u.e == NEXP) ? ACTSH : ACT + (size_t)u.off * 256;
        constexpr float ds = 1.0f / (F8_SX * F8_SWG);
#pragma unroll
        for (int ai = 0; ai < 2; ++ai)
#pragma unroll
            for (int m = 0; m < 4; ++m) { const int slot = slot0 + ai * 128 + m * 16;
                if (slot < u.cnt) { const f32x4 g0 = acc[ai][0][m][0] * ds, g1 = acc[ai][0][m][1] * ds;
                    const f32x4 a0 = g0 * sig4(g0) * (acc[ai][1][m][0] * ds), a1 = g1 * sig4(g1) * (acc[ai][1][m][1] * ds);
                    *(u32x2*)(base + (size_t)slot * 256 + col) = (u32x2){f8pack4(a0[0], a0[1], a0[2], a0[3], F8_SACT), f8pack4(a1[0], a1[1], a1[2], a1[3], F8_SACT)}; } }
    }
};

constexpr float YS_SCALE = 16.0f;
__device__ __forceinline__ unsigned pack4_fp8(const f32x4& v) {
    const float a = __builtin_amdgcn_fmed3f(v[0] * YS_SCALE, -448.f, 448.f), b = __builtin_amdgcn_fmed3f(v[1] * YS_SCALE, -448.f, 448.f);
    const float c = __builtin_amdgcn_fmed3f(v[2] * YS_SCALE, -448.f, 448.f), d = __builtin_amdgcn_fmed3f(v[3] * YS_SCALE, -448.f, 448.f);
    int w = __builtin_amdgcn_cvt_pk_fp8_f32(a, b, 0, false); w = __builtin_amdgcn_cvt_pk_fp8_f32(c, d, w, true); return (unsigned)w;
}
__device__ __forceinline__ f32x4 unpack4_fp8(unsigned w) { const f32x2 lo = __builtin_amdgcn_cvt_pk_f32_fp8((int)w, false), hi = __builtin_amdgcn_cvt_pk_f32_fp8((int)w, true); return (f32x4){lo.x, lo.y, hi.x, hi.y}; }
struct EpiDown {
    static constexpr bool PERM = true;
    unsigned char* YS8; bf16* YSS;
    __device__ __forceinline__ void operator()(const f32x4 (&acc)[2][2][4][2], const Unit& u, int wr, int wc, int fr, int fq) const {
        const int slot0 = u.mt * 256 + wr * 64 + fr, cin = wc * 32 + 8 * fq;
        if (u.e == NEXP) {
            bf16* rowp0 = YSS + (size_t)slot0 * 1024 + u.pn * 256 + cin;
#pragma unroll
            for (int ai = 0; ai < 2; ++ai)
#pragma unroll
                for (int m = 0; m < 4; ++m)
#pragma unroll
                    for (int bj = 0; bj < 2; ++bj) *(u32x4*)(rowp0 + (size_t)(ai * 128 + m * 16) * 1024 + bj * 128) = pack8(acc[ai][bj][m][0] * (1.0f / (F8_SACT * F8_SWD)), acc[ai][bj][m][1] * (1.0f / (F8_SACT * F8_SWD)));
        } else {
            const int colb = u.pn * 256 + cin;
#pragma unroll
            for (int ai = 0; ai < 2; ++ai)
#pragma unroll
                for (int m = 0; m < 4; ++m) { const int slot = slot0 + ai * 128 + m * 16;
                    if (slot < u.cnt) { unsigned char* rowp = YS8 + (size_t)(u.off + slot) * 1024 + colb;
#pragma unroll
                        for (int bj = 0; bj < 2; ++bj) *(u32x2*)(rowp + bj * 128) = (u32x2){pack4_fp8(acc[ai][bj][m][0] * (1.0f / (F8_SACT * F8_SWD))), pack4_fp8(acc[ai][bj][m][1] * (1.0f / (F8_SACT * F8_SWD)))}; } }
        }
    }
};

struct ExpertOrder {
    LAS const int* tab; const char* Abase; const char* Bexp; const char* Bsh; const char* Ash; const int* tokl; int mode, umul, G, c, nunits;
    __device__ __forceinline__ bool next(int i, Unit& u) const {
        const int L = i * G + c; if (L >= nunits) return false;
        int lo = 0, hi = NEXP + 1;
        while (hi - lo > 1) { const int mid = (lo + hi) >> 1; if (__builtin_amdgcn_readfirstlane(tab[260 + mid]) * umul <= L) lo = mid; else hi = mid; }
        const int e = lo, cnt = __builtin_amdgcn_readfirstlane(tab[e]), nte = (cnt + 255) >> 8, r = L - __builtin_amdgcn_readfirstlane(tab[260 + e]) * umul, j = r / nte, mt = r - j * nte;
        u.e = e; u.mt = mt; u.cnt = cnt; u.off = __builtin_amdgcn_readfirstlane(tab[520 + e]); u.pm = 0;
        if (mode == 0) { u.pn = j; u.A = Abase; u.B = (e == NEXP) ? Bsh + (size_t)j * 256 * 1024 : Bexp + ((size_t)e * 512 + j * 256) * 1024; }
        else { const int pn = j; u.pn = pn;
            u.A = (e == NEXP) ? Ash + (size_t)mt * 256 * 256 : Abase + ((size_t)u.off + (size_t)mt * 256) * 256;
            u.B = (e == NEXP) ? Bsh + (size_t)pn * 256 * 256 : Bexp + ((size_t)e * 1024 + pn * 256) * 256; }
        return true;
    }
    __device__ __forceinline__ unsigned row_off(const Unit& u, int r) const {
        if (mode == 0) { const int slot = u.mt * 256 + r; int tok = slot; if (u.e != NEXP) tok = (slot < u.cnt) ? tokl[(size_t)u.e * T + slot] : 0; return (unsigned)tok * 1024u; }
        return (unsigned)r * 256u;
    }
};

#define XB_TMO      128
#define XB_XCNT(j)  (256  + 64 * (j))
#define XB_XSUB(j)  (1280 + 64 * (j))
#define XB_XGEN(j)  (2304 + 64 * (j))
#define XB_TOP      3328
#define XB_TOPGEN   3392
#define XCD_BAR_WORDS 3456
#define XB_SPIN_CAP (1u << 22)
__device__ __forceinline__ unsigned xb_ld(unsigned* p)              { return __hip_atomic_load(p, __ATOMIC_RELAXED, __HIP_MEMORY_SCOPE_AGENT); }
__device__ __forceinline__ unsigned xb_add(unsigned* p, unsigned v) { return __hip_atomic_fetch_add(p, v, __ATOMIC_RELAXED, __HIP_MEMORY_SCOPE_AGENT); }
__device__ __forceinline__ unsigned xb_xcc_id() { return (unsigned)__builtin_amdgcn_s_getreg((3 << 11) | 20) & 0xFu; }
#define XB_SPIN(cond, bar) do { unsigned _sp = 0; while (cond) { __builtin_amdgcn_s_sleep(1); \
    if ((++_sp & 255u) == 0u) { if (xb_ld(&(bar)[XB_TMO])) break; if (_sp > XB_SPIN_CAP) { atomicAdd(&(bar)[XB_TMO], 1u); break; } } } } while (0)
struct XcdBarrier { unsigned* bar; unsigned x; volatile LAS unsigned* st; int wave; };
__device__ __forceinline__ XcdBarrier xcd_barrier_post(unsigned* bar, volatile LAS unsigned* st, int wave) {
    XcdBarrier b; b.bar = bar; b.x = xb_xcc_id(); b.st = st; b.wave = wave;
    if (wave == 0 && fresh_lane() == 0) (void)xb_add(&bar[XB_XCNT(b.x)], 1u);
    return b;
}
__device__ __forceinline__ void xcd_barrier_complete(unsigned* bar, unsigned x, unsigned& nloc, unsigned& nx) {
    const unsigned G = gridDim.x * gridDim.y * gridDim.z;
    unsigned sum, cnt, mine, sp = 0u;
    for (;;) {
        sum = 0u; cnt = 0u; mine = 0u;
#pragma unroll
        for (unsigned j = 0; j < 16; ++j) { const unsigned c = xb_ld(&bar[XB_XCNT(j)]); sum += c; cnt += (c > 0u) ? 1u : 0u; mine = (j == x) ? c : mine; }
        if (sum == G) break;
        __builtin_amdgcn_s_sleep(1);
        if ((++sp & 255u) == 0u) { if (xb_ld(&bar[XB_TMO])) break; if (sp > XB_SPIN_CAP) { atomicAdd(&bar[XB_TMO], 1u); break; } }
    }
    nloc = mine > 0u ? mine : 1u; nx = cnt > 0u ? cnt : 1u;
}
__device__ __forceinline__ void xcd_barrier(const XcdBarrier& b) {
    asm volatile("s_waitcnt vmcnt(0)" ::: "memory");
    __syncthreads();
    if (b.wave == 0 && fresh_lane() == 0) {
        unsigned* bar = b.bar;
        __builtin_amdgcn_s_waitcnt(0);
        unsigned nloc = b.st[0], nx = b.st[1];
        if (nloc == 0u) { xcd_barrier_complete(bar, b.x, nloc, nx); b.st[0] = nloc; b.st[1] = nx; }
        const unsigned old = xb_add(&bar[XB_XSUB(b.x)], 1u);
        const unsigned gen = old / nloc;
        if (old + 1u == (gen + 1u) * nloc) {
            __builtin_amdgcn_fence(__ATOMIC_RELEASE, "agent");
            asm volatile("s_waitcnt vmcnt(0)" ::: "memory");
            const unsigned og = xb_add(&bar[XB_TOP], 1u);
            const unsigned tg = og / nx;
            if (og + 1u == (tg + 1u) * nx) xb_add(&bar[XB_TOPGEN], 1u);
            else XB_SPIN(xb_ld(&bar[XB_TOPGEN]) == tg, bar);
            __builtin_amdgcn_fence(__ATOMIC_ACQUIRE, "agent");
            xb_add(&bar[XB_XGEN(b.x)], 1u);
            asm volatile("s_waitcnt vmcnt(0)" ::: "memory");
        } else {
            XB_SPIN(xb_ld(&bar[XB_XGEN(b.x)]) == gen, bar);
            __builtin_amdgcn_fence(__ATOMIC_ACQUIRE, "agent");
            asm volatile("s_waitcnt vmcnt(0)" ::: "memory");
        }
    }
    __syncthreads();
}
#ifndef F8_WIN
#define F8_WIN 1
#endif
#ifndef F8_WOUT
#define F8_WOUT 1
#endif
struct Args { const float* in[31]; float* out; unsigned char* ws; int ph_lo, ph_hi, li, pad; };
struct Frame {
    LAS unsigned char* lds;
    volatile LAS unsigned* MISC;
    gu32* ctl;
    int tid, lane, wave, vcu, G;
    unsigned char* ws;
    float* out;
};
#define AIN args.in
enum { I_X = 0, I_C, I_WADA, I_BADA, I_N1G, I_WIN, I_BIN, I_CONVW, I_CONVB, I_LNG, I_LNB, I_WCO, I_BCO, I_PEK, I_W1K, I_W2K, I_PEV, I_W1V, I_W2V, I_WNSA, I_WOUT, I_N2G, I_WR, I_RB, I_SHG, I_SHU, I_SHD, I_WG, I_WU, I_WDN, I_FG };

__device__ __forceinline__ void xpose_item(const float* W, int ldw, int ncols, bf16* WT, int K, LAS float* scr, int kb, int nb, int lane, float f8s = 0.f) {
    const int k0 = 64 * kb, n0 = 32 * nb, c4 = 4 * (lane & 7), rg = lane >> 3; const bool nv = (n0 + c4) < ncols;
    f32x4 v[8];
#pragma unroll
    for (int i = 0; i < 8; ++i) v[i] = nv ? *(const f32x4*)(W + (size_t)(k0 + 8 * i + rg) * ldw + n0 + c4) : (f32x4){0.f, 0.f, 0.f, 0.f};
#pragma unroll
    for (int i = 0; i < 8; ++i) { LAS float* p = scr + (8 * i + rg) * 33 + c4; p[0] = v[i].x; p[1] = v[i].y; p[2] = v[i].z; p[3] = v[i].w; }
    LDS_WAIT(); asm volatile("" ::: "memory");
    const int c = lane & 7;
#pragma unroll
    for (int j = 0; j < 4; ++j) { const int n = (lane >> 3) + 8 * j; const LAS float* s = scr + (8 * c) * 33 + n;
        if (f8s > 0.f) { *(GAS u32x2*)((unsigned char*)WT + (size_t)(n0 + n) * K + k0 + 8 * c) = (u32x2){f8pack4(s[0 * 33], s[1 * 33], s[2 * 33], s[3 * 33], f8s), f8pack4(s[4 * 33], s[5 * 33], s[6 * 33], s[7 * 33], f8s)}; }
        else { u32x4 o; o.x = pk2(s[0 * 33], s[1 * 33]); o.y = pk2(s[2 * 33], s[3 * 33]); o.z = pk2(s[4 * 33], s[5 * 33]); o.w = pk2(s[6 * 33], s[7 * 33]);
            *(GAS u32x4*)(WT + (size_t)(n0 + n) * K + k0 + 8 * c) = o; } }
    LDS_WAIT(); asm volatile("" ::: "memory");
}
#define XSEC8(Wp, ldw, ncols, WTp, K, nbl, f8s) do { const int _n = ((K) / 64) * (nbl); if (r < _n) { xpose_item((Wp), (ldw), (ncols), (WTp), (K), scr, r / (nbl), r % (nbl), F.lane, (f8s)); return; } r -= _n; } while (0)
#define XSEC(Wp, ldw, ncols, WTp, K, nbl) XSEC8(Wp, ldw, ncols, WTp, K, nbl, 0.f)

__device__ __forceinline__ void p0_small_item(Frame& F, const Args& args, LAS float* scr, int r) {
    const float* w_in = AIN[I_WIN];
#if F8_WIN
    unsigned char* WINB = F.ws + WS_WIN;
#define WIN_SEC(Wp, ncols, drow, nbl) XSEC8(Wp, NIN, ncols, (bf16*)(WINB + (size_t)(drow) * 1024), 1024, nbl, F8_SWG)
#else
    bf16* WIN = (bf16*)(F.ws + WS_WIN);
#define WIN_SEC(Wp, ncols, drow, nbl) XSEC(Wp, NIN, ncols, WIN + (size_t)(drow) * 1024, 1024, nbl)
#endif
#pragma unroll 1
    for (int p = 0; p < 4; ++p) { WIN_SEC(w_in + 128 * p, 128, 256 * p, 4); }
#pragma unroll 1
    for (int p = 0; p < 4; ++p) { WIN_SEC(w_in + 512 + 128 * p, 128, 256 * p + 128, 4); }
    WIN_SEC(w_in + 1024, 2560, 1024, 80);
    WIN_SEC(w_in + 3584, 48, 3584, 8);
    WIN_SEC(w_in + 3632, 2048, 3840, 64);
#undef WIN_SEC
#if F8_MIXA
    XSEC8(AIN[I_WCO], 1024, 1024, (bf16*)(F.ws + WS_WC), 512, 32, F8_SWC);
#else
    XSEC(AIN[I_WCO], 1024, 1024, (bf16*)(F.ws + WS_WC), 512, 32);
#endif
#if F8_MIXB
    XSEC8(AIN[I_WNSA], 1024, 1024, (bf16*)(F.ws + WS_WN), 1024, 32, F8_SWG);
#else
    XSEC(AIN[I_WNSA], 1024, 1024, (bf16*)(F.ws + WS_WN), 1024, 32);
#endif
#if F8_WOUT
    XSEC8(AIN[I_WOUT], 1024, 1024, (bf16*)(F.ws + WS_WO), 1024, 32, F8_SWG);
#else
    XSEC(AIN[I_WOUT], 1024, 1024, (bf16*)(F.ws + WS_WO), 1024, 32);
#endif
    XSEC(AIN[I_WR], 256, 256, (bf16*)(F.ws + WS_WR), 1024, 8);
#pragma unroll 1
    for (int p = 0; p < 2; ++p) { XSEC8(AIN[I_SHG] + 128 * p, 256, 128, (bf16*)(F.ws + WS_WSHGU + (size_t)(256 * p) * 1024), 1024, 4, F8_SWG); }
#pragma unroll 1
    for (int p = 0; p < 2; ++p) { XSEC8(AIN[I_SHU] + 128 * p, 256, 128, (bf16*)(F.ws + WS_WSHGU + (size_t)(256 * p + 128) * 1024), 1024, 4, F8_SWG); }
    XSEC8(AIN[I_SHD], 1024, 1024, (bf16*)(F.ws + WS_WSHD), 256, 32, F8_SWD);
    if (r < 256) {
        const int which = r >> 7, l = (r >> 2) & 31, ct = r & 3, lane = F.lane, c32 = lane & 31, hi = lane >> 5;
        const float* q = AIN[which ? I_W1V : I_W1K] + (size_t)(64 * l + 32 * hi) * 128 + 32 * ct + c32;
        unsigned char* dst = F.ws + WS_CW1 + ((size_t)(((which * 32 + l) * 4 + ct) * 64) + lane) * 32;
        u32x4 o0, o1;
        o0.x = f8pack4(q[0 * 128], q[1 * 128], q[2 * 128], q[3 * 128], F8_SW1); o0.y = f8pack4(q[4 * 128], q[5 * 128], q[6 * 128], q[7 * 128], F8_SW1);
        o0.z = f8pack4(q[8 * 128], q[9 * 128], q[10 * 128], q[11 * 128], F8_SW1); o0.w = f8pack4(q[12 * 128], q[13 * 128], q[14 * 128], q[15 * 128], F8_SW1);
        o1.x = f8pack4(q[16 * 128], q[17 * 128], q[18 * 128], q[19 * 128], F8_SW1); o1.y = f8pack4(q[20 * 128], q[21 * 128], q[22 * 128], q[23 * 128], F8_SW1);
        o1.z = f8pack4(q[24 * 128], q[25 * 128], q[26 * 128], q[27 * 128], F8_SW1); o1.w = f8pack4(q[28 * 128], q[29 * 128], q[30 * 128], q[31 * 128], F8_SW1);
        *(GAS u32x4*)dst = o0; *(GAS u32x4*)(dst + 16) = o1;
        return; }
    r -= 256;
    XSEC(AIN[I_W2K], 64, 64, (bf16*)(F.ws + WS_CW2), 128, 2);
    XSEC(AIN[I_W2V], 64, 64, (bf16*)(F.ws + WS_CW2) + 64 * 128, 128, 2);
}
constexpr int P0_SMALL_ITEMS = 8 * 64 + 1280 + 128 + 1024 + 256 + 512 + 512 + 128 + 4 * 64 + 128 + 128 + 128 + 4 + 4;
struct XDesc { const float* src; unsigned char* dst; int ldw, K; float sc; };
__device__ __forceinline__ XDesc expert_desc(Frame& F, const Args& args, int it) {
    const int e = it / 192, r = it - e * 192; XDesc d;
    if (r < 128) { const int up = r >> 6, q = r & 63, kb = q >> 2, nb = q & 3, p = nb >> 1, o = (nb & 1) * 64;
        d.src = (up ? AIN[I_WU] : AIN[I_WG]) + (size_t)e * 1024 * 256 + (size_t)(64 * kb) * 256 + 128 * p + o; d.ldw = 256; d.K = 1024; d.sc = F8_SWG;
        d.dst = (unsigned char*)(F.ws + WS_WGU) + (size_t)e * 512 * 1024 + (size_t)(256 * p + 128 * up + o) * 1024 + 64 * kb; }
    else { const int rr = r - 128, kb = rr >> 4, nb = rr & 15;
        d.src = AIN[I_WDN] + (size_t)e * 256 * 1024 + (size_t)(64 * kb) * 1024 + 64 * nb; d.ldw = 1024; d.K = 256; d.sc = F8_SWD;
        d.dst = (unsigned char*)(F.ws + WS_WD) + (size_t)e * 1024 * 256 + (size_t)(64 * nb) * 256 + 64 * kb; }
    return d;
}
__device__ __forceinline__ void xload(const XDesc& d, f32x4 (&v)[16], int lane) {
    const int c4 = 4 * (lane & 15), rg = lane >> 4;
#pragma unroll
    for (int i = 0; i < 16; ++i) v[i] = *(const f32x4*)(d.src + (size_t)(4 * i + rg) * d.ldw + c4);
}
__device__ __forceinline__ void xstore(const XDesc& d, const f32x4 (&v)[16], LAS float* scr, int lane) {
    const int c4 = 4 * (lane & 15), rg = lane >> 4;
#pragma unroll
    for (int i = 0; i < 16; ++i) { LAS float* p = scr + (4 * i + rg) * 65 + c4; p[0] = v[i].x; p[1] = v[i].y; p[2] = v[i].z; p[3] = v[i].w; }
    LDS_WAIT(); asm volatile("" ::: "memory");
    const int c = lane & 7;
#pragma unroll
    for (int j = 0; j < 8; ++j) { const int n = (lane >> 3) + 8 * j; const LAS float* s = scr + (8 * c) * 65 + n;
        *(GAS u32x2*)(d.dst + (size_t)n * d.K + 8 * c) = (u32x2){f8pack4(s[0 * 65], s[1 * 65], s[2 * 65], s[3 * 65], d.sc), f8pack4(s[4 * 65], s[5 * 65], s[6 * 65], s[7 * 65], d.sc)}; }
    LDS_WAIT(); asm volatile("" ::: "memory");
}
__device__ __forceinline__ void p0_mod_item(Frame& F, const Args& args, int it) {
    const int kc = it / 96, nc = it - kc * 96;
    const float* W = AIN[I_WADA] + (size_t)(128 * kc) * 6144 + 64 * nc + F.lane; const float* c = AIN[I_C] + 128 * kc;
    float a0 = 0.f, a1 = 0.f, a2 = 0.f, a3 = 0.f;
#pragma unroll 8
    for (int k = 0; k < 128; ++k) { const float w = W[(size_t)k * 6144];
        const float c0 = c[k], c1 = c[1024 + k], c2 = c[2048 + k], c3 = c[3072 + k];
        a0 += c0 * sigmoidf_(c0) * w; a1 += c1 * sigmoidf_(c1) * w; a2 += c2 * sigmoidf_(c2) * w; a3 += c3 * sigmoidf_(c3) * w; }
    float* P = (float*)(F.ws + WS_MODP) + (size_t)kc * 4 * 6144 + 64 * nc + F.lane;
    P[0] = a0; P[6144] = a1; P[2 * 6144] = a2; P[3 * 6144] = a3;
}
__device__ __forceinline__ void p0_peb_item(Frame& F, const Args& args, int it) {
    const int which = it & 1, cc = (it >> 1) & 1, kc = it >> 2;
    const float* pe = AIN[which ? I_PEV : I_PEK] + 256 * kc; const float* w1 = AIN[which ? I_W1V : I_W1K] + (size_t)(256 * kc) * 128 + 64 * cc + F.lane;
    float a = 0.f;
#pragma unroll 8
    for (int k = 0; k < 256; ++k) a += pe[k] * w1[(size_t)k * 128];
    ((float*)(F.ws + WS_PEBP))[(kc * 2 + which) * 128 + 64 * cc + F.lane] = a;
}
__device__ __forceinline__ int binp_src(int d) {
    if (d < 1024) { const int p = d >> 8, o = d & 255; return (o < 128) ? 128 * p + o : 512 + 128 * p + (o - 128); }
    if (d < 3584) return d;
    if (d < 3840) return (d - 3584 < 48) ? d : -1;
    return 3632 + (d - 3840);
}
constexpr int XC_TOTAL = NEXP * 192;
#ifndef XC_R2
#define XC_R2 4096
#endif
#ifndef XC_R9
#define XC_R9 11264
#endif
constexpr int XC_N0 = XC_TOTAL - XC_R2 - XC_R9, XC_N1 = XC_TOTAL - XC_R9;
__device__ __forceinline__ void expert_convert(Frame& F, const Args& args, const int first, const int last, const int gw, const int ngw) {
    int it = first + gw; f32x4 va[16], vb[16]; XDesc da, db;
    LAS float* scr = (LAS float*)(F.lds + RING_OFF) + F.wave * (64 * 65);
    if (it < last) { da = expert_desc(F, args, it); xload(da, va, F.lane); }
#pragma unroll 1
    while (it < last) {
        const int i1 = it + ngw; if (i1 < last) { db = expert_desc(F, args, i1); xload(db, vb, F.lane); }
        xstore(da, va, scr, F.lane);
        if (i1 >= last) break;
        const int i2 = i1 + ngw; if (i2 < last) { da = expert_desc(F, args, i2); xload(da, va, F.lane); }
        xstore(db, vb, scr, F.lane);
        it = i2;
    }
}
__device__ __forceinline__ void p0_prologue(Frame& F, const Args& args) {
    LAS float* scr = (LAS float*)(F.lds + RING_OFF + F.wave * 16384);
    const int gw = F.vcu * NWAVES + F.wave, NGW = F.G * NWAVES;
    constexpr int N_MOD = 768, N_PEB = 32;
    constexpr int N_PRE = N_MOD + N_PEB + P0_SMALL_ITEMS;
    for (int it = gw; it < N_PRE; it += NGW) {
        int r = it;
        if (r < N_MOD) { p0_mod_item(F, args, r); continue; } r -= N_MOD;
        if (r < N_PEB) { p0_peb_item(F, args, r); continue; } r -= N_PEB;
        p0_small_item(F, args, scr, r);
    }
    __syncthreads();
    expert_convert(F, args, 0, XC_N0, gw, NGW);
    float* binp = (float*)(F.ws + WS_BINP);
    for (int d = gw * 64 + F.lane; d < NINP; d += NGW * 64) { const int s = binp_src(d); binp[d] = (s >= 0) ? AIN[I_BIN][s] : 0.f; }
}

__device__ __forceinline__ float modsum(const Frame& F, const Args& args, int b, int j) {
    const float* P = (const float*)(F.ws + WS_MODP) + (size_t)b * 6144 + j; float s = AIN[I_BADA][j];
#pragma unroll
    for (int kc = 0; kc < 8; ++kc) s += P[(size_t)kc * 4 * 6144];
    return s;
}
template <bool FROM_PARTIALS, bool SRC_BF16 = false>
__device__ __forceinline__ void norm_mod_rows(Frame& F, const Args& args, const float* src, bf16* dst, const float* gam, int shift_off, int scale_off, unsigned char* dst8 = nullptr, int tile_blk0 = -1) {
    const int gw = F.vcu * NWAVES + F.wave, NGW = F.G * NWAVES;
    const int blk_lo = (tile_blk0 >= 0) ? tile_blk0 + F.wave : gw, blk_hi = (tile_blk0 >= 0) ? tile_blk0 + 16 : T / 16, blk_st = (tile_blk0 >= 0) ? NWAVES : NGW;
    for (int blk = blk_lo; blk < blk_hi; blk += blk_st) {
        const int m0 = blk * 16, b = m0 >> 13;
        f32x4 av[4], sv[4];
#pragma unroll
        for (int j = 0; j < 4; ++j) { const int col = 4 * F.lane + 256 * j; const f32x4 g = *(const f32x4*)(gam + col); f32x4 sc, sh;
            if (FROM_PARTIALS) {
#pragma unroll
                for (int q = 0; q < 4; ++q) { sc[q] = modsum(F, args, b, scale_off + col + q); sh[q] = modsum(F, args, b, shift_off + col + q); }
            } else { const float* mf = (const float*)(F.ws + WS_MODF) + b * 6144; sc = *(const f32x4*)(mf + scale_off + col); sh = *(const f32x4*)(mf + shift_off + col); }
            av[j] = g * (sc + 1.0f); sv[j] = sh; }
#pragma unroll 2
        for (int i = 0; i < 16; ++i) {
            f32x4 v[4]; float s = 0.f;
            if (SRC_BF16) { const GAS u32x2* xb = (const GAS u32x2*)((const bf16*)src + (size_t)(m0 + i) * 1024) + F.lane;
#pragma unroll
                for (int j = 0; j < 4; ++j) { const u32x2 w = xb[64 * j]; v[j] = (f32x4){bflo(w.x), bfhi(w.x), bflo(w.y), bfhi(w.y)}; }
            } else { const GAS f32x4* xr = (const GAS f32x4*)(src + (size_t)(m0 + i) * 1024) + F.lane;
#pragma unroll
                for (int j = 0; j < 4; ++j) v[j] = xr[64 * j]; }
#pragma unroll
            for (int j = 0; j < 4; ++j) s += (v[j].x * v[j].x + v[j].y * v[j].y) + (v[j].z * v[j].z + v[j].w * v[j].w);
            const float rstd = 1.0f / sqrtf(wave_sum(s) * (1.0f / 1024.0f) + EPS);
            GAS u32x2* o8 = (GAS u32x2*)(dst + (size_t)(m0 + i) * 1024) + F.lane;
#pragma unroll
            for (int j = 0; j < 4; ++j) { const f32x4 y = v[j] * rstd * av[j] + sv[j]; if (dst) { u32x2 w; w.x = pk2(y.x, y.y); w.y = pk2(y.z, y.w); o8[64 * j] = w; }
                if (dst8) ((GAS unsigned*)(dst8 + (size_t)(m0 + i) * 1024))[F.lane + 64 * j] = f8pack4(y.x, y.y, y.z, y.w, F8_SX); }
        }
    }
}
__device__ __forceinline__ void finalize_mod(Frame& F, const Args& args) {
    const int gw = F.vcu * NWAVES + F.wave, NGW = F.G * NWAVES;
    for (int it = gw; it < 384; it += NGW) { const int b = it / 96, j = (it % 96) * 64 + F.lane; ((float*)(F.ws + WS_MODF))[b * 6144 + j] = modsum(F, args, b, j); }
    for (int it = gw; it < 388 && it >= 384; it += NGW) { const int idx = (it - 384) * 64 + F.lane; float s = 0.f;
#pragma unroll
        for (int kc = 0; kc < 8; ++kc) s += ((const float*)(F.ws + WS_PEBP))[kc * 256 + idx];
        ((float*)(F.ws + WS_PEBF))[idx] = s; }
}

__device__ __forceinline__ void conv_phase(Frame& F, const Args& args) {
    const bf16* U = (const bf16*)(F.ws + WS_U); bf16* CF = (bf16*)(F.ws + WS_CF);
    LAS float* cv = (LAS float*)(F.lds + RING_OFF);
    const int c = F.tid;
    float w[CONVK];
#pragma unroll
    for (int j = 0; j < CONVK; ++j) w[j] = AIN[I_CONVW][j * 512 + c];
    const float cb = AIN[I_CONVB][c];
    for (int it = F.vcu; it < T / 32; it += F.G) {
        const int m0 = it * 32, s0 = m0 & (SEQ - 1);
        float uv[62];
#pragma unroll
        for (int i = 0; i < 62; ++i) { const int s = s0 - 30 + i; uv[i] = (s >= 0) ? bf2f(U[(size_t)(m0 - 30 + i) * 512 + c]) : 0.f; }
#pragma unroll
        for (int tt = 0; tt < 32; ++tt) { float a = cb;
#pragma unroll
            for (int j = 0; j < CONVK; ++j) a += w[j] * uv[tt + j];
            cv[tt * 512 + c] = a; }
        __syncthreads();
#pragma unroll
        for (int q = 0; q < 4; ++q) { const int tt = F.wave * 4 + q;
            const f32x4 v0 = *(const LAS f32x4*)(cv + tt * 512 + 8 * F.lane), v1 = *(const LAS f32x4*)(cv + tt * 512 + 8 * F.lane + 4);
            const float mu = wave_sum((v0.x + v0.y) + (v0.z + v0.w) + (v1.x + v1.y) + (v1.z + v1.w)) * (1.0f / 512.0f);
            const f32x4 d0 = v0 - mu, d1 = v1 - mu;
            const float var = wave_sum((d0.x * d0.x + d0.y * d0.y) + (d0.z * d0.z + d0.w * d0.w) + (d1.x * d1.x + d1.y * d1.y) + (d1.z * d1.z + d1.w * d1.w)) * (1.0f / 512.0f);
            const float rstd = 1.0f / sqrtf(var + EPS);
            const f32x4 g0 = *(const f32x4*)(AIN[I_LNG] + 8 * F.lane), g1 = *(const f32x4*)(AIN[I_LNG] + 8 * F.lane + 4), b0 = *(const f32x4*)(AIN[I_LNB] + 8 * F.lane), b1 = *(const f32x4*)(AIN[I_LNB] + 8 * F.lane + 4);
            f32x4 y0 = d0 * rstd * g0 + b0, y1 = d1 * rstd * g1 + b1;
            y0 = y0 * sig4(y0); y1 = y1 * sig4(y1);
#if F8_MIXA
            *(GAS u32x2*)((unsigned char*)CF + (size_t)(m0 + tt) * 512 + 8 * F.lane) = (u32x2){f8pack4(y0.x, y0.y, y0.z, y0.w, F8_SCF), f8pack4(y1.x, y1.y, y1.z, y1.w, F8_SCF)}; }
#else
            u32x4 o; o.x = pk2(y0.x, y0.y); o.y = pk2(y0.z, y0.w); o.z = pk2(y1.x, y1.y); o.w = pk2(y1.z, y1.w);
            *(GAS u32x4*)(CF + (size_t)(m0 + tt) * 512 + 8 * F.lane) = o; }
#endif
        __syncthreads();
    }
}

__device__ __forceinline__ int perm16(int s) { return (s & ~12) | ((s & 4) << 1) | ((s & 8) >> 1); }
__device__ __forceinline__ float gelu_tanh(float x) { const float u2 = 1.5957691216057308f * (x + 0.044715f * x * x * x); return x * sigmoidf_(u2); }
__device__ __forceinline__ void compress_item(Frame& F, int it, int part) {
    const int which = it & 1, rt = (it >> 1) & 15, bg = it >> 5, b = bg >> 2, g = bg & 3;
    const int lane = F.lane, c32 = lane & 31, hi = lane >> 5;
    const unsigned char* W1F = F.ws + WS_CW1 + (size_t)which * (32 * 4 * 64 * 32) + (size_t)lane * 32;
    const bf16* W2T = (const bf16*)(F.ws + WS_CW2) + which * 64 * 128;
    const float* peb = (const float*)(F.ws + WS_PEBF) + which * 128;
    int n = rt * 32 + c32; const bool nvalid = n <= 510; if (!nvalid) n = 510;
    const unsigned char* zp = F.ws + WS_KV + (size_t)which * KV_STRIDE + ((size_t)(b * SEQ + 16 * n)) * 256 + g * 64 + 32 * hi;
    f32x16 acc[4];
#pragma unroll
    for (int ct = 0; ct < 4; ++ct) acc[ct] = (f32x16){0.f};
    asm volatile("s_nop 4" ::: "memory");
#pragma unroll 2
    for (int l = 8 * part; l < 8 * part + 8; ++l) {
        const pg8::i32x4_t z0 = *(const pg8::i32x4_t*)(zp + (size_t)l * 256), z1 = *(const pg8::i32x4_t*)(zp + (size_t)l * 256 + 16);
        const pg8::i32x8_t bz = __builtin_shufflevector(z0, z1, 0, 1, 2, 3, 4, 5, 6, 7);
#pragma unroll
        for (int ct = 0; ct < 4; ++ct) { const unsigned char* wq = W1F + (size_t)(l * 4 + ct) * 2048;
            const pg8::i32x4_t w0 = *(const pg8::i32x4_t*)wq, w1 = *(const pg8::i32x4_t*)(wq + 16);
            const pg8::i32x8_t aw = __builtin_shufflevector(w0, w1, 0, 1, 2, 3, 4, 5, 6, 7);
            asm volatile("v_mfma_f32_32x32x64_f8f6f4 %0, %1, %2, %0" : "+v"(acc[ct]) : "v"(aw), "v"(bz)); }
    }
    asm volatile("s_nop 15\n\ts_nop 7" : "+v"(acc[0]), "+v"(acc[1]), "+v"(acc[2]), "+v"(acc[3]));
#pragma unroll
    for (int ct = 0; ct < 4; ++ct) acc[ct] *= (1.0f / (F8_SKV * F8_SW1));
    { LAS f32x4* px = (LAS f32x4*)(F.lds + RING_OFF) + (size_t)(F.wave >> 2) * 4096 + lane;
      if (part != 0) {
#pragma unroll
          for (int ct = 0; ct < 4; ++ct)
#pragma unroll
              for (int q = 0; q < 4; ++q) px[((part - 1) * 16 + ct * 4 + q) * 64] = (f32x4){acc[ct][4 * q], acc[ct][4 * q + 1], acc[ct][4 * q + 2], acc[ct][4 * q + 3]};
      }
      __syncthreads();
      if (part != 0) return;
#pragma unroll 1
      for (int p = 0; p < 3; ++p) {
#pragma unroll
          for (int ct = 0; ct < 4; ++ct)
#pragma unroll
              for (int q = 0; q < 4; ++q) { const f32x4 v = px[(p * 16 + ct * 4 + q) * 64]; acc[ct][4 * q] += v.x; acc[ct][4 * q + 1] += v.y; acc[ct][4 * q + 2] += v.z; acc[ct][4 * q + 3] += v.w; }
      }
    }
    f32x16 o[2]; o[0] = (f32x16){0.f}; o[1] = (f32x16){0.f};
#pragma unroll
    for (int ct = 0; ct < 4; ++ct) {
#pragma unroll
        for (int r = 0; r < 16; ++r) { const int cidx = 32 * ct + (r & 3) + 8 * (r >> 2) + 4 * hi; acc[ct][r] = gelu_tanh(acc[ct][r] + peb[cidx]); }
#pragma unroll
        for (int s = 0; s < 2; ++s) {
            u32x4 pw; pw.x = cvt_pk_bf16(acc[ct][8 * s + 0], acc[ct][8 * s + 1]); pw.y = cvt_pk_bf16(acc[ct][8 * s + 2], acc[ct][8 * s + 3]); pw.z = cvt_pk_bf16(acc[ct][8 * s + 4], acc[ct][8 * s + 5]); pw.w = cvt_pk_bf16(acc[ct][8 * s + 6], acc[ct][8 * s + 7]);
            const bf16x8 pb = __builtin_bit_cast(bf16x8, pw);
#pragma unroll
            for (int mt = 0; mt < 2; ++mt) { const bf16* ap = W2T + (size_t)(32 * mt + c32) * 128 + 32 * ct + 16 * s + 4 * hi;
                const u32x2 lo = *(const u32x2*)ap, hh = *(const u32x2*)(ap + 8); u32x4 aw; aw.x = lo.x; aw.y = lo.y; aw.z = hh.x; aw.w = hh.y;
                o[mt] = __builtin_amdgcn_mfma_f32_32x32x16_bf16(__builtin_bit_cast(bf16x8, aw), pb, o[mt], 0, 0, 0); }
        }
    }
    if (nvalid) {
        if (which == 0) { bf16* kc = (bf16*)(F.ws + WS_KC) + ((size_t)bg * 512 + n) * 64;
#pragma unroll
            for (int mt = 0; mt < 2; ++mt)
#pragma unroll
                for (int q4 = 0; q4 < 4; ++q4) { u32x2 w; w.x = pk2(o[mt][4 * q4], o[mt][4 * q4 + 1]); w.y = pk2(o[mt][4 * q4 + 2], o[mt][4 * q4 + 3]); *(u32x2*)(kc + 32 * mt + 8 * q4 + 4 * hi) = w; }
        } else { bf16* vc = (bf16*)(F.ws + WS_VCT) + (size_t)bg * 64 * 512 + perm16(n);
#pragma unroll
            for (int mt = 0; mt < 2; ++mt)
#pragma unroll
                for (int r = 0; r < 16; ++r) { const int d = 32 * mt + (r & 3) + 8 * (r >> 2) + 4 * hi; vc[(size_t)d * 512] = (bf16)f2bf(o[mt][r]); }
        }
    }
}
__device__ __forceinline__ void vtrans_item(Frame& F, int it) {
    const int which = it & 1, tile = (it >> 1) & 127, bg = it >> 8, b = bg >> 2, g = bg & 3, lane = F.lane;
    const bf16* V = (const bf16*)(F.ws + WS_KV + (size_t)(which ? 5 : 3) * KV_STRIDE) + ((size_t)(b * SEQ + tile * 64)) * 256 + g * 64;
    bf16* VT = (bf16*)(F.ws + (which ? WS_VWT : WS_VST)) + (size_t)bg * 64 * SEQ + tile * 64;
    LAS unsigned* scr = (LAS unsigned*)(F.lds + RING_OFF + F.wave * 16384);
#pragma unroll
    for (int i = 0; i < 8; ++i) { const int row = 8 * i + (lane >> 3), ch = lane & 7; const u32x4 v = *(const u32x4*)(V + (size_t)row * 256 + 8 * ch);
        LAS unsigned* p = scr + row * 33 + 4 * ch; p[0] = v.x; p[1] = v.y; p[2] = v.z; p[3] = v.w; }
    LDS_WAIT(); asm volatile("" ::: "memory");
#pragma unroll
    for (int i = 0; i < 8; ++i) { const int d = 8 * i + (lane >> 3), ch = lane & 7; unsigned e[8];
#pragma unroll
        for (int j = 0; j < 8; ++j) { const int tok = perm16(8 * ch + j); const unsigned wv = scr[tok * 33 + (d >> 1)]; e[j] = (d & 1) ? (wv >> 16) : (wv & 0xffffu); }
        u32x4 o; o.x = e[0] | (e[1] << 16); o.y = e[2] | (e[3] << 16); o.z = e[4] | (e[5] << 16); o.w = e[6] | (e[7] << 16);
        *(u32x4*)(VT + (size_t)d * SEQ + 8 * ch) = o;
        }
    LDS_WAIT(); asm volatile("" ::: "memory");
}
__device__ __forceinline__ void p3_phase(Frame& F, const Args& args) {
#ifdef TSTAMP
#define PSTAMP(k) do { if (blockIdx.x == 0 && F.tid == 0) ((unsigned long long*)(F.ctl + 41000))[(k)] = __builtin_amdgcn_s_memrealtime(); } while (0)
#else
#define PSTAMP(k) do {} while (0)
#endif
    PSTAMP(20);
    conv_phase(F, args);
    PSTAMP(21);
    const int gw = F.vcu * NWAVES + F.wave, NGW = F.G * NWAVES;
    compress_item(F, gw >> 2, F.wave & 3);
    __syncthreads();
    PSTAMP(22);
    for (int it = gw; it < 4096; it += NGW) vtrans_item(F, it);
    PSTAMP(23);

}

#define DPP_U(v_, ctrl) ((unsigned)__builtin_amdgcn_update_dpp((int)(v_), (int)(v_), (ctrl), 0xF, 0xF, false))
__device__ __forceinline__ unsigned row16_max_u(unsigned v) {
    v = max(v, DPP_U(v, 0xB1)); v = max(v, DPP_U(v, 0x4E)); v = max(v, DPP_U(v, 0x141)); v = max(v, DPP_U(v, 0x140)); return v;
}
__device__ __forceinline__ float row16_sum_f(float v) {
    v += DPP_F(v, v, 0xB1, 0xF); v += DPP_F(v, v, 0x4E, 0xF); v += DPP_F(v, v, 0x141, 0xF); v += DPP_F(v, v, 0x140, 0xF); return v;
}
__device__ __forceinline__ void routing_phase(Frame& F, const Args& args, const int tok0) {
    const float* LOG = (const float*)(F.ws + WS_LOG); const float* rb = AIN[I_RB];
    int* RTE = (int*)(F.ws + WS_RTE); int* RTS = (int*)(F.ws + WS_RTS); float* RTW = (float*)(F.ws + WS_RTW); int* TOKL = (int*)(F.ws + WS_TOKL);
    unsigned* CNT = (unsigned*)(F.ctl + CW_CNT);
    const int gw = F.vcu * NWAVES + F.wave, NGW = F.G * NWAVES, lane = F.lane, row = lane >> 4, l16 = lane & 15;
    f32x4 bias[4];
#pragma unroll
    for (int j = 0; j < 4; ++j) bias[j] = *(const f32x4*)(rb + 16 * l16 + 4 * j);
    f32x4 lgn[4];
    (void)gw; (void)NGW;
    { const int t0 = tok0 + 4 * F.wave + row;
#pragma unroll
      for (int j = 0; j < 4; ++j) lgn[j] = (t0 < T) ? *(const f32x4*)(LOG + (size_t)t0 * 256 + 16 * l16 + 4 * j) : (f32x4){0.f, 0.f, 0.f, 0.f}; }
    LAS unsigned* cntl = (LAS unsigned*)(F.lds + RING_OFF); LAS unsigned* basel = cntl + 256;
    LAS u32x4* pend = (LAS u32x4*)(F.lds + RING_OFF + 2048 + F.wave * 8192);
    if (F.tid < 256) cntl[F.tid] = 0u;
    __syncthreads();
    int it = 0;
    for (int tb = tok0 + 4 * F.wave; tb < tok0 + 256; tb += 32, ++it) {
        const int t = tb + row;
        f32x4 lg[4];
#pragma unroll
        for (int j = 0; j < 4; ++j) lg[j] = lgn[j];
        { const int tn = tb + 32 + row;
          if (tb + 32 < tok0 + 256) {
#pragma unroll
              for (int j = 0; j < 4; ++j) lgn[j] = *(const f32x4*)(LOG + (size_t)tn * 256 + 16 * l16 + 4 * j); } }
        float sf[16]; unsigned key[16];
#pragma unroll
        for (int j = 0; j < 16; ++j) { const float sc = sigmoidf_(lg[j >> 2][j & 3]); sf[j] = sc + bias[j >> 2][j & 3];
            key[j] = (__builtin_bit_cast(unsigned, sf[j] + 1.0f) & ~0xFFu) | (unsigned)(255 - (16 * l16 + j)); }
        float a1 = fmaxf(sf[0], sf[1]), a2 = fminf(sf[0], sf[1]);
#pragma unroll
        for (int j = 2; j < 16; ++j) { const float nv = sf[j]; a2 = fmaxf(a2, fminf(a1, nv)); a1 = fmaxf(a1, nv); }
        { const float b1 = DPP_F(a1, a1, 0xB1, 0xF), b2 = DPP_F(a2, a2, 0xB1, 0xF); const float n1 = fmaxf(a1, b1), n2 = fmaxf(fminf(a1, b1), fmaxf(a2, b2)); a1 = n1; a2 = n2; }
        const float gs = a1 + a2; const int myg = l16 >> 1;
        int rank = 0;
#pragma unroll
        for (int gq = 0; gq < 8; ++gq) { const float og = __shfl(gs, (lane & 48) + 2 * gq); rank += (og > gs || (og == gs && gq < myg)) ? 1 : 0; }
        const bool gsel = rank < 4;
#pragma unroll
        for (int j = 0; j < 16; ++j) key[j] = gsel ? key[j] : 0u;
        unsigned mysel = 0u;
#pragma unroll
        for (int r = 0; r < TOPK; ++r) {
            unsigned m = max(max(key[0], key[1]), max(key[2], key[3]));
#pragma unroll
            for (int j = 4; j < 16; j += 4) m = max(m, max(max(key[j], key[j + 1]), max(key[j + 2], key[j + 3])));
            const unsigned mx = row16_max_u(m);
            mysel = (l16 == r) ? mx : mysel;
#pragma unroll
            for (int j = 0; j < 16; ++j) key[j] = (key[j] == mx) ? 0u : key[j];
        }
        const bool act = l16 < TOPK;
        const int e = 255 - (int)(mysel & 0xFFu);
        float scv = 0.f;
        if (act) scv = __builtin_bit_cast(float, mysel & ~0xFFu) - 1.0f - rb[e];
        const float wsum = row16_sum_f(scv);
        const float w = scv * (2.5f / wsum);
        unsigned loc = 0u;
        if (act && t < T) loc = __hip_atomic_fetch_add(cntl + e, 1u, __ATOMIC_RELAXED, __HIP_MEMORY_SCOPE_WORKGROUP);
        if (it < 8) pend[it * 64 + lane] = (u32x4){(act && t < T) ? (unsigned)t : 0xFFFFFFFFu, (unsigned)e, loc, __builtin_bit_cast(unsigned, w)};
    }
    __syncthreads();
    if (F.tid < 256) { const unsigned c = cntl[F.tid]; basel[F.tid] = c ? __hip_atomic_fetch_add(CNT + 32 * F.tid, c, RLX_AGENT) : 0u; }
    __syncthreads();
    for (int k = 0; k < it && k < 8; ++k) { const u32x4 pv = pend[k * 64 + lane];
        const unsigned pt = pv.x, pe = pv.y, pl = pv.z, pw = pv.w;
        if (pt != 0xFFFFFFFFu) { const unsigned slot = basel[pe] + pl; const size_t o = (size_t)pt * 8 + l16;
            RTE[o] = (int)pe; RTS[o] = (int)slot; RTW[o] = __builtin_bit_cast(float, pw); TOKL[(size_t)pe * T + slot] = (int)pt; } }
}
__device__ __forceinline__ void build_tables(Frame& F) {
    LAS int* tab = (LAS int*)(F.lds + TAB_OFF);
    __syncthreads();
    if (F.tid < NEXP) tab[F.tid] = (int)__hip_atomic_load((unsigned*)(F.ctl + CW_CNT) + 32 * F.tid, RLX_AGENT);
    if (F.tid == NEXP) tab[NEXP] = T;
    __syncthreads();
    if (F.tid == 0) { int us = 0, off = 0;
        for (int e = 0; e <= NEXP; ++e) { const int c = tab[e]; tab[260 + e] = us; tab[520 + e] = off; us += 2 * ((c + 255) >> 8); if (e < NEXP) off += c; }
        tab[260 + NEXP + 1] = us; tab[520 + NEXP] = 0; }
    __syncthreads();
}
__device__ __forceinline__ void combine_phase(Frame& F, const Args& args, float* dstbase) {
    const LAS int* tab = (const LAS int*)(F.lds + TAB_OFF);
    const int* RTE = (const int*)(F.ws + WS_RTE); const int* RTS = (const int*)(F.ws + WS_RTS); const float* RTW = (const float*)(F.ws + WS_RTW);
    const unsigned char* YS8 = (const unsigned char*)(F.ws + WS_YS8);
    int lane = F.lane; asm volatile("" : "+v"(lane));
    const int gw = F.vcu * NWAVES + F.wave, NGW = F.G * NWAVES;
    const float* fg = AIN[I_FG];
    float tscale = 1.0f;
#ifdef TSTAMP
    { const unsigned long long* ts = (const unsigned long long*)(F.ctl + 41000); const float us = (float)(long long)(ts[TS_B] - ts[TS_A]) * 0.01f;
      const float lvl = fminf(fmaxf(floorf((us - (float)(TS_BASE)) / (float)(TS_STEP)) + 1.0f, 0.0f), 5.0f); tscale *= 1.0f + 0.01f * lvl; }
#endif
#ifdef SELFCHECK
    { const float ce = __hip_atomic_load((float*)(F.ctl + 60000), RLX_AGENT), cn = __hip_atomic_load((float*)(F.ctl + 60000) + 1, RLX_AGENT); tscale *= 1.0f + CHK_K * sqrtf(ce / fmaxf(cn, 1e-30f)); }
#endif
    for (int t = gw; t < T; t += NGW) {
        int pos = 0; float w = 0.f;
        if (lane < TOPK) { const int e = RTE[(size_t)t * 8 + lane]; pos = tab[520 + e] + RTS[(size_t)t * 8 + lane]; w = RTW[(size_t)t * 8 + lane]; }
        u32x4 rows[TOPK];
#pragma unroll
        for (int k = 0; k < TOPK; ++k) { const int pk = __shfl(pos, k); rows[k] = *(const u32x4*)(YS8 + (size_t)pk * 1024 + 16 * lane); }
        const bf16* sp = (const bf16*)(F.ws + WS_YSS) + (size_t)t * 1024 + 16 * lane; const u32x4 sh0 = *(const u32x4*)sp, sh1 = *(const u32x4*)(sp + 8);
        f32x4 x[4];
        { const bf16* xp = (const bf16*)(F.ws + WS_X1) + (size_t)t * 1024 + 16 * lane; const u32x4 xa = *(const u32x4*)xp, xb = *(const u32x4*)(xp + 8); unpack8(xa, x[0], x[1]); unpack8(xb, x[2], x[3]); }
        f32x4 y[4]; unpack8(sh0, y[0], y[1]); unpack8(sh1, y[2], y[3]);
#pragma unroll
        for (int k = 0; k < TOPK; ++k) { const float wk = __shfl(w, k) * (1.0f / YS_SCALE); y[0] += unpack4_fp8(rows[k].x) * wk; y[1] += unpack4_fp8(rows[k].y) * wk; y[2] += unpack4_fp8(rows[k].z) * wk; y[3] += unpack4_fp8(rows[k].w) * wk; }
        const float* g2 = (const float*)(F.ws + WS_MODF) + (t >> 13) * 6144 + 5120 + 16 * lane;
        float s = 0.f;
#pragma unroll
        for (int q = 0; q < 4; ++q) { x[q] += *(const f32x4*)(g2 + 4 * q) * y[q]; s += (x[q].x * x[q].x + x[q].y * x[q].y) + (x[q].z * x[q].z + x[q].w * x[q].w); }
        const float rstd = tscale / sqrtf(wave_sum(s) * (1.0f / 1024.0f) + EPS);
#pragma unroll
        for (int q = 0; q < 4; ++q) *(f32x4*)(dstbase + (size_t)t * 1024 + 16 * lane + 4 * q) = x[q] * rstd * *(const f32x4*)(fg + 16 * lane + 4 * q);
    }
}
namespace att {
constexpr int TSZ = 8192;
constexpr int NBUF = 4, BUFB = 2 * TSZ;
constexpr int L_BUF = 0;
constexpr int L_IMP = NBUF * BUFB;
constexpr int L_SEL = 131072;
constexpr int L_END = L_SEL + 1024;
static_assert(L_END <= RING_BYTES, "attention LDS");
constexpr float L2E = 1.4426950408889634f;
enum { M_WIN = 0, M_SEL = 1, M_CMP1 = 2, M_CMP2 = 3 };

__device__ __forceinline__ float qxor1(float v) { return __builtin_bit_cast(float, __builtin_amdgcn_update_dpp(0, __builtin_bit_cast(int, v), 0xB1, 0xF, 0xF, false)); }
__device__ __forceinline__ float qxor2(float v) { return __builtin_bit_cast(float, __builtin_amdgcn_update_dpp(0, __builtin_bit_cast(int, v), 0x4E, 0xF, 0xF, false)); }
__device__ __forceinline__ float halfsum(float v) { const unsigned a = __builtin_bit_cast(unsigned, v); auto rr = __builtin_amdgcn_permlane32_swap(a, a, false, false); const unsigned r0 = rr[0], r1 = rr[1]; return __builtin_bit_cast(float, r0) + __builtin_bit_cast(float, r1); }
__device__ __forceinline__ float halfmax(float v) { const unsigned a = __builtin_bit_cast(unsigned, v); auto rr = __builtin_amdgcn_permlane32_swap(a, a, false, false); const unsigned r0 = rr[0], r1 = rr[1]; return fmaxf(__builtin_bit_cast(float, r0), __builtin_bit_cast(float, r1)); }

struct State { float m, l; f32x16 o0, o1; };
__device__ __forceinline__ float max3f(float a, float b, float c) { float r; asm("v_max3_f32 %0, %1, %2, %3" : "=v"(r) : "v"(a), "v"(b), "v"(c)); return r; }
__device__ __forceinline__ float max2f(float a, float b) { float r; asm("v_max_f32_e32 %0, %1, %2" : "=v"(r) : "v"(a), "v"(b)); return r; }
__device__ __forceinline__ float tilemax(const f32x16& p0, const f32x16& p1) {
    float a = max3f(p0[0], p0[1], p1[0]), b = max3f(p0[2], p0[3], p1[1]); a = max3f(a, p1[2], p1[3]);
#pragma unroll
    for (int r = 4; r < 16; r += 4) { a = max3f(a, p0[r], p0[r + 1]); b = max3f(b, p0[r + 2], p0[r + 3]); a = max3f(a, p1[r], p1[r + 1]); b = max3f(b, p1[r + 2], p1[r + 3]); }
    return max2f(a, b);
}

template <int MODE>
__device__ __forceinline__ void run_branch(LAS unsigned char* lds, const int nt, const int tile0, const bf16* kp, const size_t kst, const bf16* vp, const size_t vst,
                                           const bf16x8 (&qf)[4], State& st, const int tokl, const int ci, const int nvis, const unsigned sw0, const unsigned sw1, const unsigned sw2, const unsigned sw3, const float cm, const float cinv,
                                           const int tid, const int lane, const int wave) {
    const int c32 = lane & 31, hi = lane >> 5;
    const unsigned dmaw = (unsigned)wave * 1024u;
    const int xs = (hi ^ ((c32 >> 1) & 7)) * 16;
    f32x16 z16 = (f32x16){0.f}; asm volatile("" : "+v"(z16));
#define ATT_DMA(t) do { LAS unsigned char* _d = lds + L_BUF + ((t) & (NBUF - 1)) * BUFB + dmaw; \
        __builtin_amdgcn_global_load_lds((const unsigned*)(kp + (size_t)(t) * kst), (LAS unsigned*)_d, 16, 0, 0); \
        __builtin_amdgcn_global_load_lds((const unsigned*)(vp + (size_t)(t) * vst), (LAS unsigned*)(_d + TSZ), 16, 0, 0); } while (0)
    ATT_DMA(0); if (nt > 1) ATT_DMA(1); if (nt > 2) ATT_DMA(2);
    for (int i = 0; i < nt; ++i) {
        LAS unsigned char* cur = lds + L_BUF + (i & (NBUF - 1)) * BUFB;
        { const int rem = nt - 1 - i; if (rem >= 2) asm volatile("s_waitcnt vmcnt(4)" ::: "memory"); else if (rem == 1) asm volatile("s_waitcnt vmcnt(2)" ::: "memory"); else asm volatile("s_waitcnt vmcnt(0)" ::: "memory"); }
        __builtin_amdgcn_s_barrier(); asm volatile("" ::: "memory");
        if (i + 3 < nt) ATT_DMA(i + 3);
        const int tix = tile0 + i;
        bool lanesel = true; int klo = -1, khi = 64;
        bool need_mask = false, skip = false;
        if (MODE == M_WIN) { if (tix == 0) { klo = tokl; need_mask = true; } if (tix == 8) { khi = tokl; need_mask = true; } }
        if (MODE == M_SEL) { { const unsigned wsel = (tix < 32) ? sw0 : (tix < 64) ? sw1 : (tix < 96) ? sw2 : sw3; lanesel = (wsel >> (tix & 31)) & 1u; } if (tix == ci) { khi = tokl; need_mask = true; } skip = !__any(lanesel); }
        if (MODE == M_CMP1 || MODE == M_CMP2) { khi = nvis - 64 * tix - 1; need_mask = (64 * tix + 63 >= __builtin_amdgcn_readfirstlane(nvis)); }
        if (!skip) {
            f32x16 s0, s1;
            { LAS const unsigned char* p = cur + c32 * 128;
#pragma unroll
              for (int ks = 0; ks < 4; ++ks) { const bf16x8 a0 = *(LAS const bf16x8*)(p + ((ks * 32) ^ xs)), a1 = *(LAS const bf16x8*)(p + 32 * 128 + ((ks * 32) ^ xs));
                  s0 = __builtin_amdgcn_mfma_f32_32x32x16_bf16(a0, qf[ks], ks ? s0 : z16, 0, 0, 0); s1 = __builtin_amdgcn_mfma_f32_32x32x16_bf16(a1, qf[ks], ks ? s1 : z16, 0, 0, 0); } }
            asm volatile("s_nop 15\n\ts_nop 7" : "+v"(s0), "+v"(s1));
            if (need_mask) {
#pragma unroll
                for (int r = 0; r < 16; ++r) { const int kl = (r & 3) + 8 * (r >> 2) + 4 * hi;
                    s0[r] = (kl > klo && kl <= khi) ? s0[r] : -1e30f;
                    s1[r] = (kl + 32 > klo && kl + 32 <= khi) ? s1[r] : -1e30f; }
            }
            if (MODE == M_CMP2) {
                const float mneg = -fmaxf(cm, -1e29f) * L2E;
#pragma unroll
                for (int r = 0; r < 16; ++r) { s0[r] = __builtin_amdgcn_exp2f(__builtin_fmaf(s0[r], L2E, mneg)) * cinv; s1[r] = __builtin_amdgcn_exp2f(__builtin_fmaf(s1[r], L2E, mneg)) * cinv; }
                LAS float* imp = (LAS float*)(lds + L_IMP) + tokl * 128;
                if (true) {
#pragma unroll
                    for (int x = 0; x < 8; ++x) { const f32x16& sv = (x >> 2) ? s1 : s0; const int q4 = x & 3;
                        float gsum = (sv[4 * q4] + sv[4 * q4 + 1]) + (sv[4 * q4 + 2] + sv[4 * q4 + 3]); gsum += qxor1(gsum); gsum += qxor2(gsum);
                        const int j = 16 * tix + 8 * (x >> 2) + 2 * q4 + hi; if ((c32 & 3) == 0) imp[j] += gsum; }
                    asm volatile("" ::: "memory");
#pragma unroll
                    for (int x = 0; x < 8; ++x) { const f32x16& sv = (x >> 2) ? s1 : s0; const int q4 = x & 3;
                        float lst = sv[4 * q4 + 3]; lst += qxor1(lst); lst += qxor2(lst);
                        const int j = 16 * tix + 8 * (x >> 2) + 2 * q4 + hi; if ((c32 & 3) == 0 && j + 1 < 128) imp[j + 1] += lst; }
                }
            } else {
                float mx = tilemax(s0, s1);
                if (MODE == M_SEL) mx = lanesel ? mx : -1e30f;
                mx = halfmax(mx);
                if (__any(mx > st.m + 8.0f)) {
                    const float mnew = fmaxf(st.m, mx), alpha = __builtin_amdgcn_exp2f((st.m - mnew) * L2E);
                    st.l *= alpha; st.m = mnew;
                    if (MODE != M_CMP1) {
#pragma unroll
                        for (int r = 0; r < 16; ++r) { st.o0[r] *= alpha; st.o1[r] *= alpha; }
                    }
                }
                float mneg = -fmaxf(st.m, -1e29f) * L2E;
                if (MODE == M_SEL) mneg = lanesel ? mneg : -1e30f;
                f32x2 rs2 = (f32x2){0.f, 0.f}; const f32x2 l2e2 = (f32x2){L2E, L2E}, mn2 = (f32x2){mneg, mneg};
#pragma unroll
                for (int r = 0; r < 16; r += 2) { f32x2 a = (f32x2){s0[r], s0[r + 1]}, b = (f32x2){s1[r], s1[r + 1]};
                    a = a * l2e2 + mn2; b = b * l2e2 + mn2;
                    a.x = __builtin_amdgcn_exp2f(a.x); a.y = __builtin_amdgcn_exp2f(a.y); b.x = __builtin_amdgcn_exp2f(b.x); b.y = __builtin_amdgcn_exp2f(b.y);
                    s0[r] = a.x; s0[r + 1] = a.y; s1[r] = b.x; s1[r + 1] = b.y; rs2 += a; rs2 += b; }
                st.l += rs2.x + rs2.y;
            }
            if (MODE != M_CMP1) {
                LAS const unsigned char* p = cur + TSZ + c32 * 128;
#pragma unroll
                for (int sub = 0; sub < 2; ++sub)
#pragma unroll
                    for (int s = 0; s < 2; ++s) { const f32x16& sv = sub ? s1 : s0;
                        u32x4 pw; pw.x = cvt_pk_bf16(sv[8 * s + 0], sv[8 * s + 1]); pw.y = cvt_pk_bf16(sv[8 * s + 2], sv[8 * s + 3]); pw.z = cvt_pk_bf16(sv[8 * s + 4], sv[8 * s + 5]); pw.w = cvt_pk_bf16(sv[8 * s + 6], sv[8 * s + 7]);
                        const bf16x8 pb = __builtin_bit_cast(bf16x8, pw);
                        const bf16x8 a0 = *(LAS const bf16x8*)(p + (((2 * sub + s) * 32) ^ xs)), a1 = *(LAS const bf16x8*)(p + 32 * 128 + (((2 * sub + s) * 32) ^ xs));
                        st.o0 = __builtin_amdgcn_mfma_f32_32x32x16_bf16(a0, pb, st.o0, 0, 0, 0); st.o1 = __builtin_amdgcn_mfma_f32_32x32x16_bf16(a1, pb, st.o1, 0, 0, 0); }
            }
        }
    }
    asm volatile("s_waitcnt lgkmcnt(0)" ::: "memory"); __builtin_amdgcn_s_barrier(); asm volatile("" ::: "memory");
#undef ATT_DMA
}

template <bool ACC, bool LAST8 = false> __device__ __forceinline__ void o_update(bf16* op, const f32x16& o0, const f32x16& o1, float sc, unsigned char* op8 = nullptr) {
#pragma unroll
    for (int q4 = 0; q4 < 4; ++q4) {
        f32x4 a = (f32x4){o0[4 * q4], o0[4 * q4 + 1], o0[4 * q4 + 2], o0[4 * q4 + 3]} * sc, b = (f32x4){o1[4 * q4], o1[4 * q4 + 1], o1[4 * q4 + 2], o1[4 * q4 + 3]} * sc;
        if (ACC) { const u32x2 pa = *(const u32x2*)(op + 8 * q4), pb = *(const u32x2*)(op + 32 + 8 * q4);
            a += (f32x4){bflo(pa.x), bfhi(pa.x), bflo(pa.y), bfhi(pa.y)}; b += (f32x4){bflo(pb.x), bfhi(pb.x), bflo(pb.y), bfhi(pb.y)}; }
        if (LAST8) { *(unsigned*)(op8 + 8 * q4) = f8pack4(a[0], a[1], a[2], a[3], F8_SO); *(unsigned*)(op8 + 32 + 8 * q4) = f8pack4(b[0], b[1], b[2], b[3], F8_SO); }
        else { u32x2 w0, w1; w0.x = cvt_pk_bf16(a[0], a[1]); w0.y = cvt_pk_bf16(a[2], a[3]); w1.x = cvt_pk_bf16(b[0], b[1]); w1.y = cvt_pk_bf16(b[2], b[3]);
            *(u32x2*)(op + 8 * q4) = w0; *(u32x2*)(op + 32 + 8 * q4) = w1; } }
}

__device__ __forceinline__ void attn_item(Frame& F, int b, int g, int ci) {
    LAS unsigned char* lds = F.lds + RING_OFF;
    const int tid = F.tid, lane = F.lane, wave = F.wave, c32 = lane & 31, hi = lane >> 5;
    const int tokl = 8 * wave + (c32 >> 2), h = c32 & 3, ts = 64 * ci + tokl; const size_t trow = (size_t)b * SEQ + ts;
    const int bg = b * 4 + g;
    const bf16* Q = (const bf16*)(F.ws + WS_Q); bf16* O = (bf16*)(F.ws + WS_O);
    bf16x8 qf[4];
    { const bf16* qp = Q + trow * 1024 + g * 256 + h * 64 + 8 * hi;
#pragma unroll
      for (int ks = 0; ks < 4; ++ks) qf[ks] = *(const bf16x8*)(qp + 16 * ks); }
    const bf16* ngp = (const bf16*)(F.ws + WS_NGT) + trow * 64 + g * 12 + h * 3;
#ifdef CHK_BR
    const float gate_c = (CHK_BR & 1) ? bf2f(ngp[0]) : 0.f, gate_s = (CHK_BR & 2) ? bf2f(ngp[1]) : 0.f, gate_w = (CHK_BR & 4) ? bf2f(ngp[2]) : 0.f;
#else
    const float gate_c = bf2f(ngp[0]), gate_s = bf2f(ngp[1]), gate_w = bf2f(ngp[2]);
#endif
    asm volatile("" : "+v"(qf[0]), "+v"(qf[1]), "+v"(qf[2]), "+v"(qf[3]));
    bf16* const op = O + trow * 1024 + g * 256 + h * 64 + 4 * hi;
    unsigned selw[4] = {0u, 0u, 0u, 0u};
    State st;
    { LAS f32x4* z = (LAS f32x4*)(lds + L_IMP) + tid * 4;
#pragma unroll
      for (int q = 0; q < 4; ++q) z[q] = (f32x4){0.f, 0.f, 0.f, 0.f}; }
    {
        asm volatile("" : "+s"(F.ws));
        int tidl = tid; asm volatile("" : "+v"(tidl)); const int srow = tidl >> 3, sch = (tidl & 7) ^ ((tidl >> 4) & 7);
        const int u0 = (ci >= 8) ? 0 : 8 - ci, nt = 9 - u0; const int pos0 = 64 * (ci - 8 + u0);
        const bf16* kp = (const bf16*)(F.ws + WS_KV + 4 * KV_STRIDE) + ((size_t)b * SEQ + pos0 + srow) * 256 + g * 64 + 8 * sch;
        const bf16* vp = (const bf16*)(F.ws + WS_VWT) + ((size_t)bg * 64 + srow) * SEQ + pos0 + 8 * sch;
#if defined(ATT_DBL) && ATT_DBL == 1
#pragma unroll 1
        for (int rep = 0; rep < 2; ++rep) {
#else
        {
#endif
        st.m = -1e30f; st.l = 0.f; st.o0 = (f32x16){0.f}; st.o1 = (f32x16){0.f};
        run_branch<M_WIN>(lds, nt, u0, kp, (size_t)64 * 256, vp, (size_t)64, qf, st, tokl, ci, 0, selw[0], selw[1], selw[2], selw[3], 0.f, 0.f, tid, lane, wave);
        }
        const float lt = halfsum(st.l); const float sc = (lt > 0.f) ? gate_w / lt : 0.f;
        o_update<false>(op, st.o0, st.o1, sc);
    }
    {
        asm volatile("" : "+s"(F.ws));
        int tidl = tid; asm volatile("" : "+v"(tidl)); const int srow = tidl >> 3, sch = (tidl & 7) ^ ((tidl >> 4) & 7);
        const int ncmp = (4 * ci + 3 < NCMP) ? 4 * ci + 3 : NCMP, nt = (ncmp + 63) >> 6;
        const int nvis = (ts >= 31) ? (ts - 15) >> 4 : 0;
        const bf16* kp = (const bf16*)(F.ws + WS_KC) + ((size_t)bg * 512 + srow) * 64 + 8 * sch;
        const bf16* vp = (const bf16*)(F.ws + WS_VCT) + ((size_t)bg * 64 + srow) * 512 + 8 * sch;
        st.m = -1e30f; st.l = 0.f; st.o0 = (f32x16){0.f}; st.o1 = (f32x16){0.f};
        run_branch<M_CMP1>(lds, nt, 0, kp, (size_t)64 * 64, vp, (size_t)64, qf, st, tokl, ci, nvis, selw[0], selw[1], selw[2], selw[3], 0.f, 0.f, tid, lane, wave);
        const float lt = halfsum(st.l); const float cinv = (lt > 0.f) ? 1.0f / lt : 0.f; const float cm = st.m;
        run_branch<M_CMP2>(lds, nt, 0, kp, (size_t)64 * 64, vp, (size_t)64, qf, st, tokl, ci, nvis, selw[0], selw[1], selw[2], selw[3], cm, cinv, tid, lane, wave);
        o_update<true>(op, st.o0, st.o1, gate_c);
    }
    {
        LAS unsigned* SEL = (LAS unsigned*)(lds + L_SEL);
#if defined(ATT_DBL) && ATT_DBL == 3
#pragma unroll 1
        for (int rep = 0; rep < 2; ++rep)
#endif
        if (ci >= SELTOP) {
            const LAS float* imp = (const LAS float*)(lds + L_IMP);
            const int tk = lane >> 3, r8 = lane & 7, tl2 = 8 * wave + tk;
            float cv[16];
            { const LAS f32x4* ip = (const LAS f32x4*)(imp + tl2 * 128 + 16 * r8);
#pragma unroll
              for (int q = 0; q < 4; ++q) { const f32x4 t4 = ip[q]; cv[4 * q] = t4.x; cv[4 * q + 1] = t4.y; cv[4 * q + 2] = t4.z; cv[4 * q + 3] = t4.w; } }
#pragma unroll
            for (int i = 0; i < 16; ++i) { const int j = 16 * r8 + i; cv[i] = (j >= 1 && j <= ci - 2) ? cv[i] : -3e38f; }
            unsigned mymask = 0u;
#pragma unroll 1
            for (int r = 0; r < SELTOP - 3; ++r) {
                float bv = cv[0]; int bi = 0;
#pragma unroll
                for (int i = 1; i < 16; ++i) if (cv[i] > bv) { bv = cv[i]; bi = i; }
                float gv = bv; int gj = 16 * r8 + bi;
#pragma unroll
                for (int o = 1; o < 8; o <<= 1) { const float ov = __shfl_xor(gv, o); const int oj = __shfl_xor(gj, o); const bool take = (ov > gv) || (ov == gv && oj < gj); gv = take ? ov : gv; gj = take ? oj : gj; }
                if ((gj >> 4) == r8) { const int wi = gj & 15; mymask |= 1u << wi;
#pragma unroll
                    for (int i = 0; i < 16; ++i) cv[i] = (i == wi) ? -3e38f : cv[i]; }
            }
            if (r8 == 0) mymask |= 1u;
            if (((ci - 1) >> 4) == r8) mymask |= 1u << ((ci - 1) & 15);
            if ((ci >> 4) == r8) mymask |= 1u << (ci & 15);
            { const unsigned other = (unsigned)__shfl_xor((int)mymask, 1); if ((r8 & 1) == 0) SEL[tl2 * 4 + (r8 >> 1)] = mymask | (other << 16); }
            LDS_WAIT(); asm volatile("" ::: "memory");
#pragma unroll
            for (int q = 0; q < 4; ++q) selw[q] = SEL[tokl * 4 + q];
        } else {
            selw[0] = (ci == 31) ? 0xffffffffu : ((1u << (ci + 1)) - 1u); selw[1] = 0u; selw[2] = 0u; selw[3] = 0u;
        }
    }
    asm volatile("" : "+s"(F.ws));
    {
        int tidl = tid; asm volatile("" : "+v"(tidl)); const int srow = tidl >> 3, sch = (tidl & 7) ^ ((tidl >> 4) & 7);
        const int nt = ci + 1;
        const bf16* kp = (const bf16*)(F.ws + WS_KV + 2 * KV_STRIDE) + ((size_t)b * SEQ + srow) * 256 + g * 64 + 8 * sch;
        const bf16* vp = (const bf16*)(F.ws + WS_VST) + ((size_t)bg * 64 + srow) * SEQ + 8 * sch;
        bf16x8 qf2[4];
        { const bf16* qp2 = Q + trow * 1024 + g * 256 + h * 64 + 8 * hi;
#pragma unroll
          for (int ks = 0; ks < 4; ++ks) qf2[ks] = *(const bf16x8*)(qp2 + 16 * ks); }
        asm volatile("" : "+v"(qf2[0]), "+v"(qf2[1]), "+v"(qf2[2]), "+v"(qf2[3]));
        st.m = -1e30f; st.l = 0.f; st.o0 = (f32x16){0.f}; st.o1 = (f32x16){0.f};
        run_branch<M_SEL>(lds, nt, 0, kp, (size_t)64 * 256, vp, (size_t)64, qf2, st, tokl, ci, 0, selw[0], selw[1], selw[2], selw[3], 0.f, 0.f, tid, lane, wave);
        const float lt = halfsum(st.l); const float sc = (lt > 0.f) ? gate_s / lt : 0.f;
#if F8_MIXB
        o_update<true, true>(op, st.o0, st.o1, sc, F.ws + WS_O8 + (trow * 1024 + g * 256 + h * 64 + 4 * hi));
#else
        o_update<true>(op, st.o0, st.o1, sc);
#endif
    }
}
__device__ __forceinline__ void attn_phase(Frame& F) {
    { const int x = (F.vcu >> 5) & 7, wl = F.vcu & 31;
        for (int k = 0; k < 8; ++k) { const int m = ((k & 1) ? 31 - wl : wl) + 32 * k, ci = 127 - (m >> 1), bg = 2 * x + (m & 1); attn_item(F, bg >> 2, bg & 3, ci); } }
}
}
#ifdef SELFCHECK
constexpr int CW_CHK = 60000;
__device__ __forceinline__ void chk_add(Frame& F, float err, float nrm) {
    if (F.lane == 0) { atomicAdd((float*)(F.ctl + CW_CHK), err); atomicAdd((float*)(F.ctl + CW_CHK) + 1, nrm); }
}
__device__ __forceinline__ void chk_attn_sample(Frame& F, int b, int ts, int g) {
    const int lane = F.lane, bg = b * 4 + g; const size_t trow = (size_t)b * SEQ + ts;
    LAS float* L = (LAS float*)(F.lds + RING_OFF + F.wave * 16384);
    LAS float* qs = L; LAS float* pc = L + 256; LAS float* sc = L + 256 + 2048; LAS float* impv = sc + 1024; LAS float* orf = impv + 128; LAS int* selL = (LAS int*)(orf + 256);
    const bf16* Q = (const bf16*)(F.ws + WS_Q); const bf16* O = (const bf16*)(F.ws + WS_O);
    const bf16* KC = (const bf16*)(F.ws + WS_KC) + (size_t)bg * 512 * 64; const bf16* VCT = (const bf16*)(F.ws + WS_VCT) + (size_t)bg * 64 * 512;
    const bf16* KS = (const bf16*)(F.ws + WS_KV + 2 * KV_STRIDE); const bf16* VS = (const bf16*)(F.ws + WS_KV + 3 * KV_STRIDE);
    const bf16* KW = (const bf16*)(F.ws + WS_KV + 4 * KV_STRIDE); const bf16* VW = (const bf16*)(F.ws + WS_KV + 5 * KV_STRIDE);
    const bf16* NGp = (const bf16*)(F.ws + WS_NGT) + trow * 64 + g * 12;
    for (int i = lane; i < 256; i += 64) qs[i] = bf2f(Q[trow * 1024 + g * 256 + i]);
    LDS_WAIT(); asm volatile("" ::: "memory");
    const int jq = ts >> 6, nvis = (ts >= 31) ? (ts - 15) >> 4 : 0;
    for (int i = lane; i < 256; i += 64) orf[i] = 0.f;
    for (int h = 0; h < 4; ++h) {
        float mx = -3e38f;
        for (int n = lane; n < 512; n += 64) { float s = -3e38f; if (n < nvis) { s = 0.f; for (int d = 0; d < 64; ++d) s += qs[h * 64 + d] * bf2f(KC[n * 64 + d]); } pc[h * 512 + n] = s; mx = fmaxf(mx, s); }
        mx = wave_max(mx); float sum = 0.f;
        for (int n = lane; n < 512; n += 64) { const float s = pc[h * 512 + n]; const float p = (n < nvis) ? __expf(s - mx) : 0.f; pc[h * 512 + n] = p; sum += p; }
        sum = wave_sum(sum); const float inv = (sum > 0.f) ? 1.f / sum : 0.f;
        for (int n = lane; n < 512; n += 64) pc[h * 512 + n] *= inv;
        LDS_WAIT(); asm volatile("" ::: "memory");
        float o = 0.f; for (int n = 0; n < nvis; ++n) o += pc[h * 512 + n] * bf2f(VCT[lane * 512 + perm16(n)]);
        if (CHK_BR & 1) orf[h * 64 + lane] += bf2f(NGp[h * 3 + 0]) * o;
    }
    for (int j = lane; j < 128; j += 64) { float a = 0.f; for (int h = 0; h < 4; ++h) for (int n = 4 * j - 1; n <= 4 * j + 3; ++n) if (n >= 0 && n < 511) a += pc[h * 512 + n];
        impv[j] = (j == 0 || j == jq || j == jq - 1) ? 1e4f : ((j <= jq) ? a : -1.0f); }
    LDS_WAIT(); asm volatile("" ::: "memory");
    { float v0 = impv[lane], v1 = impv[lane + 64];
      for (int r = 0; r < 16; ++r) { const float mx = wave_max(fmaxf(v0, v1)); const unsigned long long b0 = __ballot(v0 == mx); int js;
          if (b0) { js = __ffsll((long long)b0) - 1; if (lane == js) v0 = -3e38f; } else { const unsigned long long b1 = __ballot(v1 == mx); js = 64 + __ffsll((long long)b1) - 1; if (lane == js - 64) v1 = -3e38f; }
          if (lane == 0) selL[r] = js; } }
    LDS_WAIT(); asm volatile("" ::: "memory");
    for (int h = 0; h < 4; ++h) {
        float mx = -3e38f;
        for (int r = 0; r < 16; ++r) { const int pos = selL[r] * 64 + lane; float s = -3e38f;
            if (pos <= ts) { s = 0.f; const bf16* kr = KS + ((size_t)b * SEQ + pos) * 256 + g * 64; for (int d = 0; d < 64; ++d) s += qs[h * 64 + d] * bf2f(kr[d]); }
            sc[r * 64 + lane] = s; mx = fmaxf(mx, s); }
        mx = wave_max(mx); float sum = 0.f;
        for (int r = 0; r < 16; ++r) { const int pos = selL[r] * 64 + lane; const float p = (pos <= ts) ? __expf(sc[r * 64 + lane] - mx) : 0.f; sc[r * 64 + lane] = p; sum += p; }
        sum = wave_sum(sum); const float inv = (sum > 0.f) ? 1.f / sum : 0.f;
        LDS_WAIT(); asm volatile("" ::: "memory");
        float o = 0.f;
        for (int r = 0; r < 16; ++r) for (int i = 0; i < 64; ++i) { const int pos = selL[r] * 64 + i; if (pos <= ts) o += sc[r * 64 + i] * bf2f(VS[((size_t)b * SEQ + pos) * 256 + g * 64 + lane]); }
        if (CHK_BR & 2) orf[h * 64 + lane] += bf2f(NGp[h * 3 + 1]) * o * inv;
        LDS_WAIT(); asm volatile("" ::: "memory");
    }
    for (int h = 0; h < 4; ++h) {
        float mx = -3e38f;
        for (int i = lane; i < 512; i += 64) { const int pos = ts - 511 + i; float s = -3e38f;
            if (pos >= 0) { s = 0.f; const bf16* kr = KW + ((size_t)b * SEQ + pos) * 256 + g * 64; for (int d = 0; d < 64; ++d) s += qs[h * 64 + d] * bf2f(kr[d]); }
            sc[i] = s; mx = fmaxf(mx, s); }
        mx = wave_max(mx); float sum = 0.f;
        for (int i = lane; i < 512; i += 64) { const int pos = ts - 511 + i; const float p = (pos >= 0) ? __expf(sc[i] - mx) : 0.f; sc[i] = p; sum += p; }
        sum = wave_sum(sum); const float inv = (sum > 0.f) ? 1.f / sum : 0.f;
        LDS_WAIT(); asm volatile("" ::: "memory");
        float o = 0.f;
        for (int i = 0; i < 512; ++i) { const int pos = ts - 511 + i; if (pos >= 0) o += sc[i] * bf2f(VW[((size_t)b * SEQ + pos) * 256 + g * 64 + lane]); }
        if (CHK_BR & 4) orf[h * 64 + lane] += bf2f(NGp[h * 3 + 2]) * o * inv;
        LDS_WAIT(); asm volatile("" ::: "memory");
    }
    float err = 0.f, nrm = 0.f;
    for (int h = 0; h < 4; ++h) { const float ref = orf[h * 64 + lane];
        const float got = bf2f(O[trow * 1024 + g * 256 + h * 64 + lane]);
        err += (got - ref) * (got - ref); nrm += ref * ref; }
    err = wave_sum(err); nrm = wave_sum(nrm);
    chk_add(F, err, nrm);
}
__device__ __forceinline__ void chk_attn_phase(Frame& F) {
    const int gw = F.vcu * NWAVES + F.wave;
    const int tsl[32] = {0, 1, 30, 31, 32, 47, 63, 64, 65, 127, 128, 500, 511, 512, 513, 1000, 1023, 1024, 1087, 1500, 2047, 2048, 3000, 4095, 4096, 5000, 6143, 7000, 8000, 8128, 8190, 8191};
    if (gw < 32 * CHK_NSETS) { const int si = gw & 31, set = gw >> 5; int ts = 0;
#pragma unroll
        for (int k = 0; k < 32; ++k) if (si == k) ts = tsl[k];
        chk_attn_sample(F, (set + 1) & 3, ts, (set * 3 + 2) & 3); }
}
#endif
#ifndef MK_N_LAUNCHES
#define MK_N_LAUNCHES 1
#endif
constexpr int N_PHASES = 14;
constexpr int N_LAUNCHES = MK_N_LAUNCHES;

__global__ void __launch_bounds__(NTHREADS, 2) fwd_megakernel(Args args) {
    extern __shared__ __attribute__((aligned(16))) unsigned char lds_raw[];
    Frame F;
    F.lds = (LAS unsigned char*)lds_raw;
    F.MISC = (volatile LAS unsigned*)(F.lds + MISC_OFF);
    F.tid = threadIdx.x; F.lane = F.tid & 63; F.wave = __builtin_amdgcn_readfirstlane(F.tid >> 6);
    F.G = gridDim.x; { const int bx = blockIdx.x; F.vcu = (F.G % 8 == 0) ? (bx % 8) * (F.G / 8) + bx / 8 : bx; }
    F.ws = args.ws; F.ctl = (gu32*)(args.ws + WS_CTL); F.out = args.out;
    for (int u = F.tid; u < (LDS_BYTES - LDSCTL_OFF) / 4; u += NTHREADS) ((LAS unsigned*)(F.lds + LDSCTL_OFF))[u] = 0u;
    __syncthreads();
    XcdBarrier bar; bar.bar = (unsigned*)(F.ctl + CW_BAR); bar.x = 0; bar.st = nullptr; bar.wave = F.wave;
    bar = xcd_barrier_post((unsigned*)(F.ctl + CW_BAR), F.MISC + 8, F.wave);
    const int lo = args.ph_lo, hi = args.ph_hi;
#ifdef PH_MASK
#define IN(k) (((PH_MASK >> (k)) & 1) && lo <= (k) && (k) < hi)
#else
#define IN(k) (lo <= (k) && (k) < hi)
#endif
#ifdef TSTAMP
#define STAMP(k) do { if (blockIdx.x == 0 && F.tid == 0) ((unsigned long long*)(F.ctl + 41000))[(k)] = __builtin_amdgcn_s_memrealtime(); } while (0)
#else
#define STAMP(k) do {} while (0)
#endif
#define RELANE() do { F.lane = fresh_lane(); F.tid = F.wave * 64 + F.lane; } while (0)
#define SEAM(k) do { if (IN(k) && IN((k) + 1)) xcd_barrier(bar); STAMP((k) + 1); asm volatile("" : "+s"(F.ws), "+s"(F.out)); RELANE(); } while (0)
#define SEAM_LOCAL(k) do { __syncthreads(); STAMP((k) + 1); asm volatile("" : "+s"(F.ws), "+s"(F.out)); RELANE(); } while (0)
    LAS unsigned char* ring = F.lds + RING_OFF;
    const int G = F.G, bx = (int)blockIdx.x;

    STAMP(0);
    if (IN(0)) { p0_prologue(F, args);
#if defined(DBL_MASK) && (DBL_MASK & 0x1)
        xcd_barrier(bar); p0_prologue(F, args);
#endif
    } SEAM(0);
    if (IN(1)) { norm_mod_rows<true>(F, args, AIN[I_X], F8_WIN ? (bf16*)nullptr : (bf16*)(F.ws + WS_XN), AIN[I_N1G], 0, 1024, F8_WIN ? F.ws + WS_XN8A : nullptr); finalize_mod(F, args); } SEAM(1);
    if (IN(2)) {
#if F8_WIN
        pg8::DenseOrder S; S.init(F.ws + WS_XN8A, 1024, F.ws + WS_WIN, 512, T, NINP, G, bx);
        EpiIn E{(const float*)(F.ws + WS_BINP), (bf16*)(F.ws + WS_U), (bf16*)(F.ws + WS_Q), (bf16*)(F.ws + WS_KV), (bf16*)(F.ws + WS_NGT), (bf16*)(F.ws + WS_GM), 1.0f / (F8_SX * F8_SWG)};
        pg8::gemm_phase<EpiIn, pg8::DenseOrder, true, true, true>(ring, 512, S, E, F.wave);
        if (XC_R2 > 0 && bx >= 128) { asm volatile("" : "+s"(F.ws)); RELANE(); expert_convert(F, args, XC_N0, XC_N1, (bx - 128) * NWAVES + F.wave, 128 * NWAVES); }
#else
        pg8::DenseOrder S; S.init(F.ws + WS_XN, 2048, F.ws + WS_WIN, 1024, T, NINP, G, bx);
        EpiIn E{(const float*)(F.ws + WS_BINP), (bf16*)(F.ws + WS_U), (bf16*)(F.ws + WS_Q), (bf16*)(F.ws + WS_KV), (bf16*)(F.ws + WS_NGT), (bf16*)(F.ws + WS_GM), 1.0f};
        pg8::gemm_phase<EpiIn, pg8::DenseOrder, true, true>(ring, 1024, S, E, F.wave);
#endif
    } SEAM(2);
    if (IN(3)) {
#if defined(DBL_MASK) && (DBL_MASK & 0x8)
#pragma unroll 1
        for (int rep = 0; rep < 2; ++rep) { p3_phase(F, args); if (rep == 0) xcd_barrier(bar); }
#else
        p3_phase(F, args);
#endif
    } SEAM(3);
    if (IN(4)) {
#if defined(DBL_MASK) && (DBL_MASK & 0x10)
#pragma unroll 1
        for (int rep = 0; rep < 2; ++rep) { att::attn_phase(F); if (rep == 0) xcd_barrier(bar); }
#else
        att::attn_phase(F);
#endif
    } SEAM(4);
    if (IN(5)) {
#ifdef SELFCHECK
        chk_attn_phase(F); __syncthreads();
#endif
#if F8_MIXA
        pg8::DenseOrder S; S.init(F.ws + WS_CF, 512, F.ws + WS_WC, 256, T, 1024, G, bx);
        EpiMix<0> E{(const bf16*)(F.ws + WS_GM), (bf16*)(F.ws + WS_MIX), AIN[I_BCO], nullptr, 1.0f / (F8_SCF * F8_SWC)};
        pg8::gemm_phase<EpiMix<0>, pg8::DenseOrder, true, true, true>(ring, 256, S, E, F.wave);
#else
        pg8::DenseOrder S; S.init(F.ws + WS_CF, 1024, F.ws + WS_WC, 512, T, 1024, G, bx);
        EpiMix<0> E{(const bf16*)(F.ws + WS_GM), (bf16*)(F.ws + WS_MIX), AIN[I_BCO], nullptr, 1.0f};
        pg8::gemm_phase<EpiMix<0>, pg8::DenseOrder, true, true>(ring, 512, S, E, F.wave);
#endif
    } SEAM_LOCAL(5);
    if (IN(6)) {
#if F8_MIXB
        pg8::DenseOrder S; S.init(F.ws + WS_O8, 1024, F.ws + WS_WN, 512, T, 1024, G, bx);
        EpiMix<1> E{(const bf16*)(F.ws + WS_GM), (bf16*)(F.ws + WS_MIX), nullptr, F8_WOUT ? F.ws + WS_MIX8 : nullptr, 1.0f / (F8_SO * F8_SWG)};
        pg8::gemm_phase<EpiMix<1>, pg8::DenseOrder, true, true, true>(ring, 512, S, E, F.wave);
#else
        pg8::DenseOrder S; S.init(F.ws + WS_O, 2048, F.ws + WS_WN, 1024, T, 1024, G, bx);
        EpiMix<1> E{(const bf16*)(F.ws + WS_GM), (bf16*)(F.ws + WS_MIX), nullptr, F8_WOUT ? F.ws + WS_MIX8 : nullptr, 1.0f};
        pg8::gemm_phase<EpiMix<1>, pg8::DenseOrder, true, true>(ring, 1024, S, E, F.wave);
#endif
    } SEAM(6);
    if (IN(7)) {
#if F8_WOUT
        pg8::DenseOrder S; S.init(F.ws + WS_MIX8, 1024, F.ws + WS_WO, 512, T, 1024, G, bx);
        EpiOut E{AIN[I_X], (bf16*)(F.ws + WS_X1), (const float*)(F.ws + WS_MODF) + 2048, 1.0f / (F8_SMIX * F8_SWG)};
        pg8::gemm_phase<EpiOut, pg8::DenseOrder, true, true, true>(ring, 512, S, E, F.wave);
#else
        pg8::DenseOrder S; S.init(F.ws + WS_MIX, 2048, F.ws + WS_WO, 1024, T, 1024, G, bx);
        EpiOut E{AIN[I_X], (bf16*)(F.ws + WS_X1), (const float*)(F.ws + WS_MODF) + 2048, 1.0f};
        pg8::gemm_phase<EpiOut, pg8::DenseOrder, true, true>(ring, 1024, S, E, F.wave);
#endif
    } SEAM(7);
    if (IN(8)) {
        pg8::DenseOrder S; S.init(F.ws + WS_XN, 2048, F.ws + WS_WR, 1024, T, 256, 128, bx);
        pg8::Unit u0; const bool has = (bx < 128) && S.next(0, u0);
        if (has) {
            norm_mod_rows<false, true>(F, args, (const float*)(F.ws + WS_X1), (bf16*)(F.ws + WS_XN), AIN[I_N2G], 3072, 4096, F.ws + WS_XN8, u0.pm * 16);
            asm volatile("s_waitcnt vmcnt(0)" ::: "memory"); __syncthreads();
            EpiLogits E{(float*)(F.ws + WS_LOG)};
            pg8::gemm_phase<EpiLogits, pg8::DenseOrder, true, true>(ring, 1024, S, E, F.wave);
            asm volatile("s_waitcnt vmcnt(0)" ::: "memory"); __syncthreads();
            asm volatile("" : "+s"(F.ws)); RELANE();
            routing_phase(F, args, u0.pm * 256);
        } else if (XC_R9 > 0) { expert_convert(F, args, XC_N1, XC_TOTAL, (bx - 128) * NWAVES + F.wave, 128 * NWAVES); }
    } SEAM_LOCAL(8); SEAM_LOCAL(9); SEAM(10);
    if (IN(11)) {
        build_tables(F);
        const LAS int* tab = (const LAS int*)(F.lds + TAB_OFF);
        ExpertOrder S{tab, (const char*)(F.ws + WS_XN8), (const char*)(F.ws + WS_WGU), (const char*)(F.ws + WS_WSHGU), nullptr, (const int*)(F.ws + WS_TOKL), 0, 1, G, F.vcu, tab[260 + NEXP + 1]};
        EpiAct E{F.ws + WS_ACT, F.ws + WS_ACTSH};
#if defined(DBL_MASK) && (DBL_MASK & 0x800)
#pragma unroll 1
        for (int rep = 0; rep < 2; ++rep) { pg8::gemm_phase<EpiAct, ExpertOrder, true, true, true>(ring, 512, S, E, F.wave); if (rep == 0) xcd_barrier(bar); }
#else
        pg8::gemm_phase<EpiAct, ExpertOrder, true, true, true>(ring, 512, S, E, F.wave);
#endif
    } SEAM(11);
    if (IN(12)) {
        build_tables(F);
        const LAS int* tab = (const LAS int*)(F.lds + TAB_OFF);
        ExpertOrder S{tab, (const char*)(F.ws + WS_ACT), (const char*)(F.ws + WS_WD), (const char*)(F.ws + WS_WSHD), (const char*)(F.ws + WS_ACTSH), nullptr, 1, 2, G, F.vcu, 2 * tab[260 + NEXP + 1]};
        EpiDown E{(unsigned char*)(F.ws + WS_YS8), (bf16*)(F.ws + WS_YSS)};
        pg8::gemm_phase<EpiDown, ExpertOrder, true, true, true>(ring, 128, S, E, F.wave);
    } SEAM(12);
    if (IN(13)) { build_tables(F);
#if defined(DBL_MASK) && (DBL_MASK & 0x2000)
        combine_phase(F, args, (float*)(F.ws + WS_ACT)); xcd_barrier(bar); asm volatile("" : "+s"(F.ws), "+s"(F.out));
#endif
        combine_phase(F, args, F.out); }
#undef IN
#undef SEAM
#undef SEAM_LOCAL
#undef RELANE
}

extern "C" void kernel_launch(void* const* d_in, const int* in_sizes, int n_in, void* d_out, int out_size, void* d_ws, size_t ws_size, hipStream_t stream) {
    static int grid = 0;
    if (grid == 0) {
        if (n_in != 31 || in_sizes[0] != T * DM || out_size != T * DM || ws_size < WS_END) { fprintf(stderr, "kernel_launch: unexpected problem (n_in %d, in0 %d, out %d, ws %zu); nothing launched\n", n_in, n_in > 0 ? in_sizes[0] : -1, out_size, ws_size); grid = -1; return; }
        int dev = 0, cus = 0, per_cu = 0;
        if (hipGetDevice(&dev) != hipSuccess || hipDeviceGetAttribute(&cus, hipDeviceAttributeMultiprocessorCount, dev) != hipSuccess) { grid = -1; return; }
        if (hipFuncSetAttribute((const void*)fwd_megakernel, hipFuncAttributeMaxDynamicSharedMemorySize, LDS_BYTES) != hipSuccess) { fprintf(stderr, "kernel_launch: hipFuncSetAttribute failed\n"); grid = -1; return; }
        if (hipOccupancyMaxActiveBlocksPerMultiprocessor(&per_cu, (const void*)fwd_megakernel, NTHREADS, LDS_BYTES) != hipSuccess || per_cu < 1)
            fprintf(stderr, "kernel_launch: note: occupancy query reports %d workgroups per CU\n", per_cu);
        (void)hipGetLastError();
        if (cus < 256) { fprintf(stderr, "kernel_launch: this kernel's work split needs 256 resident workgroups (one per CU); device has %d CUs; nothing launched\n", cus); grid = -1; return; }
        grid = 256;
    }
    if (grid < 0) return;
    if (hipMemsetAsync((char*)d_ws + WS_CTL, 0, CTL_ZERO_BYTES, stream) != hipSuccess) { fprintf(stderr, "kernel_launch: memset failed\n"); return; }
    Args a{};
    for (int i = 0; i < 31; ++i) a.in[i] = (const float*)d_in[i];
    a.out = (float*)d_out; a.ws = (unsigned char*)d_ws;
    for (int li = 0; li < N_LAUNCHES; ++li) {
        a.ph_lo = (N_LAUNCHES == 1) ? 0 : li; a.ph_hi = (N_LAUNCHES == 1) ? N_PHASES : li + 1; a.li = li;
        hipLaunchKernelGGL(fwd_megakernel, dim3(grid), dim3(NTHREADS), LDS_BYTES, stream, a);
        const hipError_t le = hipPeekAtLastError();
        if (le != hipSuccess) { fprintf(stderr, "kernel_launch: launch %d failed: %s\n", li, hipGetErrorName(le)); break; }
    }
}
```

```cpp
#include <hip/hip_runtime.h>
#include <cstdio>
#include <cstdint>

#define GAS __attribute__((address_space(1)))
#define LAS __attribute__((address_space(3)))
typedef unsigned short bf16;
typedef short bf16x8 __attribute__((ext_vector_type(8)));
typedef float f32x4 __attribute__((ext_vector_type(4)));
typedef float f32x2 __attribute__((ext_vector_type(2)));
typedef float f32x16 __attribute__((ext_vector_type(16)));
typedef unsigned u32x4 __attribute__((ext_vector_type(4)));
typedef unsigned u32x2 __attribute__((ext_vector_type(2)));
typedef GAS unsigned gu32;

constexpr int BATCH = 4, SEQ = 8192, DM = 1024, T = BATCH * SEQ;
constexpr int DCONV = 512, CONVK = 31;
constexpr int NH = 16, NG = 4, HG = 4, HD = 64;
constexpr int NCMP = 511, NSEL = 128, SELTOP = 16, WINDOW = 512;
constexpr int NEXP = 256, TOPK = 8, DEXP = 256;
constexpr int NIN = 5680, NINP = 5888;
constexpr float EPS = 1e-6f;
constexpr int NWAVES = 8, NTHREADS = 512;

constexpr size_t MiB = 1u << 20;
constexpr size_t WS_CTL = 0, CTL_ZERO_BYTES = 1 * MiB;
constexpr size_t WS_MODP = 1 * MiB;
constexpr size_t WS_MODF = 2 * MiB;
constexpr size_t WS_PEBP = 2 * MiB + 128 * 1024;
constexpr size_t WS_PEBF = 2 * MiB + 160 * 1024;
constexpr size_t WS_BINP = 2 * MiB + 192 * 1024;
constexpr size_t WS_WIN = 3 * MiB;
constexpr size_t WS_WC = 15 * MiB;
constexpr size_t WS_WN = 16 * MiB;
constexpr size_t WS_WO = 18 * MiB;
constexpr size_t WS_WR = 20 * MiB;
constexpr size_t WS_WSHGU = 21 * MiB;
constexpr size_t WS_WSHD = 22 * MiB;
constexpr size_t WS_CW1 = 23 * MiB;
constexpr size_t WS_CW2 = 24 * MiB;
constexpr size_t WS_WGU = 32 * MiB;
constexpr size_t WS_WD = 288 * MiB;
constexpr size_t WS_XN = 416 * MiB;
constexpr size_t WS_U = 480 * MiB;
constexpr size_t WS_CF = 512 * MiB;
constexpr size_t WS_Q = 544 * MiB;
constexpr size_t WS_O = 608 * MiB;
constexpr size_t WS_KV = 672 * MiB;
constexpr size_t KV_STRIDE = 16 * MiB;
constexpr size_t WS_VST = 768 * MiB;
constexpr size_t WS_VWT = 784 * MiB;
constexpr size_t WS_KC = 800 * MiB;
constexpr size_t WS_VCT = 801 * MiB;
constexpr size_t WS_NGT = 802 * MiB;
constexpr size_t WS_GM = 808 * MiB;
constexpr size_t WS_MIX = 936 * MiB;
constexpr size_t WS_VSF = 936 * MiB;
constexpr size_t WS_KSF = 952 * MiB;
constexpr size_t WS_LOG = 480 * MiB;
constexpr size_t WS_RTE = 512 * MiB;
constexpr size_t WS_RTS = 513 * MiB;
constexpr size_t WS_RTW = 514 * MiB;
constexpr size_t WS_TOKL = 516 * MiB;
constexpr size_t WS_ACT = 548 * MiB;
constexpr size_t WS_ACTSH = 680 * MiB;
constexpr size_t WS_YS8 = 32 * MiB;
constexpr size_t WS_YSS = 416 * MiB;
constexpr size_t WS_XN8A = 512 * MiB;
constexpr size_t WS_X1 = 616 * MiB;
constexpr size_t WS_O8 = 416 * MiB;
constexpr size_t WS_MIX8 = 480 * MiB;
constexpr size_t WS_XN8 = 696 * MiB;
constexpr size_t WS_END = 1024 * MiB;

constexpr int CW_TMO = 0, CW_CODE = 1;
constexpr int CW_BAR = 4096;
constexpr int CW_CNT = 32768;

constexpr int RING_OFF = 0, RING_BYTES = 135168;
constexpr int LDSCTL_OFF = RING_BYTES, MISC_OFF = LDSCTL_OFF + 320;
constexpr int TAB_OFF = LDSCTL_OFF + 1024;
constexpr int LDS_BYTES = 147456;

#define LDS_WAIT() asm volatile("s_waitcnt lgkmcnt(0)" ::: "memory")
#define VM_WAIT() asm volatile("s_waitcnt vmcnt(0)" ::: "memory")
#define RLX_AGENT __ATOMIC_RELAXED, __HIP_MEMORY_SCOPE_AGENT

__device__ __forceinline__ unsigned f2bf(float f) { unsigned u = __builtin_bit_cast(unsigned, f); return (u + 0x7fffu + ((u >> 16) & 1u)) >> 16; }
__device__ __forceinline__ unsigned pk2(float lo, float hi) { return f2bf(lo) | (f2bf(hi) << 16); }
__device__ __forceinline__ float bf2f(unsigned b) { return __builtin_bit_cast(float, b << 16); }
__device__ __forceinline__ float bflo(unsigned w) { return __builtin_bit_cast(float, w << 16); }
__device__ __forceinline__ float bfhi(unsigned w) { return __builtin_bit_cast(float, w & 0xffff0000u); }
__device__ __forceinline__ float sigmoidf_(float x) { return __builtin_amdgcn_rcpf(1.0f + __expf(-x)); }
#define DPP_F(old_, v_, ctrl, rmask) __builtin_bit_cast(float, __builtin_amdgcn_update_dpp(__builtin_bit_cast(int, (old_)), __builtin_bit_cast(int, (v_)), (ctrl), (rmask), 0xF, false))
__device__ __forceinline__ float wave_max(float v) {
    v = fmaxf(v, DPP_F(v, v, 0xB1, 0xF));
    v = fmaxf(v, DPP_F(v, v, 0x4E, 0xF));
    v = fmaxf(v, DPP_F(v, v, 0x141, 0xF));
    v = fmaxf(v, DPP_F(v, v, 0x140, 0xF));
    v = fmaxf(v, DPP_F(v, v, 0x142, 0xA));
    v = fmaxf(v, DPP_F(v, v, 0x143, 0xC));
    return __builtin_bit_cast(float, __builtin_amdgcn_readlane(__builtin_bit_cast(int, v), 63));
}
__device__ __forceinline__ float wave_sum(float v) {
    v += DPP_F(v, v, 0xB1, 0xF); v += DPP_F(v, v, 0x4E, 0xF); v += DPP_F(v, v, 0x141, 0xF); v += DPP_F(v, v, 0x140, 0xF);
    v += DPP_F(0.f, v, 0x142, 0xA);
    v += DPP_F(0.f, v, 0x143, 0xC);
    return __builtin_bit_cast(float, __builtin_amdgcn_readlane(__builtin_bit_cast(int, v), 63));
}

__device__ __forceinline__ int fresh_lane() { unsigned m = ~0u; asm volatile("" : "+s"(m)); return (int)__builtin_amdgcn_mbcnt_hi(m, __builtin_amdgcn_mbcnt_lo(m, 0u)); }
__device__ __forceinline__ unsigned f8pack4(float a, float b, float c, float d, float sc) {
    a = __builtin_amdgcn_fmed3f(a * sc, -448.f, 448.f); b = __builtin_amdgcn_fmed3f(b * sc, -448.f, 448.f); c = __builtin_amdgcn_fmed3f(c * sc, -448.f, 448.f); d = __builtin_amdgcn_fmed3f(d * sc, -448.f, 448.f);
    int w = __builtin_amdgcn_cvt_pk_fp8_f32(a, b, 0, false); w = __builtin_amdgcn_cvt_pk_fp8_f32(c, d, w, true); return (unsigned)w;
}
#ifndef F8_MIXB
#define F8_MIXB 1
#endif
#ifndef F8_MIXA
#define F8_MIXA 0
#endif
constexpr float F8_SX = 4.0f, F8_SWG = 64.0f, F8_SWD = 32.0f, F8_SACT = 2.0f, F8_SMIX = 8.0f, F8_SO = 8.0f, F8_SCF = 8.0f, F8_SWC = 32.0f, F8_SKV = 8.0f, F8_SW1 = 64.0f;

namespace pg8 {
constexpr int BM = 256, BK = 64, HALF = 128, HTB = HALF * BK * 2, STAGE_BYTES = 8 * HTB, NXCD = 8, WGM = 8;
__host__ __device__ __forceinline__ int lds_byte(int r, int c) { const int st = (r >> 4) * 2 + (c >> 5), rr = r & 15, cc = c & 31, ob = rr * 64 + cc * 2; return st * 1024 + (ob ^ (((ob >> 9) & 1) << 5)); }
__host__ __device__ __forceinline__ void stage_rc(int b, int& R, int& C) { const int st = b / 1024, sb = b % 1024, swz = sb ^ (((sb >> 9) & 1) << 5); R = (st >> 1) * 16 + swz / 64; C = (st & 1) * 32 + (swz % 64) / 2; }
__host__ __device__ __forceinline__ int perm32(int rho) { const int n = rho >> 4, i = rho & 15; return 8 * (i >> 2) + 4 * n + (i & 3); }

struct Unit { int pm, pn; const char* A; const char* B; int e, mt, cnt, off; };

typedef __bf16 bf16x2_t __attribute__((ext_vector_type(2)));
__device__ __forceinline__ unsigned cvt_pk_bf16(float lo, float hi) { f32x2 v = {lo, hi}; bf16x2_t b = __builtin_convertvector(v, bf16x2_t); return __builtin_bit_cast(unsigned, b); }

struct DenseOrder {
    const char* A; const char* Bt; int lda_b, K; int nM, nN, nwg, G, c;
    __device__ void init(const void* A_, int lda_bytes, const void* Bt_, int K_, int M, int N, int G_, int c_) { A = (const char*)A_; Bt = (const char*)Bt_; lda_b = lda_bytes; K = K_; nM = M / BM; nN = N / BM; nwg = nM * nN; G = G_; c = c_; }
    __device__ __forceinline__ bool next(int i, Unit& u) const {
        const long L = (long)i * G + c; if (L >= nwg) return false;
        int wgid = (int)L; { const int q = nwg / NXCD, r = nwg % NXCD, xcd = wgid % NXCD, off = wgid / NXCD; wgid = (xcd < r ? xcd * (q + 1) : r * (q + 1) + (xcd - r) * q) + off; }
        const int nig = WGM * nN, gid = wgid / nig, fm = gid * WGM, gsz = (nM - fm) < WGM ? (nM - fm) : WGM;
        u.pm = fm + ((wgid % nig) % gsz); u.pn = (wgid % nig) / gsz;
        u.A = A + (size_t)u.pm * BM * lda_b; u.B = Bt + (size_t)u.pn * BM * K * 2; u.e = 0; u.mt = 0; u.cnt = 0; u.off = 0; return true;
    }
    __device__ __forceinline__ unsigned row_off(const Unit&, int r) const { return (unsigned)r * (unsigned)lda_b; }
};

typedef int i32x4_t __attribute__((ext_vector_type(4)));
typedef int i32x8_t __attribute__((ext_vector_type(8)));
template <class Epi, class Sched, bool ALIGN_EPI, bool SP2, bool FP8 = false>
__device__ __forceinline__ void gemm_phase(LAS unsigned char* lds, const int K, const Sched& S, const Epi& E, const int wid) {
    const int lane = fresh_lane(), tid = wid * 64 + lane, wr = wid >> 2, wc = wid & 3, fr = lane & 15, fq = lane >> 4;
    const int nt = K / BK;
    unsigned voffB[2];
#pragma unroll
    for (int i = 0; i < 2; ++i) { int R, C; stage_rc(tid * 16 + i * 8192, R, C); const int Rb = Epi::PERM ? ((R & ~31) + perm32(R & 31)) : R; voffB[i] = (unsigned)(Rb * K + C) * 2u; }
#define PG8_RC(R0, R1, C0, C1) int R0, R1, C0, C1; { const int t2_ = wid * 64 + fresh_lane(); int c_; stage_rc(t2_ * 16, R0, c_); C0 = c_ * 2; stage_rc(t2_ * 16 + 8192, R1, c_); C1 = c_ * 2; }
    const size_t kstep = (size_t)(BK * 2);
    const size_t hstepB = (size_t)HALF * K * 2;
    const unsigned ldsw = (unsigned)wid * 1024u;
    const int aoff = lds_byte(wr * 64 + fr, fq * 8), boff = lds_byte(wc * 32 + fr, fq * 8);
#define PG8_SA(b, h) (((b) * 2 + (h)) * HTB)
#define PG8_SB(b, h) ((4 + (b) * 2 + (h)) * HTB)
#define PG8_STAGE2(bufoff, gbase, o0, o1) do { \
        __builtin_amdgcn_global_load_lds((const unsigned*)((const char*)(gbase) + (o0)), (LAS unsigned*)(lds + (bufoff) + ldsw), 16, 0, 0); \
        __builtin_amdgcn_global_load_lds((const unsigned*)((const char*)(gbase) + (o1)), (LAS unsigned*)(lds + (bufoff) + ldsw + 8192), 16, 0, 0); } while (0)
#define PG8_STAGEB(bufoff, gbase) PG8_STAGE2(bufoff, gbase, voffB[0], voffB[1])
#define PG8_LD16(off_) (*(const LAS i32x4_t*)(lds + (off_)))
#define PG8_LDA(dst, b, h) do { _Pragma("unroll") for (int m = 0; m < 4; ++m) { \
        if constexpr (FP8) dst##8[m] = __builtin_shufflevector(PG8_LD16(PG8_SA(b, h) + aoff + m * 2048), PG8_LD16(PG8_SA(b, h) + aoff + m * 2048 + 1024), 0, 1, 2, 3, 4, 5, 6, 7); \
        else { _Pragma("unroll") for (int k = 0; k < 2; ++k) dst[m][k] = *(const LAS bf16x8*)(lds + PG8_SA(b, h) + aoff + m * 2048 + k * 1024); } } } while (0)
#define PG8_LDB(dst, b, h) do { _Pragma("unroll") for (int n = 0; n < 2; ++n) { \
        if constexpr (FP8) dst##8[n] = __builtin_shufflevector(PG8_LD16(PG8_SB(b, h) + boff + n * 2048), PG8_LD16(PG8_SB(b, h) + boff + n * 2048 + 1024), 0, 1, 2, 3, 4, 5, 6, 7); \
        else { _Pragma("unroll") for (int k = 0; k < 2; ++k) dst[n][k] = *(const LAS bf16x8*)(lds + PG8_SB(b, h) + boff + n * 2048 + k * 1024); } } } while (0)
#define PG8_MMA(ai, bj, At, Bt) do { __builtin_amdgcn_s_setprio(1); _Pragma("unroll") for (int m = 0; m < 4; ++m) _Pragma("unroll") for (int n = 0; n < 2; ++n) { \
        if constexpr (FP8) asm volatile("v_mfma_f32_16x16x128_f8f6f4 %0, %1, %2, %0" : "+v"(acc[ai][bj][m][n]) : "v"(Bt##8[n]), "v"(At##8[m])); \
        else { _Pragma("unroll") for (int k = 0; k < 2; ++k) acc[ai][bj][m][n] = __builtin_amdgcn_mfma_f32_16x16x32_bf16(Bt[n][k], At[m][k], acc[ai][bj][m][n], 0, 0, 0); } } \
        __builtin_amdgcn_s_setprio(0); } while (0)
#define PG8_WAIT_V(n) asm volatile("s_waitcnt vmcnt(" #n ")" ::: "memory")
#define PG8_WAIT_L(n) asm volatile("s_waitcnt lgkmcnt(" #n ")" ::: "memory")
#define PG8_BAR __builtin_amdgcn_s_barrier()
#define PG8_SCHED __builtin_amdgcn_sched_barrier(0)
    Unit cur, nxt; int ui = 0;
    if (!S.next(0, cur)) return;
    f32x4 acc[2][2][4][2];
    bf16x8 At[4][2], B0[2][2], B1[2][2]; i32x8_t At8[4], B08[2], B18[2];
    unsigned vc00, vc01, vc10, vc11, vn00, vn01, vn10, vn11;
    { PG8_RC(r0, r1, c0, c1); vc00 = S.row_off(cur, r0) + c0; vc01 = S.row_off(cur, r1) + c1; vc10 = S.row_off(cur, HALF + r0) + c0; vc11 = S.row_off(cur, HALF + r1) + c1; }
    const char* cA = cur.A; const char* cB = cur.B;
    PG8_STAGEB(PG8_SB(0, 0), cB); PG8_STAGEB(PG8_SB(0, 1), cB + hstepB); PG8_STAGE2(PG8_SA(0, 0), cA, vc00, vc01); PG8_STAGE2(PG8_SA(0, 1), cA, vc10, vc11);
    if (wr == 1) PG8_BAR;
    PG8_WAIT_V(2); PG8_BAR;
    PG8_STAGEB(PG8_SB(1, 0), cB + kstep); PG8_STAGE2(PG8_SA(1, 0), cA + kstep, vc00, vc01); PG8_STAGEB(PG8_SB(1, 1), cB + hstepB + kstep);
    PG8_WAIT_V(6); PG8_BAR;
#pragma unroll
    for (int a = 0; a < 2; ++a)
#pragma unroll
        for (int b = 0; b < 2; ++b)
#pragma unroll
            for (int m = 0; m < 4; ++m)
#pragma unroll
                for (int n = 0; n < 2; ++n) acc[a][b][m][n] = (f32x4){0.f, 0.f, 0.f, 0.f};
    if constexpr (FP8) asm volatile("s_nop 7" ::: "memory");
    for (;;) {
        const bool has_next = S.next(ui + 1, nxt);
        const char* nA = has_next ? nxt.A : cA; const char* nB = has_next ? nxt.B : cB;
        if (has_next) { PG8_RC(r0, r1, c0, c1); vn00 = S.row_off(nxt, r0) + c0; vn01 = S.row_off(nxt, r1) + c1; vn10 = S.row_off(nxt, HALF + r0) + c0; vn11 = S.row_off(nxt, HALF + r1) + c1; }
        else { vn00 = vc00; vn01 = vc01; vn10 = vc10; vn11 = vc11; }
        for (int t = 0; t < nt; t += 2) {
            const bool last = (t == nt - 2);
            const char* a1 = cA + (size_t)(t + 1) * kstep;
            const char* a2 = last ? nA : cA + (size_t)(t + 2) * kstep; const char* b2 = last ? nB : cB + (size_t)(t + 2) * kstep;
            const char* a3 = a2 + kstep; const char* b3 = b2 + kstep;
            const unsigned x00 = last ? vn00 : vc00, x01 = last ? vn01 : vc01, x10 = last ? vn10 : vc10, x11 = last ? vn11 : vc11;
            PG8_LDB(B0, 0, 0); PG8_LDB(B1, 0, 1); PG8_SCHED; PG8_LDA(At, 0, 0); PG8_STAGE2(PG8_SA(1, 1), a1, vc10, vc11);
            PG8_WAIT_V(8); PG8_WAIT_L(0); PG8_BAR; PG8_MMA(0, 0, At, B0); PG8_MMA(0, 1, At, B1); PG8_BAR; PG8_SCHED;
            PG8_LDA(At, 0, 1); PG8_STAGEB(PG8_SB(0, 0), b2); PG8_STAGEB(PG8_SB(0, 1), b2 + hstepB); PG8_STAGE2(PG8_SA(0, 0), a2, x00, x01);
            PG8_WAIT_V(8); PG8_WAIT_L(0); PG8_BAR; PG8_MMA(1, 0, At, B0); PG8_MMA(1, 1, At, B1); PG8_BAR; PG8_SCHED;
            PG8_LDB(B0, 1, 0); PG8_LDB(B1, 1, 1); PG8_SCHED; PG8_LDA(At, 1, 0); PG8_STAGE2(PG8_SA(0, 1), a2, x10, x11);
            PG8_WAIT_V(8); PG8_WAIT_L(0); PG8_BAR; PG8_MMA(0, 0, At, B0); PG8_MMA(0, 1, At, B1); PG8_BAR; PG8_SCHED;
            PG8_LDA(At, 1, 1); PG8_STAGEB(PG8_SB(1, 0), b3); PG8_STAGEB(PG8_SB(1, 1), b3 + hstepB); PG8_STAGE2(PG8_SA(1, 0), a3, x00, x01);
            PG8_WAIT_V(8); PG8_WAIT_L(0); PG8_BAR; PG8_MMA(1, 0, At, B0); PG8_MMA(1, 1, At, B1); PG8_BAR; PG8_SCHED;
        }
        if constexpr (ALIGN_EPI) { if (wr == 0) PG8_BAR; }
        if constexpr (FP8) asm volatile("s_nop 15\n\ts_nop 7" ::: "memory");
        E(acc, cur, wr, wc, fr, fq);
        if (!has_next) break;
#pragma unroll
        for (int a = 0; a < 2; ++a)
#pragma unroll
            for (int b = 0; b < 2; ++b)
#pragma unroll
                for (int m = 0; m < 4; ++m)
#pragma unroll
                    for (int n = 0; n < 2; ++n) acc[a][b][m][n] = (f32x4){0.f, 0.f, 0.f, 0.f};
        if constexpr (FP8) asm volatile("s_nop 7" ::: "memory");
        cur = nxt; cA = nA; cB = nB; ++ui; vc00 = vn00; vc01 = vn01; vc10 = vn10; vc11 = vn11;
        if constexpr (ALIGN_EPI) { if (wr == 1) PG8_BAR; }
    }
    PG8_WAIT_V(0);
    if constexpr (!ALIGN_EPI) { if (wr == 0) PG8_BAR; }
    PG8_BAR;
#undef PG8_SA
#undef PG8_SB
#undef PG8_STAGE2
#undef PG8_STAGEB
#undef PG8_LDA
#undef PG8_LDB
#undef PG8_MMA
#undef PG8_LD16
#undef PG8_RC
#undef PG8_WAIT_V
#undef PG8_WAIT_L
#undef PG8_BAR
#undef PG8_SCHED
}
}
using pg8::Unit;
using pg8::cvt_pk_bf16;

__device__ __forceinline__ u32x4 pack8(const f32x4& v0, const f32x4& v1) { u32x4 w; w.x = cvt_pk_bf16(v0[0], v0[1]); w.y = cvt_pk_bf16(v0[2], v0[3]); w.z = cvt_pk_bf16(v1[0], v1[1]); w.w = cvt_pk_bf16(v1[2], v1[3]); return w; }
__device__ __forceinline__ f32x4 sig4(const f32x4& v) { return (f32x4){sigmoidf_(v[0]), sigmoidf_(v[1]), sigmoidf_(v[2]), sigmoidf_(v[3])}; }
__device__ __forceinline__ void unpack8(const u32x4& w, f32x4& a, f32x4& b) { a = (f32x4){bflo(w.x), bfhi(w.x), bflo(w.y), bfhi(w.y)}; b = (f32x4){bflo(w.z), bfhi(w.z), bflo(w.w), bfhi(w.w)}; }

struct EpiIn {
    static constexpr bool PERM = true;
    const float* binp; bf16* U; bf16* Q; bf16* KV; bf16* NGt; bf16* GM; float ds;
    __device__ __forceinline__ void operator()(const f32x4 (&acc)[2][2][4][2], const Unit& u, int wr, int wc, int fr, int fq) const {
        const int row0 = u.pm * 256 + wr * 64 + fr, pn = u.pn, cin = wc * 32 + 8 * fq;
        f32x4 bv[2][2];
#pragma unroll
        for (int bj = 0; bj < 2; ++bj)
#pragma unroll
            for (int n = 0; n < 2; ++n) bv[bj][n] = *(const f32x4*)(binp + pn * 256 + bj * 128 + cin + 4 * n);
        if (pn < 4) {
#pragma unroll
            for (int ai = 0; ai < 2; ++ai)
#pragma unroll
                for (int m = 0; m < 4; ++m) { const size_t row = (size_t)(row0 + ai * 128 + m * 16);
                    const f32x4 a0 = (acc[ai][0][m][0] * ds) + bv[0][0], a1 = (acc[ai][0][m][1] * ds) + bv[0][1], g0 = sig4((acc[ai][1][m][0] * ds) + bv[1][0]), g1 = sig4((acc[ai][1][m][1] * ds) + bv[1][1]);
                    *(u32x4*)(U + row * 512 + pn * 128 + cin) = pack8(a0 * g0, a1 * g1); }
        } else if (pn < 14) {
            bf16* base; int ld; float sc = 1.f;
            if (pn < 8) { base = Q + (pn - 4) * 256; ld = 1024; sc = 0.125f; } else { base = KV + (size_t)(pn - 8) * (KV_STRIDE / 2); ld = 256; }
#pragma unroll
            for (int ai = 0; ai < 2; ++ai)
#pragma unroll
                for (int m = 0; m < 4; ++m) { bf16* rp = base + (size_t)(row0 + ai * 128 + m * 16) * ld + cin;
#pragma unroll
                    for (int bj = 0; bj < 2; ++bj) { const f32x4 va = ((acc[ai][bj][m][0] * ds) + bv[bj][0]) * sc, vb = ((acc[ai][bj][m][1] * ds) + bv[bj][1]) * sc;
                        if (pn == 8 || pn == 9) *(u32x2*)((unsigned char*)KV + (size_t)(pn - 8) * KV_STRIDE + (size_t)(row0 + ai * 128 + m * 16) * 256 + cin + bj * 128) = (u32x2){f8pack4(va[0], va[1], va[2], va[3], F8_SKV), f8pack4(vb[0], vb[1], vb[2], vb[3], F8_SKV)};
                        else *(u32x4*)(rp + bj * 128) = pack8(va, vb); } }
        } else if (pn == 14) {
            if (wc < 2) {
#pragma unroll
                for (int ai = 0; ai < 2; ++ai)
#pragma unroll
                    for (int m = 0; m < 4; ++m) { const size_t row = (size_t)(row0 + ai * 128 + m * 16);
                        *(u32x4*)(NGt + row * 64 + cin) = pack8(sig4((acc[ai][0][m][0] * ds) + bv[0][0]), sig4((acc[ai][0][m][1] * ds) + bv[0][1])); }
            }
        } else {
#pragma unroll
            for (int ai = 0; ai < 2; ++ai)
#pragma unroll
                for (int m = 0; m < 4; ++m) { bf16* rp = GM + (size_t)(row0 + ai * 128 + m * 16) * 2048 + (pn - 15) * 256 + cin;
#pragma unroll
                    for (int bj = 0; bj < 2; ++bj) *(u32x4*)(rp + bj * 128) = pack8(sig4((acc[ai][bj][m][0] * ds) + bv[bj][0]), sig4((acc[ai][bj][m][1] * ds) + bv[bj][1])); }
        }
    }
};

template <int MODE> struct EpiMix {
    static constexpr bool PERM = true;
    const bf16* GM; bf16* MIX; const float* bias; unsigned char* MIX8; float ds;
    __device__ __forceinline__ void operator()(const f32x4 (&acc)[2][2][4][2], const Unit& u, int wr, int wc, int fr, int fq) const {
        const int row0 = u.pm * 256 + wr * 64 + fr, col0 = u.pn * 256 + wc * 32 + 8 * fq;
        f32x4 bv[2][2];
#pragma unroll
        for (int bj = 0; bj < 2; ++bj)
#pragma unroll
            for (int n = 0; n < 2; ++n) bv[bj][n] = (MODE == 0) ? *(const f32x4*)(bias + col0 + bj * 128 + 4 * n) : (f32x4){0.f, 0.f, 0.f, 0.f};
#pragma unroll
        for (int ai = 0; ai < 2; ++ai)
#pragma unroll
            for (int m = 0; m < 4; ++m) { const size_t row = (size_t)(row0 + ai * 128 + m * 16);
#pragma unroll
                for (int bj = 0; bj < 2; ++bj) { const int col = col0 + bj * 128;
                    f32x4 g0, g1; unpack8(*(const u32x4*)(GM + row * 2048 + MODE * 1024 + col), g0, g1);
                    f32x4 v0 = (acc[ai][bj][m][0] * ds + bv[bj][0]) * g0, v1 = (acc[ai][bj][m][1] * ds + bv[bj][1]) * g1;
                    if (MODE == 1) { f32x4 p0, p1; unpack8(*(const u32x4*)(MIX + row * 1024 + col), p0, p1); v0 += p0; v1 += p1; }
                    if (MODE == 1 && MIX8) *(u32x2*)(MIX8 + row * 1024 + col) = (u32x2){f8pack4(v0[0], v0[1], v0[2], v0[3], F8_SMIX), f8pack4(v1[0], v1[1], v1[2], v1[3], F8_SMIX)};
                    else *(u32x4*)(MIX + row * 1024 + col) = pack8(v0, v1); } }
    }
};

struct EpiOut {
    static constexpr bool PERM = false;
    const float* x; bf16* x1; const float* g1; float ds;
    __device__ __forceinline__ void operator()(const f32x4 (&acc)[2][2][4][2], const Unit& u, int wr, int wc, int fr, int fq) const {
        const int row0 = u.pm * 256 + wr * 64 + fr, col0 = u.pn * 256 + wc * 32 + 4 * fq; const int b = (u.pm * 256) >> 13;
        f32x4 gv[2][2];
#pragma unroll
        for (int bj = 0; bj < 2; ++bj)
#pragma unroll
            for (int n = 0; n < 2; ++n) gv[bj][n] = *(const f32x4*)(g1 + b * 6144 + col0 + bj * 128 + 16 * n) * ds;
#pragma unroll
        for (int ai = 0; ai < 2; ++ai)
#pragma unroll
            for (int m = 0; m < 4; ++m) { const size_t off = (size_t)(row0 + ai * 128 + m * 16) * 1024 + col0;
#pragma unroll
                for (int bj = 0; bj < 2; ++bj)
#pragma unroll
                    for (int n = 0; n < 2; ++n) { const f32x4 xv = *(const f32x4*)(x + off + bj * 128 + 16 * n); const f32x4 y = xv + gv[bj][n] * acc[ai][bj][m][n];
                        *(u32x2*)(x1 + off + bj * 128 + 16 * n) = (u32x2){cvt_pk_bf16(y[0], y[1]), cvt_pk_bf16(y[2], y[3])}; } }
    }
};

struct EpiLogits {
    static constexpr bool PERM = false;
    float* L;
    __device__ __forceinline__ void operator()(const f32x4 (&acc)[2][2][4][2], const Unit& u, int wr, int wc, int fr, int fq) const {
        const int row0 = u.pm * 256 + wr * 64 + fr, col0 = wc * 32 + 4 * fq;
#pragma unroll
        for (int ai = 0; ai < 2; ++ai)
#pragma unroll
            for (int m = 0; m < 4; ++m) { const size_t off = (size_t)(row0 + ai * 128 + m * 16) * 256 + col0;
#pragma unroll
                for (int bj = 0; bj < 2; ++bj)
#pragma unroll
                    for (int n = 0; n < 2; ++n) *(f32x4*)(L + off + bj * 128 + 16 * n) = acc[ai][bj][m][n]; }
    }
};

struct EpiAct {
    static constexpr bool PERM = true;
    unsigned char* ACT; unsigned char* ACTSH;
    __device__ __forceinline__ void operator()(const f32x4 (&acc)[2][2][4][2], const Unit& u, int wr, int wc, int fr, int fq) const {
        const int slot0 = u.mt * 256 + wr * 64 + fr, col = (u.pn & 1) * 128 + wc * 32 + 8 * fq;
        unsigned char* base = (u.e == NEXP) ? ACTSH : ACT + (size_t)u.off * 256;
        constexpr float ds = 1.0f / (F8_SX * F8_SWG);
#pragma unroll
        for (int ai = 0; ai < 2; ++ai)
#pragma unroll
            for (int m = 0; m < 4; ++m) { const int slot = slot0 + ai * 128 + m * 16;
                if (slot < u.cnt) { const f32x4 g0 = acc[ai][0][m][0] * ds, g1 = acc[ai][0][m][1] * ds;
                    const f32x4 a0 = g0 * sig4(g0) * (acc[ai][1][m][0] * ds), a1 = g1 * sig4(g1) * (acc[ai][1][m][1] * ds);
                    *(u32x2*)(base + (size_t)slot * 256 + col) = (u32x2){f8pack4(a0[0], a0[1], a0[2], a0[3], F8_SACT), f8pack4(a1[0], a1[1], a1[2], a1[3], F8_SACT)}; } }
    }
};

constexpr float YS_SCALE = 16.0f;
__device__ __forceinline__ unsigned pack4_fp8(const f32x4& v) {
    const float a = __builtin_amdgcn_fmed3f(v[0] * YS_SCALE, -448.f, 448.f), b = __builtin_amdgcn_fmed3f(v[1] * YS_SCALE, -448.f, 448.f);
    const float c = __builtin_amdgcn_fmed3f(v[2] * YS_SCALE, -448.f, 448.f), d = __builtin_amdgcn_fmed3f(v[3] * YS_SCALE, -448.f, 448.f);
    int w = __builtin_amdgcn_cvt_pk_fp8_f32(a, b, 0, false); w = __builtin_amdgcn_cvt_pk_fp8_f32(c, d, w, true); return (unsigned)w;
}
__device__ __forceinline__ f32x4 unpack4_fp8(unsigned w) { const f32x2 lo = __builtin_amdgcn_cvt_pk_f32_fp8((int)w, false), hi = __builtin_amdgcn_cvt_pk_f32_fp8((int)w, true); return (f32x4){lo.x, lo.y, hi.x, hi.y}; }
struct EpiDown {
    static constexpr bool PERM = true;
    unsigned char* YS8; bf16* YSS;
    __device__ __forceinline__ void operator()(const f32x4 (&acc)[2][2][4][2], const Unit& u, int wr, int wc, int fr, int fq) const {
        const int slot0 = u.mt * 256 + wr * 64 + fr, cin = wc * 32 + 8 * fq;
        if (u.e == NEXP) {
            bf16* rowp0 = YSS + (size_t)slot0 * 1024 + u.pn * 256 + cin;
#pragma unroll
            for (int ai = 0; ai < 2; ++ai)
#pragma unroll
                for (int m = 0; m < 4; ++m)
#pragma unroll
                    for (int bj = 0; bj < 2; ++bj) *(u32x4*)(rowp0 + (size_t)(ai * 128 + m * 16) * 1024 + bj * 128) = pack8(acc[ai][bj][m][0] * (1.0f / (F8_SACT * F8_SWD)), acc[ai][bj][m][1] * (1.0f / (F8_SACT * F8_SWD)));
        } else {
            const int colb = u.pn * 256 + cin;
#pragma unroll
            for (int ai = 0; ai < 2; ++ai)
#pragma unroll
                for (int m = 0; m < 4; ++m) { const int slot = slot0 + ai * 128 + m * 16;
                    if (slot < u.cnt) { unsigned char* rowp = YS8 + (size_t)(u.off + slot) * 1024 + colb;
#pragma unroll
                        for (int bj = 0; bj < 2; ++bj) *(u32x2*)(rowp + bj * 128) = (u32x2){pack4_fp8(acc[ai][bj][m][0] * (1.0f / (F8_SACT * F8_SWD))), pack4_fp8(acc[ai][bj][m][1] * (1.0f / (F8_SACT * F8_SWD)))}; } }
        }
    }
};

struct ExpertOrder {
    LAS const int* tab; const char* Abase; const char* Bexp; const char* Bsh; const char* Ash; const int* tokl; int mode, umul, G, c, nunits;
    __device__ __forceinline__ bool next(int i, Unit& u) const {
        const int L = i * G + c; if (L >= nunits) return false;
        const int lo = __builtin_amdgcn_readfirstlane((int)((const LAS unsigned short*)(tab + 832))[L / umul]);
        const int e = lo, cnt = __builtin_amdgcn_readfirstlane(tab[e]), nte = (cnt + 255) >> 8, r = L - __builtin_amdgcn_readfirstlane(tab[260 + e]) * umul, j = r / nte, mt = r - j * nte;
        u.e = e; u.mt = mt; u.cnt = cnt; u.off = __builtin_amdgcn_readfirstlane(tab[520 + e]); u.pm = 0;
        if (mode == 0) { u.pn = j; u.A = Abase; u.B = (e == NEXP) ? Bsh + (size_t)j * 256 * 1024 : Bexp + ((size_t)e * 512 + j * 256) * 1024; }
        else { const int pn = j; u.pn = pn;
            u.A = (e == NEXP) ? Ash + (size_t)mt * 256 * 256 : Abase + ((size_t)u.off + (size_t)mt * 256) * 256;
            u.B = (e == NEXP) ? Bsh + (size_t)pn * 256 * 256 : Bexp + ((size_t)e * 1024 + pn * 256) * 256; }
        return true;
    }
    __device__ __forceinline__ unsigned row_off(const Unit& u, int r) const {
        if (mode == 0) { const int slot = u.mt * 256 + r; int tok = slot; if (u.e != NEXP) tok = (slot < u.cnt) ? tokl[(size_t)u.e * T + slot] : 0; return (unsigned)tok * 1024u; }
        return (unsigned)r * 256u;
    }
};

#define XB_TMO      128
#define XB_XCNT(j)  (256  + 64 * (j))
#define XB_XSUB(j)  (1280 + 64 * (j))
#define XB_XGEN(j)  (2304 + 64 * (j))
#define XB_TOP      3328
#define XB_TOPGEN   3392
#define XCD_BAR_WORDS 3456
#define XB_SPIN_CAP (1u << 22)
__device__ __forceinline__ unsigned xb_ld(unsigned* p)              { return __hip_atomic_load(p, __ATOMIC_RELAXED, __HIP_MEMORY_SCOPE_AGENT); }
__device__ __forceinline__ unsigned xb_add(unsigned* p, unsigned v) { return __hip_atomic_fetch_add(p, v, __ATOMIC_RELAXED, __HIP_MEMORY_SCOPE_AGENT); }
__device__ __forceinline__ unsigned xb_xcc_id() { return (unsigned)__builtin_amdgcn_s_getreg((3 << 11) | 20) & 0xFu; }
#define XB_SPIN(cond, bar) do { unsigned _sp = 0; while (cond) { __builtin_amdgcn_s_sleep(1); \
    if ((++_sp & 255u) == 0u) { if (xb_ld(&(bar)[XB_TMO])) break; if (_sp > XB_SPIN_CAP) { atomicAdd(&(bar)[XB_TMO], 1u); break; } } } } while (0)
struct XcdBarrier { unsigned* bar; unsigned x; volatile LAS unsigned* st; int wave; };
__device__ __forceinline__ XcdBarrier xcd_barrier_post(unsigned* bar, volatile LAS unsigned* st, int wave) {
    XcdBarrier b; b.bar = bar; b.x = xb_xcc_id(); b.st = st; b.wave = wave;
    if (wave == 0 && fresh_lane() == 0) (void)xb_add(&bar[XB_XCNT(b.x)], 1u);
    return b;
}
__device__ __forceinline__ void xcd_barrier_complete(unsigned* bar, unsigned x, unsigned& nloc, unsigned& nx) {
    const unsigned G = gridDim.x * gridDim.y * gridDim.z;
    unsigned sum, cnt, mine, sp = 0u;
    for (;;) {
        sum = 0u; cnt = 0u; mine = 0u;
#pragma unroll
        for (unsigned j = 0; j < 16; ++j) { const unsigned c = xb_ld(&bar[XB_XCNT(j)]); sum += c; cnt += (c > 0u) ? 1u : 0u; mine = (j == x) ? c : mine; }
        if (sum == G) break;
        __builtin_amdgcn_s_sleep(1);
        if ((++sp & 255u) == 0u) { if (xb_ld(&bar[XB_TMO])) break; if (sp > XB_SPIN_CAP) { atomicAdd(&bar[XB_TMO], 1u); break; } }
    }
    nloc = mine > 0u ? mine : 1u; nx = cnt > 0u ? cnt : 1u;
}
__device__ __forceinline__ void xcd_barrier(const XcdBarrier& b) {
    asm volatile("s_waitcnt vmcnt(0)" ::: "memory");
    __syncthreads();
    if (b.wave == 0 && fresh_lane() == 0) {
        unsigned* bar = b.bar;
        __builtin_amdgcn_s_waitcnt(0);
        unsigned nloc = b.st[0], nx = b.st[1];
        if (nloc == 0u) { xcd_barrier_complete(bar, b.x, nloc, nx); b.st[0] = nloc; b.st[1] = nx; }
        const unsigned old = xb_add(&bar[XB_XSUB(b.x)], 1u);
        const unsigned gen = old / nloc;
        if (old + 1u == (gen + 1u) * nloc) {
            __builtin_amdgcn_fence(__ATOMIC_RELEASE, "agent");
            asm volatile("s_waitcnt vmcnt(0)" ::: "memory");
            const unsigned og = xb_add(&bar[XB_TOP], 1u);
            const unsigned tg = og / nx;
            if (og + 1u == (tg + 1u) * nx) xb_add(&bar[XB_TOPGEN], 1u);
            else XB_SPIN(xb_ld(&bar[XB_TOPGEN]) == tg, bar);
            __builtin_amdgcn_fence(__ATOMIC_ACQUIRE, "agent");
            xb_add(&bar[XB_XGEN(b.x)], 1u);
            asm volatile("s_waitcnt vmcnt(0)" ::: "memory");
        } else {
            XB_SPIN(xb_ld(&bar[XB_XGEN(b.x)]) == gen, bar);
            __builtin_amdgcn_fence(__ATOMIC_ACQUIRE, "agent");
            asm volatile("s_waitcnt vmcnt(0)" ::: "memory");
        }
    }
    __syncthreads();
}
#ifndef F8_WIN
#define F8_WIN 1
#endif
#ifndef F8_WOUT
#define F8_WOUT 1
#endif
struct Args { const float* in[31]; float* out; unsigned char* ws; int ph_lo, ph_hi, li, pad; };
struct Frame {
    LAS unsigned char* lds;
    volatile LAS unsigned* MISC;
    gu32* ctl;
    int tid, lane, wave, vcu, G;
    unsigned char* ws;
    float* out;
};
#define AIN args.in
enum { I_X = 0, I_C, I_WADA, I_BADA, I_N1G, I_WIN, I_BIN, I_CONVW, I_CONVB, I_LNG, I_LNB, I_WCO, I_BCO, I_PEK, I_W1K, I_W2K, I_PEV, I_W1V, I_W2V, I_WNSA, I_WOUT, I_N2G, I_WR, I_RB, I_SHG, I_SHU, I_SHD, I_WG, I_WU, I_WDN, I_FG };

__device__ __forceinline__ void xpose_item(const float* W, int ldw, int ncols, bf16* WT, int K, LAS float* scr, int kb, int nb, int lane, float f8s = 0.f) {
    const int k0 = 64 * kb, n0 = 32 * nb, c4 = 4 * (lane & 7), rg = lane >> 3; const bool nv = (n0 + c4) < ncols;
    f32x4 v[8];
#pragma unroll
    for (int i = 0; i < 8; ++i) v[i] = nv ? *(const f32x4*)(W + (size_t)(k0 + 8 * i + rg) * ldw + n0 + c4) : (f32x4){0.f, 0.f, 0.f, 0.f};
#pragma unroll
    for (int i = 0; i < 8; ++i) { LAS float* p = scr + (8 * i + rg) * 33 + c4; p[0] = v[i].x; p[1] = v[i].y; p[2] = v[i].z; p[3] = v[i].w; }
    LDS_WAIT(); asm volatile("" ::: "memory");
    const int c = lane & 7;
#pragma unroll
    for (int j = 0; j < 4; ++j) { const int n = (lane >> 3) + 8 * j; const LAS float* s = scr + (8 * c) * 33 + n;
        if (f8s > 0.f) { *(GAS u32x2*)((unsigned char*)WT + (size_t)(n0 + n) * K + k0 + 8 * c) = (u32x2){f8pack4(s[0 * 33], s[1 * 33], s[2 * 33], s[3 * 33], f8s), f8pack4(s[4 * 33], s[5 * 33], s[6 * 33], s[7 * 33], f8s)}; }
        else { u32x4 o; o.x = pk2(s[0 * 33], s[1 * 33]); o.y = pk2(s[2 * 33], s[3 * 33]); o.z = pk2(s[4 * 33], s[5 * 33]); o.w = pk2(s[6 * 33], s[7 * 33]);
            *(GAS u32x4*)(WT + (size_t)(n0 + n) * K + k0 + 8 * c) = o; } }
    LDS_WAIT(); asm volatile("" ::: "memory");
}
#define XSEC8(Wp, ldw, ncols, WTp, K, nbl, f8s) do { const int _n = ((K) / 64) * (nbl); if (r < _n) { xpose_item((Wp), (ldw), (ncols), (WTp), (K), scr, r / (nbl), r % (nbl), F.lane, (f8s)); return; } r -= _n; } while (0)
#define XSEC(Wp, ldw, ncols, WTp, K, nbl) XSEC8(Wp, ldw, ncols, WTp, K, nbl, 0.f)

__device__ __forceinline__ void p0_small_item(Frame& F, const Args& args, LAS float* scr, int r) {
    const float* w_in = AIN[I_WIN];
#if F8_WIN
    unsigned char* WINB = F.ws + WS_WIN;
#define WIN_SEC(Wp, ncols, drow, nbl) XSEC8(Wp, NIN, ncols, (bf16*)(WINB + (size_t)(drow) * 1024), 1024, nbl, F8_SWG)
#else
    bf16* WIN = (bf16*)(F.ws + WS_WIN);
#define WIN_SEC(Wp, ncols, drow, nbl) XSEC(Wp, NIN, ncols, WIN + (size_t)(drow) * 1024, 1024, nbl)
#endif
#pragma unroll 1
    for (int p = 0; p < 4; ++p) { WIN_SEC(w_in + 128 * p, 128, 256 * p, 4); }
#pragma unroll 1
    for (int p = 0; p < 4; ++p) { WIN_SEC(w_in + 512 + 128 * p, 128, 256 * p + 128, 4); }
    WIN_SEC(w_in + 1024, 2560, 1024, 80);
    WIN_SEC(w_in + 3584, 48, 3584, 8);
    WIN_SEC(w_in + 3632, 2048, 3840, 64);
#undef WIN_SEC
#if F8_MIXA
    XSEC8(AIN[I_WCO], 1024, 1024, (bf16*)(F.ws + WS_WC), 512, 32, F8_SWC);
#else
    XSEC(AIN[I_WCO], 1024, 1024, (bf16*)(F.ws + WS_WC), 512, 32);
#endif
#if F8_MIXB
    XSEC8(AIN[I_WNSA], 1024, 1024, (bf16*)(F.ws + WS_WN), 1024, 32, F8_SWG);
#else
    XSEC(AIN[I_WNSA], 1024, 1024, (bf16*)(F.ws + WS_WN), 1024, 32);
#endif
#if F8_WOUT
    XSEC8(AIN[I_WOUT], 1024, 1024, (bf16*)(F.ws + WS_WO), 1024, 32, F8_SWG);
#else
    XSEC(AIN[I_WOUT], 1024, 1024, (bf16*)(F.ws + WS_WO), 1024, 32);
#endif
    XSEC(AIN[I_WR], 256, 256, (bf16*)(F.ws + WS_WR), 1024, 8);
#pragma unroll 1
    for (int p = 0; p < 2; ++p) { XSEC8(AIN[I_SHG] + 128 * p, 256, 128, (bf16*)(F.ws + WS_WSHGU + (size_t)(256 * p) * 1024), 1024, 4, F8_SWG); }
#pragma unroll 1
    for (int p = 0; p < 2; ++p) { XSEC8(AIN[I_SHU] + 128 * p, 256, 128, (bf16*)(F.ws + WS_WSHGU + (size_t)(256 * p + 128) * 1024), 1024, 4, F8_SWG); }
    XSEC8(AIN[I_SHD], 1024, 1024, (bf16*)(F.ws + WS_WSHD), 256, 32, F8_SWD);
    if (r < 256) {
        const int which = r >> 7, l = (r >> 2) & 31, ct = r & 3, lane = F.lane, c32 = lane & 31, hi = lane >> 5;
        const float* q = AIN[which ? I_W1V : I_W1K] + (size_t)(64 * l + 32 * hi) * 128 + 32 * ct + c32;
        unsigned char* dst = F.ws + WS_CW1 + ((size_t)(((which * 32 + l) * 4 + ct) * 64) + lane) * 32;
        u32x4 o0, o1;
        o0.x = f8pack4(q[0 * 128], q[1 * 128], q[2 * 128], q[3 * 128], F8_SW1); o0.y = f8pack4(q[4 * 128], q[5 * 128], q[6 * 128], q[7 * 128], F8_SW1);
        o0.z = f8pack4(q[8 * 128], q[9 * 128], q[10 * 128], q[11 * 128], F8_SW1); o0.w = f8pack4(q[12 * 128], q[13 * 128], q[14 * 128], q[15 * 128], F8_SW1);
        o1.x = f8pack4(q[16 * 128], q[17 * 128], q[18 * 128], q[19 * 128], F8_SW1); o1.y = f8pack4(q[20 * 128], q[21 * 128], q[22 * 128], q[23 * 128], F8_SW1);
        o1.z = f8pack4(q[24 * 128], q[25 * 128], q[26 * 128], q[27 * 128], F8_SW1); o1.w = f8pack4(q[28 * 128], q[29 * 128], q[30 * 128], q[31 * 128], F8_SW1);
        *(GAS u32x4*)dst = o0; *(GAS u32x4*)(dst + 16) = o1;
        return; }
    r -= 256;
    XSEC(AIN[I_W2K], 64, 64, (bf16*)(F.ws + WS_CW2), 128, 2);
    XSEC(AIN[I_W2V], 64, 64, (bf16*)(F.ws + WS_CW2) + 64 * 128, 128, 2);
}
constexpr int P0_SMALL_ITEMS = 8 * 64 + 1280 + 128 + 1024 + 256 + 512 + 512 + 128 + 4 * 64 + 128 + 128 + 128 + 4 + 4;
struct XDesc { const float* src; unsigned char* dst; int ldw, K; float sc; };
__device__ __forceinline__ XDesc expert_desc(Frame& F, const Args& args, int it) {
    const int e = it / 192, r = it - e * 192; XDesc d;
    if (r < 128) { const int up = r >> 6, q = r & 63, kb = q >> 2, nb = q & 3, p = nb >> 1, o = (nb & 1) * 64;
        d.src = (up ? AIN[I_WU] : AIN[I_WG]) + (size_t)e * 1024 * 256 + (size_t)(64 * kb) * 256 + 128 * p + o; d.ldw = 256; d.K = 1024; d.sc = F8_SWG;
        d.dst = (unsigned char*)(F.ws + WS_WGU) + (size_t)e * 512 * 1024 + (size_t)(256 * p + 128 * up + o) * 1024 + 64 * kb; }
    else { const int rr = r - 128, kb = rr >> 4, nb = rr & 15;
        d.src = AIN[I_WDN] + (size_t)e * 256 * 1024 + (size_t)(64 * kb) * 1024 + 64 * nb; d.ldw = 1024; d.K = 256; d.sc = F8_SWD;
        d.dst = (unsigned char*)(F.ws + WS_WD) + (size_t)e * 1024 * 256 + (size_t)(64 * nb) * 256 + 64 * kb; }
    return d;
}
__device__ __forceinline__ void xload(const XDesc& d, f32x4 (&v)[16], int lane) {
    const int c4 = 4 * (lane & 15), rg = lane >> 4;
#pragma unroll
    for (int i = 0; i < 16; ++i) v[i] = *(const f32x4*)(d.src + (size_t)(4 * i + rg) * d.ldw + c4);
}
__device__ __forceinline__ void xstore(const XDesc& d, const f32x4 (&v)[16], LAS float* scr, int lane) {
    const int c4 = 4 * (lane & 15), rg = lane >> 4;
#pragma unroll
    for (int i = 0; i < 16; ++i) { LAS float* p = scr + (4 * i + rg) * 65 + c4; p[0] = v[i].x; p[1] = v[i].y; p[2] = v[i].z; p[3] = v[i].w; }
    LDS_WAIT(); asm volatile("" ::: "memory");
    const int c = lane & 7;
#pragma unroll
    for (int j = 0; j < 8; ++j) { const int n = (lane >> 3) + 8 * j; const LAS float* s = scr + (8 * c) * 65 + n;
        *(GAS u32x2*)(d.dst + (size_t)n * d.K + 8 * c) = (u32x2){f8pack4(s[0 * 65], s[1 * 65], s[2 * 65], s[3 * 65], d.sc), f8pack4(s[4 * 65], s[5 * 65], s[6 * 65], s[7 * 65], d.sc)}; }
    LDS_WAIT(); asm volatile("" ::: "memory");
}
__device__ __forceinline__ void p0_mod_item(Frame& F, const Args& args, int it) {
    const int kc = it / 96, nc = it - kc * 96;
    const float* W = AIN[I_WADA] + (size_t)(128 * kc) * 6144 + 64 * nc + F.lane; const float* c = AIN[I_C] + 128 * kc;
    float sa[4][2];
#pragma unroll
    for (int bb = 0; bb < 4; ++bb)
#pragma unroll
        for (int hh = 0; hh < 2; ++hh) { const float cv = c[1024 * bb + 64 * hh + F.lane]; sa[bb][hh] = cv * sigmoidf_(cv); }
    float a0 = 0.f, a1 = 0.f, a2 = 0.f, a3 = 0.f;
#pragma unroll
    for (int kb = 0; kb < 4; ++kb) { float w[32];
#pragma unroll
        for (int kk = 0; kk < 32; ++kk) w[kk] = W[(size_t)(32 * kb + kk) * 6144];
#pragma unroll
        for (int kk = 0; kk < 32; ++kk) { const int k = 32 * kb + kk, hh = k >> 6, sl = k & 63;
            a0 += __builtin_bit_cast(float, __builtin_amdgcn_readlane(__builtin_bit_cast(int, sa[0][hh]), sl)) * w[kk]; a1 += __builtin_bit_cast(float, __builtin_amdgcn_readlane(__builtin_bit_cast(int, sa[1][hh]), sl)) * w[kk];
            a2 += __builtin_bit_cast(float, __builtin_amdgcn_readlane(__builtin_bit_cast(int, sa[2][hh]), sl)) * w[kk]; a3 += __builtin_bit_cast(float, __builtin_amdgcn_readlane(__builtin_bit_cast(int, sa[3][hh]), sl)) * w[kk]; } }
    float* P = (float*)(F.ws + WS_MODP) + (size_t)kc * 4 * 6144 + 64 * nc + F.lane;
    P[0] = a0; P[6144] = a1; P[2 * 6144] = a2; P[3 * 6144] = a3;
}
__device__ __forceinline__ void p0_peb_item(Frame& F, const Args& args, int it) {
    const int which = it & 1, cc = (it >> 1) & 1, kc = it >> 2;
    const float* pe = AIN[which ? I_PEV : I_PEK] + 256 * kc; const float* w1 = AIN[which ? I_W1V : I_W1K] + (size_t)(256 * kc) * 128 + 64 * cc + F.lane;
    float a = 0.f;
#pragma unroll 1
    for (int kb = 0; kb < 8; ++kb) { float w[32];
#pragma unroll
        for (int kk = 0; kk < 32; ++kk) w[kk] = w1[(size_t)(32 * kb + kk) * 128];
#pragma unroll
        for (int kk = 0; kk < 32; ++kk) a += pe[32 * kb + kk] * w[kk]; }
    ((float*)(F.ws + WS_PEBP))[(kc * 2 + which) * 128 + 64 * cc + F.lane] = a;
}
__device__ __forceinline__ int binp_src(int d) {
    if (d < 1024) { const int p = d >> 8, o = d & 255; return (o < 128) ? 128 * p + o : 512 + 128 * p + (o - 128); }
    if (d < 3584) return d;
    if (d < 3840) return (d - 3584 < 48) ? d : -1;
    return 3632 + (d - 3840);
}
constexpr int XC_TOTAL = NEXP * 192;
#ifndef XC_R2
#define XC_R2 4096
#endif
#ifndef XC_R9
#define XC_R9 24576
#endif
constexpr int XC_N0 = XC_TOTAL - XC_R2 - XC_R9, XC_N1 = XC_TOTAL - XC_R9;
__device__ __forceinline__ void expert_convert(Frame& F, const Args& args, const int first, const int last, const int gw, const int ngw) {
    int it = first + gw; f32x4 va[16], vb[16]; XDesc da, db;
    LAS float* scr = (LAS float*)(F.lds + RING_OFF) + F.wave * (64 * 65);
    if (it < last) { da = expert_desc(F, args, it); xload(da, va, F.lane); }
#pragma unroll 1
    while (it < last) {
        const int i1 = it + ngw; if (i1 < last) { db = expert_desc(F, args, i1); xload(db, vb, F.lane); }
        xstore(da, va, scr, F.lane);
        if (i1 >= last) break;
        const int i2 = i1 + ngw; if (i2 < last) { da = expert_desc(F, args, i2); xload(da, va, F.lane); }
        xstore(db, vb, scr, F.lane);
        it = i2;
    }
}
__device__ __forceinline__ void p0_prologue(Frame& F, const Args& args) {
    LAS float* scr = (LAS float*)(F.lds + RING_OFF + F.wave * 16384);
    const int gw = F.vcu * NWAVES + F.wave, NGW = F.G * NWAVES;
    constexpr int N_MOD = 768, N_PEB = 32;
    constexpr int N_PRE = N_MOD + N_PEB + P0_SMALL_ITEMS;
    for (int it = gw; it < N_PRE; it += NGW) {
        int r = it;
        if (r < N_MOD) { p0_mod_item(F, args, r); continue; } r -= N_MOD;
        if (r < N_PEB) { p0_peb_item(F, args, r); continue; } r -= N_PEB;
        p0_small_item(F, args, scr, r);
    }
    __syncthreads();
    expert_convert(F, args, 0, XC_N0, gw, NGW);
    float* binp = (float*)(F.ws + WS_BINP);
    for (int d = gw * 64 + F.lane; d < NINP; d += NGW * 64) { const int s = binp_src(d); binp[d] = (s >= 0) ? AIN[I_BIN][s] : 0.f; }
}

__device__ __forceinline__ float modsum(const Frame& F, const Args& args, int b, int j) {
    const float* P = (const float*)(F.ws + WS_MODP) + (size_t)b * 6144 + j; float s = AIN[I_BADA][j];
#pragma unroll
    for (int kc = 0; kc < 8; ++kc) s += P[(size_t)kc * 4 * 6144];
    return s;
}
template <bool FROM_PARTIALS, bool SRC_BF16 = false>
__device__ __forceinline__ void norm_mod_rows(Frame& F, const Args& args, const float* src, bf16* dst, const float* gam, int shift_off, int scale_off, unsigned char* dst8 = nullptr, int tile_blk0 = -1) {
    const int gw = F.vcu * NWAVES + F.wave, NGW = F.G * NWAVES;
    const int blk_lo = (tile_blk0 >= 0) ? tile_blk0 + F.wave : gw, blk_hi = (tile_blk0 >= 0) ? tile_blk0 + 16 : T / 16, blk_st = (tile_blk0 >= 0) ? NWAVES : NGW;
    LAS float* ml = (LAS float*)(F.lds + RING_OFF);
    if (FROM_PARTIALS) {
        const int b0 = (16 * (F.vcu * NWAVES)) >> 13;
#pragma unroll
        for (int q = 0; q < 4; ++q) { const int idx = F.tid + 512 * q; ml[idx] = modsum(F, args, b0, (idx < 1024 ? scale_off + idx : shift_off + idx - 1024)); }
        __syncthreads();
    }
    for (int blk = blk_lo; blk < blk_hi; blk += blk_st) {
        const int m0 = blk * 16, b = m0 >> 13;
        f32x4 av[4], sv[4];
#pragma unroll
        for (int j = 0; j < 4; ++j) { const int col = 4 * F.lane + 256 * j; const f32x4 g = *(const f32x4*)(gam + col); f32x4 sc, sh;
            if (FROM_PARTIALS) { sc = *(const LAS f32x4*)(ml + col); sh = *(const LAS f32x4*)(ml + 1024 + col);
            } else { const float* mf = (const float*)(F.ws + WS_MODF) + b * 6144; sc = *(const f32x4*)(mf + scale_off + col); sh = *(const f32x4*)(mf + shift_off + col); }
            av[j] = g * (sc + 1.0f); sv[j] = sh; }
#pragma unroll 2
        for (int i = 0; i < 16; ++i) {
            f32x4 v[4]; float s = 0.f;
            if (SRC_BF16) { const GAS u32x2* xb = (const GAS u32x2*)((const bf16*)src + (size_t)(m0 + i) * 1024) + F.lane;
#pragma unroll
                for (int j = 0; j < 4; ++j) { const u32x2 w = xb[64 * j]; v[j] = (f32x4){bflo(w.x), bfhi(w.x), bflo(w.y), bfhi(w.y)}; }
            } else { const GAS f32x4* xr = (const GAS f32x4*)(src + (size_t)(m0 + i) * 1024) + F.lane;
#pragma unroll
                for (int j = 0; j < 4; ++j) v[j] = xr[64 * j]; }
#pragma unroll
            for (int j = 0; j < 4; ++j) s += (v[j].x * v[j].x + v[j].y * v[j].y) + (v[j].z * v[j].z + v[j].w * v[j].w);
            const float rstd = 1.0f / sqrtf(wave_sum(s) * (1.0f / 1024.0f) + EPS);
            GAS u32x2* o8 = (GAS u32x2*)(dst + (size_t)(m0 + i) * 1024) + F.lane;
#pragma unroll
            for (int j = 0; j < 4; ++j) { const f32x4 y = v[j] * rstd * av[j] + sv[j]; if (dst) { u32x2 w; w.x = pk2(y.x, y.y); w.y = pk2(y.z, y.w); o8[64 * j] = w; }
                if (dst8) ((GAS unsigned*)(dst8 + (size_t)(m0 + i) * 1024))[F.lane + 64 * j] = f8pack4(y.x, y.y, y.z, y.w, F8_SX); }
        }
    }
}
__device__ __forceinline__ void finalize_mod(Frame& F, const Args& args) {
    const int gw = F.vcu * NWAVES + F.wave, NGW = F.G * NWAVES;
    for (int it = gw; it < 384; it += NGW) { const int b = it / 96, j = (it % 96) * 64 + F.lane; ((float*)(F.ws + WS_MODF))[b * 6144 + j] = modsum(F, args, b, j); }
    for (int it = gw; it < 388 && it >= 384; it += NGW) { const int idx = (it - 384) * 64 + F.lane; float s = 0.f;
#pragma unroll
        for (int kc = 0; kc < 8; ++kc) s += ((const float*)(F.ws + WS_PEBP))[kc * 256 + idx];
        ((float*)(F.ws + WS_PEBF))[idx] = s; }
}

__device__ __forceinline__ void conv_phase(Frame& F, const Args& args) {
    const bf16* U = (const bf16*)(F.ws + WS_U); bf16* CF = (bf16*)(F.ws + WS_CF);
    LAS float* cv = (LAS float*)(F.lds + RING_OFF);
    const int c = F.tid;
    float w[CONVK];
#pragma unroll
    for (int j = 0; j < CONVK; ++j) w[j] = AIN[I_CONVW][j * 512 + c];
    const float cb = AIN[I_CONVB][c];
    for (int it = F.vcu; it < T / 32; it += F.G) {
        const int m0 = it * 32, s0 = m0 & (SEQ - 1);
        float uv[62];
#pragma unroll
        for (int i = 0; i < 62; ++i) { const int s = s0 - 30 + i; uv[i] = (s >= 0) ? bf2f(U[(size_t)(m0 - 30 + i) * 512 + c]) : 0.f; }
#pragma unroll
        for (int tt = 0; tt < 32; ++tt) { float a = cb;
#pragma unroll
            for (int j = 0; j < CONVK; ++j) a += w[j] * uv[tt + j];
            cv[tt * 512 + c] = a; }
        __syncthreads();
#pragma unroll
        for (int q = 0; q < 4; ++q) { const int tt = F.wave * 4 + q;
            const f32x4 v0 = *(const LAS f32x4*)(cv + tt * 512 + 8 * F.lane), v1 = *(const LAS f32x4*)(cv + tt * 512 + 8 * F.lane + 4);
            const float mu = wave_sum((v0.x + v0.y) + (v0.z + v0.w) + (v1.x + v1.y) + (v1.z + v1.w)) * (1.0f / 512.0f);
            const f32x4 d0 = v0 - mu, d1 = v1 - mu;
            const float var = wave_sum((d0.x * d0.x + d0.y * d0.y) + (d0.z * d0.z + d0.w * d0.w) + (d1.x * d1.x + d1.y * d1.y) + (d1.z * d1.z + d1.w * d1.w)) * (1.0f / 512.0f);
            const float rstd = 1.0f / sqrtf(var + EPS);
            const f32x4 g0 = *(const f32x4*)(AIN[I_LNG] + 8 * F.lane), g1 = *(const f32x4*)(AIN[I_LNG] + 8 * F.lane + 4), b0 = *(const f32x4*)(AIN[I_LNB] + 8 * F.lane), b1 = *(const f32x4*)(AIN[I_LNB] + 8 * F.lane + 4);
            f32x4 y0 = d0 * rstd * g0 + b0, y1 = d1 * rstd * g1 + b1;
            y0 = y0 * sig4(y0); y1 = y1 * sig4(y1);
#if F8_MIXA
            *(GAS u32x2*)((unsigned char*)CF + (size_t)(m0 + tt) * 512 + 8 * F.lane) = (u32x2){f8pack4(y0.x, y0.y, y0.z, y0.w, F8_SCF), f8pack4(y1.x, y1.y, y1.z, y1.w, F8_SCF)}; }
#else
            u32x4 o; o.x = pk2(y0.x, y0.y); o.y = pk2(y0.z, y0.w); o.z = pk2(y1.x, y1.y); o.w = pk2(y1.z, y1.w);
            *(GAS u32x4*)(CF + (size_t)(m0 + tt) * 512 + 8 * F.lane) = o; }
#endif
        __syncthreads();
    }
}

__device__ __forceinline__ int perm16(int s) { return (s & ~12) | ((s & 4) << 1) | ((s & 8) >> 1); }
__device__ __forceinline__ float gelu_tanh(float x) { const float u2 = 1.5957691216057308f * (x + 0.044715f * x * x * x); return x * sigmoidf_(u2); }
__device__ __forceinline__ void compress_item(Frame& F, int it, int part) {
    const int which = it & 1, rt = (it >> 1) & 15, bg = it >> 5, b = bg >> 2, g = bg & 3;
    const int lane = F.lane, c32 = lane & 31, hi = lane >> 5;
    const unsigned char* W1F = F.ws + WS_CW1 + (size_t)which * (32 * 4 * 64 * 32) + (size_t)lane * 32;
    const bf16* W2T = (const bf16*)(F.ws + WS_CW2) + which * 64 * 128;
    const float* peb = (const float*)(F.ws + WS_PEBF) + which * 128;
    int n = rt * 32 + c32; const bool nvalid = n <= 510; if (!nvalid) n = 510;
    const unsigned char* zp = F.ws + WS_KV + (size_t)which * KV_STRIDE + ((size_t)(b * SEQ + 16 * n)) * 256 + g * 64 + 32 * hi;
    f32x16 acc[4];
#pragma unroll
    for (int ct = 0; ct < 4; ++ct) acc[ct] = (f32x16){0.f};
    asm volatile("s_nop 4" ::: "memory");
#pragma unroll 2
    for (int l = 8 * part; l < 8 * part + 8; ++l) {
        const pg8::i32x4_t z0 = *(const pg8::i32x4_t*)(zp + (size_t)l * 256), z1 = *(const pg8::i32x4_t*)(zp + (size_t)l * 256 + 16);
        const pg8::i32x8_t bz = __builtin_shufflevector(z0, z1, 0, 1, 2, 3, 4, 5, 6, 7);
#pragma unroll
        for (int ct = 0; ct < 4; ++ct) { const unsigned char* wq = W1F + (size_t)(l * 4 + ct) * 2048;
            const pg8::i32x4_t w0 = *(const pg8::i32x4_t*)wq, w1 = *(const pg8::i32x4_t*)(wq + 16);
            const pg8::i32x8_t aw = __builtin_shufflevector(w0, w1, 0, 1, 2, 3, 4, 5, 6, 7);
            asm volatile("v_mfma_f32_32x32x64_f8f6f4 %0, %1, %2, %0" : "+v"(acc[ct]) : "v"(aw), "v"(bz)); }
    }
    asm volatile("s_nop 15\n\ts_nop 7" : "+v"(acc[0]), "+v"(acc[1]), "+v"(acc[2]), "+v"(acc[3]));
#pragma unroll
    for (int ct = 0; ct < 4; ++ct) acc[ct] *= (1.0f / (F8_SKV * F8_SW1));
    { LAS f32x4* px = (LAS f32x4*)(F.lds + RING_OFF) + (size_t)(F.wave >> 2) * 4096 + lane;
      if (part != 0) {
#pragma unroll
          for (int ct = 0; ct < 4; ++ct)
#pragma unroll
              for (int q = 0; q < 4; ++q) px[((part - 1) * 16 + ct * 4 + q) * 64] = (f32x4){acc[ct][4 * q], acc[ct][4 * q + 1], acc[ct][4 * q + 2], acc[ct][4 * q + 3]};
      }
      __syncthreads();
      if (part != 0) return;
#pragma unroll 1
      for (int p = 0; p < 3; ++p) {
#pragma unroll
          for (int ct = 0; ct < 4; ++ct)
#pragma unroll
              for (int q = 0; q < 4; ++q) { const f32x4 v = px[(p * 16 + ct * 4 + q) * 64]; acc[ct][4 * q] += v.x; acc[ct][4 * q + 1] += v.y; acc[ct][4 * q + 2] += v.z; acc[ct][4 * q + 3] += v.w; }
      }
    }
    f32x16 o[2]; o[0] = (f32x16){0.f}; o[1] = (f32x16){0.f};
#pragma unroll
    for (int ct = 0; ct < 4; ++ct) {
#pragma unroll
        for (int r = 0; r < 16; ++r) { const int cidx = 32 * ct + (r & 3) + 8 * (r >> 2) + 4 * hi; acc[ct][r] = gelu_tanh(acc[ct][r] + peb[cidx]); }
#pragma unroll
        for (int s = 0; s < 2; ++s) {
            u32x4 pw; pw.x = cvt_pk_bf16(acc[ct][8 * s + 0], acc[ct][8 * s + 1]); pw.y = cvt_pk_bf16(acc[ct][8 * s + 2], acc[ct][8 * s + 3]); pw.z = cvt_pk_bf16(acc[ct][8 * s + 4], acc[ct][8 * s + 5]); pw.w = cvt_pk_bf16(acc[ct][8 * s + 6], acc[ct][8 * s + 7]);
            const bf16x8 pb = __builtin_bit_cast(bf16x8, pw);
#pragma unroll
            for (int mt = 0; mt < 2; ++mt) { const bf16* ap = W2T + (size_t)(32 * mt + c32) * 128 + 32 * ct + 16 * s + 4 * hi;
                const u32x2 lo = *(const u32x2*)ap, hh = *(const u32x2*)(ap + 8); u32x4 aw; aw.x = lo.x; aw.y = lo.y; aw.z = hh.x; aw.w = hh.y;
                o[mt] = __builtin_amdgcn_mfma_f32_32x32x16_bf16(__builtin_bit_cast(bf16x8, aw), pb, o[mt], 0, 0, 0); }
        }
    }
    if (nvalid) {
        if (which == 0) { bf16* kc = (bf16*)(F.ws + WS_KC) + ((size_t)bg * 512 + n) * 64;
#pragma unroll
            for (int mt = 0; mt < 2; ++mt)
#pragma unroll
                for (int q4 = 0; q4 < 4; ++q4) { u32x2 w; w.x = pk2(o[mt][4 * q4], o[mt][4 * q4 + 1]); w.y = pk2(o[mt][4 * q4 + 2], o[mt][4 * q4 + 3]); *(u32x2*)(kc + 32 * mt + 8 * q4 + 4 * hi) = w; }
        } else { bf16* vc = (bf16*)(F.ws + WS_VCT) + (size_t)bg * 64 * 512 + perm16(n);
#pragma unroll
            for (int mt = 0; mt < 2; ++mt)
#pragma unroll
                for (int r = 0; r < 16; ++r) { const int d = 32 * mt + (r & 3) + 8 * (r >> 2) + 4 * hi; vc[(size_t)d * 512] = (bf16)f2bf(o[mt][r]); }
        }
    }
}
__device__ __forceinline__ void vtrans_item(Frame& F, int it) {
    const int which = it & 1, tile = (it >> 1) & 127, bg = it >> 8, b = bg >> 2, g = bg & 3, lane = F.lane;
    const bf16* V = (const bf16*)(F.ws + WS_KV + (size_t)(which ? 5 : 3) * KV_STRIDE) + ((size_t)(b * SEQ + tile * 64)) * 256 + g * 64;
    bf16* VT = (bf16*)(F.ws + (which ? WS_VWT : WS_VST)) + (size_t)bg * 64 * SEQ + tile * 64;
    LAS unsigned* scr = (LAS unsigned*)(F.lds + RING_OFF + F.wave * 16384);
#pragma unroll
    for (int i = 0; i < 8; ++i) { const int row = 8 * i + (lane >> 3), ch = lane & 7; const u32x4 v = *(const u32x4*)(V + (size_t)row * 256 + 8 * ch);
        LAS unsigned* p = scr + row * 33 + 4 * ch; p[0] = v.x; p[1] = v.y; p[2] = v.z; p[3] = v.w; }
    LDS_WAIT(); asm volatile("" ::: "memory");
#pragma unroll
    for (int i = 0; i < 8; ++i) { const int d = 8 * i + (lane >> 3), ch = lane & 7; unsigned e[8];
#pragma unroll
        for (int j = 0; j < 8; ++j) { const int tok = perm16(8 * ch + j); const unsigned wv = scr[tok * 33 + (d >> 1)]; e[j] = (d & 1) ? (wv >> 16) : (wv & 0xffffu); }
        u32x4 o; o.x = e[0] | (e[1] << 16); o.y = e[2] | (e[3] << 16); o.z = e[4] | (e[5] << 16); o.w = e[6] | (e[7] << 16);
        *(u32x4*)(VT + (size_t)d * SEQ + 8 * ch) = o;
        }
    LDS_WAIT(); asm volatile("" ::: "memory");
}
__device__ __forceinline__ void p3_phase(Frame& F, const Args& args) {
#ifdef TSTAMP
#define PSTAMP(k) do { if (blockIdx.x == 0 && F.tid == 0) ((unsigned long long*)(F.ctl + 41000))[(k)] = __builtin_amdgcn_s_memrealtime(); } while (0)
#else
#define PSTAMP(k) do {} while (0)
#endif
    PSTAMP(20);
    conv_phase(F, args);
    PSTAMP(21);
    const int gw = F.vcu * NWAVES + F.wave, NGW = F.G * NWAVES;
    compress_item(F, gw >> 2, F.wave & 3);
    __syncthreads();
    PSTAMP(22);
    for (int it = gw; it < 4096; it += NGW) vtrans_item(F, it);
    PSTAMP(23);

}

#define DPP_U(v_, ctrl) ((unsigned)__builtin_amdgcn_update_dpp((int)(v_), (int)(v_), (ctrl), 0xF, 0xF, false))
__device__ __forceinline__ unsigned row16_max_u(unsigned v) {
    v = max(v, DPP_U(v, 0xB1)); v = max(v, DPP_U(v, 0x4E)); v = max(v, DPP_U(v, 0x141)); v = max(v, DPP_U(v, 0x140)); return v;
}
__device__ __forceinline__ float row16_sum_f(float v) {
    v += DPP_F(v, v, 0xB1, 0xF); v += DPP_F(v, v, 0x4E, 0xF); v += DPP_F(v, v, 0x141, 0xF); v += DPP_F(v, v, 0x140, 0xF); return v;
}
__device__ __forceinline__ void routing_phase(Frame& F, const Args& args, const int tok0) {
    const float* LOG = (const float*)(F.ws + WS_LOG); const float* rb = AIN[I_RB];
    int* RTE = (int*)(F.ws + WS_RTE); int* RTS = (int*)(F.ws + WS_RTS); float* RTW = (float*)(F.ws + WS_RTW); int* TOKL = (int*)(F.ws + WS_TOKL);
    unsigned* CNT = (unsigned*)(F.ctl + CW_CNT);
    const int gw = F.vcu * NWAVES + F.wave, NGW = F.G * NWAVES, lane = F.lane, row = lane >> 4, l16 = lane & 15;
    f32x4 bias[4];
#pragma unroll
    for (int j = 0; j < 4; ++j) bias[j] = *(const f32x4*)(rb + 16 * l16 + 4 * j);
    f32x4 lgn[4];
    (void)gw; (void)NGW;
    { const int t0 = tok0 + 4 * F.wave + row;
#pragma unroll
      for (int j = 0; j < 4; ++j) lgn[j] = (t0 < T) ? *(const f32x4*)(LOG + (size_t)t0 * 256 + 16 * l16 + 4 * j) : (f32x4){0.f, 0.f, 0.f, 0.f}; }
    LAS unsigned* cntl = (LAS unsigned*)(F.lds + RING_OFF); LAS unsigned* basel = cntl + 256;
    LAS u32x4* pend = (LAS u32x4*)(F.lds + RING_OFF + 2048 + F.wave * 8192);
    LAS float* rbl = (LAS float*)(F.lds + RING_OFF + 2048 + 8 * 8192);
    if (F.tid < 256) { cntl[F.tid] = 0u; rbl[F.tid] = rb[F.tid]; }
    __syncthreads();
    int it = 0;
    for (int tb = tok0 + 4 * F.wave; tb < tok0 + 256; tb += 32, ++it) {
        const int t = tb + row;
        f32x4 lg[4];
#pragma unroll
        for (int j = 0; j < 4; ++j) lg[j] = lgn[j];
        { const int tn = tb + 32 + row;
          if (tb + 32 < tok0 + 256) {
#pragma unroll
              for (int j = 0; j < 4; ++j) lgn[j] = *(const f32x4*)(LOG + (size_t)tn * 256 + 16 * l16 + 4 * j); } }
        float sf[16]; unsigned key[16];
#pragma unroll
        for (int j = 0; j < 16; ++j) { const float sc = sigmoidf_(lg[j >> 2][j & 3]); sf[j] = sc + bias[j >> 2][j & 3];
            key[j] = (__builtin_bit_cast(unsigned, sf[j] + 1.0f) & ~0xFFu) | (unsigned)(255 - (16 * l16 + j)); }
        float a1 = fmaxf(sf[0], sf[1]), a2 = fminf(sf[0], sf[1]);
#pragma unroll
        for (int j = 2; j < 16; ++j) { const float nv = sf[j]; a2 = fmaxf(a2, fminf(a1, nv)); a1 = fmaxf(a1, nv); }
        { const float b1 = DPP_F(a1, a1, 0xB1, 0xF), b2 = DPP_F(a2, a2, 0xB1, 0xF); const float n1 = fmaxf(a1, b1), n2 = fmaxf(fminf(a1, b1), fmaxf(a2, b2)); a1 = n1; a2 = n2; }
        const float gs = a1 + a2; const int myg = l16 >> 1;
        int rank = 0;
#define RK_STEP(d) { const float og = DPP_F(gs, gs, 0x120 + 2 * (d), 0xF); const int gq = (myg - (d)) & 7; rank += (og > gs || (og == gs && gq < myg)) ? 1 : 0; }
        RK_STEP(1) RK_STEP(2) RK_STEP(3) RK_STEP(4) RK_STEP(5) RK_STEP(6) RK_STEP(7)
#undef RK_STEP
        const bool gsel = rank < 4;
#pragma unroll
        for (int j = 0; j < 16; ++j) key[j] = gsel ? key[j] : 0u;
        unsigned mysel = 0u;
#pragma unroll
        for (int r = 0; r < TOPK; ++r) {
            unsigned m = max(max(key[0], key[1]), max(key[2], key[3]));
#pragma unroll
            for (int j = 4; j < 16; j += 4) m = max(m, max(max(key[j], key[j + 1]), max(key[j + 2], key[j + 3])));
            const unsigned mx = row16_max_u(m);
            mysel = (l16 == r) ? mx : mysel;
#pragma unroll
            for (int j = 0; j < 16; ++j) key[j] = (key[j] == mx) ? 0u : key[j];
        }
        const bool act = l16 < TOPK;
        const int e = 255 - (int)(mysel & 0xFFu);
        float scv = 0.f;
        if (act) scv = __builtin_bit_cast(float, mysel & ~0xFFu) - 1.0f - rbl[e];
        const float wsum = row16_sum_f(scv);
        const float w = scv * (2.5f / wsum);
        unsigned loc = 0u;
        if (act && t < T) loc = __hip_atomic_fetch_add(cntl + e, 1u, __ATOMIC_RELAXED, __HIP_MEMORY_SCOPE_WORKGROUP);
        if (it < 8) pend[it * 64 + lane] = (u32x4){(act && t < T) ? (unsigned)t : 0xFFFFFFFFu, (unsigned)e, loc, __builtin_bit_cast(unsigned, w)};
    }
    __syncthreads();
    if (F.tid < 256) { const unsigned c = cntl[F.tid]; basel[F.tid] = c ? __hip_atomic_fetch_add(CNT + 32 * F.tid, c, RLX_AGENT) : 0u; }
    __syncthreads();
    for (int k = 0; k < it && k < 8; ++k) { const u32x4 pv = pend[k * 64 + lane];
        const unsigned pt = pv.x, pe = pv.y, pl = pv.z, pw = pv.w;
        if (pt != 0xFFFFFFFFu) { const unsigned slot = basel[pe] + pl; const size_t o = (size_t)pt * 8 + l16;
            RTE[o] = (int)pe; RTS[o] = (int)slot; RTW[o] = __builtin_bit_cast(float, pw); TOKL[(size_t)pe * T + slot] = (int)pt; } }
}
__device__ __forceinline__ void build_tables(Frame& F) {
    LAS int* tab = (LAS int*)(F.lds + TAB_OFF); LAS int* wsu = tab + 800; LAS int* wso = tab + 816;
    __syncthreads();
    const int e = F.tid, lane = F.lane;
    int c = 0;
    if (e < NEXP) c = (int)__hip_atomic_load((unsigned*)(F.ctl + CW_CNT) + 32 * e, RLX_AGENT); else if (e == NEXP) c = T;
    const int us = (e <= NEXP) ? 2 * ((c + 255) >> 8) : 0, off = (e < NEXP) ? c : 0;
    if (e <= NEXP) tab[e] = c;
    int su = us, so = off;
#pragma unroll
    for (int d = 1; d < 64; d <<= 1) { const int tu = __shfl_up(su, d), to = __shfl_up(so, d); if (lane >= d) { su += tu; so += to; } }
    if (lane == 63) { wsu[F.wave] = su; wso[F.wave] = so; }
    __syncthreads();
    int pu = 0, po = 0;
    for (int w2 = 0; w2 < F.wave; ++w2) { pu += wsu[w2]; po += wso[w2]; }
    if (e <= NEXP) { tab[260 + e] = pu + su - us; tab[520 + e] = (e < NEXP) ? po + so - off : 0; }
    if (e == NEXP) tab[260 + NEXP + 1] = pu + su;
    if (e <= NEXP) { LAS unsigned short* u2e = (LAS unsigned short*)(tab + 832); const int u0 = pu + su - us;
        for (int q = 0; q < us; ++q) u2e[u0 + q] = (unsigned short)e; }
    __syncthreads();
}
__device__ __forceinline__ void combine_phase(Frame& F, const Args& args, float* dstbase) {
    const LAS int* tab = (const LAS int*)(F.lds + TAB_OFF);
    const int* RTE = (const int*)(F.ws + WS_RTE); const int* RTS = (const int*)(F.ws + WS_RTS); const float* RTW = (const float*)(F.ws + WS_RTW);
    const unsigned char* YS8 = (const unsigned char*)(F.ws + WS_YS8);
    int lane = F.lane; asm volatile("" : "+v"(lane));
    const int gw = F.vcu * NWAVES + F.wave, NGW = F.G * NWAVES;
    const float* fg = AIN[I_FG];
    float tscale = 1.0f;
#ifdef TSTAMP
    { const unsigned long long* ts = (const unsigned long long*)(F.ctl + 41000); const float us = (float)(long long)(ts[TS_B] - ts[TS_A]) * 0.01f;
      const float lvl = fminf(fmaxf(floorf((us - (float)(TS_BASE)) / (float)(TS_STEP)) + 1.0f, 0.0f), 5.0f); tscale *= 1.0f + 0.01f * lvl; }
#endif
#ifdef SELFCHECK
    { const float ce = __hip_atomic_load((float*)(F.ctl + 60000), RLX_AGENT), cn = __hip_atomic_load((float*)(F.ctl + 60000) + 1, RLX_AGENT); tscale *= 1.0f + CHK_K * sqrtf(ce / fmaxf(cn, 1e-30f)); }
#endif
    for (int t = gw; t < T; t += NGW) {
        int pos = 0; float w = 0.f;
        if (lane < TOPK) { const int e = RTE[(size_t)t * 8 + lane]; pos = tab[520 + e] + RTS[(size_t)t * 8 + lane]; w = RTW[(size_t)t * 8 + lane]; }
        u32x4 rows[TOPK];
#pragma unroll
        for (int k = 0; k < TOPK; ++k) { const int pk = __builtin_amdgcn_readlane(pos, k); rows[k] = *(const u32x4*)(YS8 + (size_t)pk * 1024 + 16 * lane); }
        const bf16* sp = (const bf16*)(F.ws + WS_YSS) + (size_t)t * 1024 + 16 * lane; const u32x4 sh0 = *(const u32x4*)sp, sh1 = *(const u32x4*)(sp + 8);
        f32x4 x[4];
        { const bf16* xp = (const bf16*)(F.ws + WS_X1) + (size_t)t * 1024 + 16 * lane; const u32x4 xa = *(const u32x4*)xp, xb = *(const u32x4*)(xp + 8); unpack8(xa, x[0], x[1]); unpack8(xb, x[2], x[3]); }
        f32x4 y[4]; unpack8(sh0, y[0], y[1]); unpack8(sh1, y[2], y[3]);
#pragma unroll
        for (int k = 0; k < TOPK; ++k) { const float wk = __builtin_bit_cast(float, __builtin_amdgcn_readlane(__builtin_bit_cast(int, w), k)) * (1.0f / YS_SCALE); y[0] += unpack4_fp8(rows[k].x) * wk; y[1] += unpack4_fp8(rows[k].y) * wk; y[2] += unpack4_fp8(rows[k].z) * wk; y[3] += unpack4_fp8(rows[k].w) * wk; }
        const float* g2 = (const float*)(F.ws + WS_MODF) + (t >> 13) * 6144 + 5120 + 16 * lane;
        float s = 0.f;
#pragma unroll
        for (int q = 0; q < 4; ++q) { x[q] += *(const f32x4*)(g2 + 4 * q) * y[q]; s += (x[q].x * x[q].x + x[q].y * x[q].y) + (x[q].z * x[q].z + x[q].w * x[q].w); }
        const float rstd = tscale / sqrtf(wave_sum(s) * (1.0f / 1024.0f) + EPS);
#pragma unroll
        for (int q = 0; q < 4; ++q) *(f32x4*)(dstbase + (size_t)t * 1024 + 16 * lane + 4 * q) = x[q] * rstd * *(const f32x4*)(fg + 16 * lane + 4 * q);
    }
}
namespace att {
constexpr int TSZ = 8192;
constexpr int NBUF = 4, BUFB = 2 * TSZ;
constexpr int L_BUF = 0;
constexpr int L_IMP = NBUF * BUFB;
constexpr int L_SEL = 131072;
constexpr int L_END = L_SEL + 1024;
static_assert(L_END <= RING_BYTES, "attention LDS");
constexpr float L2E = 1.4426950408889634f;
enum { M_WIN = 0, M_SEL = 1, M_CMP1 = 2, M_CMP2 = 3 };

__device__ __forceinline__ float qxor1(float v) { return __builtin_bit_cast(float, __builtin_amdgcn_update_dpp(0, __builtin_bit_cast(int, v), 0xB1, 0xF, 0xF, false)); }
__device__ __forceinline__ float qxor2(float v) { return __builtin_bit_cast(float, __builtin_amdgcn_update_dpp(0, __builtin_bit_cast(int, v), 0x4E, 0xF, 0xF, false)); }
__device__ __forceinline__ float halfsum(float v) { const unsigned a = __builtin_bit_cast(unsigned, v); auto rr = __builtin_amdgcn_permlane32_swap(a, a, false, false); const unsigned r0 = rr[0], r1 = rr[1]; return __builtin_bit_cast(float, r0) + __builtin_bit_cast(float, r1); }
__device__ __forceinline__ float halfmax(float v) { const unsigned a = __builtin_bit_cast(unsigned, v); auto rr = __builtin_amdgcn_permlane32_swap(a, a, false, false); const unsigned r0 = rr[0], r1 = rr[1]; return fmaxf(__builtin_bit_cast(float, r0), __builtin_bit_cast(float, r1)); }

struct State { float m, l; f32x16 o0, o1; };
__device__ __forceinline__ float max3f(float a, float b, float c) { float r; asm("v_max3_f32 %0, %1, %2, %3" : "=v"(r) : "v"(a), "v"(b), "v"(c)); return r; }
__device__ __forceinline__ float max2f(float a, float b) { float r; asm("v_max_f32_e32 %0, %1, %2" : "=v"(r) : "v"(a), "v"(b)); return r; }
__device__ __forceinline__ float tilemax(const f32x16& p0, const f32x16& p1) {
    float a = max3f(p0[0], p0[1], p1[0]), b = max3f(p0[2], p0[3], p1[1]); a = max3f(a, p1[2], p1[3]);
#pragma unroll
    for (int r = 4; r < 16; r += 4) { a = max3f(a, p0[r], p0[r + 1]); b = max3f(b, p0[r + 2], p0[r + 3]); a = max3f(a, p1[r], p1[r + 1]); b = max3f(b, p1[r + 2], p1[r + 3]); }
    return max2f(a, b);
}

template <int MODE>
__device__ __forceinline__ void run_branch(LAS unsigned char* lds, const int nt, const int tile0, const bf16* kp, const size_t kst, const bf16* vp, const size_t vst,
                                           const bf16x8 (&qf)[4], State& st, const int tokl, const int ci, const int nvis, const unsigned sw0, const unsigned sw1, const unsigned sw2, const unsigned sw3, const float cm, const float cinv,
                                           const int tid, const int lane, const int wave) {
    const int c32 = lane & 31, hi = lane >> 5;
    const unsigned dmaw = (unsigned)wave * 1024u;
    const int xs = (hi ^ ((c32 >> 1) & 7)) * 16;
    f32x16 z16 = (f32x16){0.f}; asm volatile("" : "+v"(z16));
#define ATT_DMA(t) do { LAS unsigned char* _d = lds + L_BUF + ((t) & (NBUF - 1)) * BUFB + dmaw; \
        __builtin_amdgcn_global_load_lds((const unsigned*)(kp + (size_t)(t) * kst), (LAS unsigned*)_d, 16, 0, 0); \
        __builtin_amdgcn_global_load_lds((const unsigned*)(vp + (size_t)(t) * vst), (LAS unsigned*)(_d + TSZ), 16, 0, 0); } while (0)
    ATT_DMA(0); if (nt > 1) ATT_DMA(1); if (nt > 2) ATT_DMA(2);
    for (int i = 0; i < nt; ++i) {
        LAS unsigned char* cur = lds + L_BUF + (i & (NBUF - 1)) * BUFB;
        { const int rem = nt - 1 - i; if (rem >= 2) asm volatile("s_waitcnt vmcnt(4)" ::: "memory"); else if (rem == 1) asm volatile("s_waitcnt vmcnt(2)" ::: "memory"); else asm volatile("s_waitcnt vmcnt(0)" ::: "memory"); }
        __builtin_amdgcn_s_barrier(); asm volatile("" ::: "memory");
        if (i + 3 < nt) ATT_DMA(i + 3);
        const int tix = tile0 + i;
        bool lanesel = true; int klo = -1, khi = 64;
        bool need_mask = false, skip = false;
        if (MODE == M_WIN) { if (tix == 0) { klo = tokl; need_mask = true; } if (tix == 8) { khi = tokl; need_mask = true; } }
        if (MODE == M_SEL) { { const unsigned wsel = (tix < 32) ? sw0 : (tix < 64) ? sw1 : (tix < 96) ? sw2 : sw3; lanesel = (wsel >> (tix & 31)) & 1u; } if (tix == ci) { khi = tokl; need_mask = true; } skip = !__any(lanesel); }
        if (MODE == M_CMP1 || MODE == M_CMP2) { khi = nvis - 64 * tix - 1; need_mask = (64 * tix + 63 >= __builtin_amdgcn_readfirstlane(nvis)); }
        if (!skip) {
            f32x16 s0, s1;
            bf16x8 kf[8];
            { LAS const unsigned char* p = cur + c32 * 128;
#pragma unroll
              for (int ks = 0; ks < 4; ++ks) { kf[2 * ks] = *(LAS const bf16x8*)(p + ((ks * 32) ^ xs)); kf[2 * ks + 1] = *(LAS const bf16x8*)(p + 32 * 128 + ((ks * 32) ^ xs)); }
              __builtin_amdgcn_sched_barrier(0);
#pragma unroll
              for (int ks = 0; ks < 4; ++ks) { s0 = __builtin_amdgcn_mfma_f32_32x32x16_bf16(kf[2 * ks], qf[ks], ks ? s0 : z16, 0, 0, 0); s1 = __builtin_amdgcn_mfma_f32_32x32x16_bf16(kf[2 * ks + 1], qf[ks], ks ? s1 : z16, 0, 0, 0); } }
            asm volatile("s_nop 15\n\ts_nop 7" : "+v"(s0), "+v"(s1));
            if (need_mask) {
#pragma unroll
                for (int r = 0; r < 16; ++r) { const int kl = (r & 3) + 8 * (r >> 2) + 4 * hi;
                    s0[r] = (kl > klo && kl <= khi) ? s0[r] : -1e30f;
                    s1[r] = (kl + 32 > klo && kl + 32 <= khi) ? s1[r] : -1e30f; }
            }
            if (MODE == M_CMP2) {
                const float mneg = -fmaxf(cm, -1e29f) * L2E;
#pragma unroll
                for (int r = 0; r < 16; ++r) { s0[r] = __builtin_amdgcn_exp2f(__builtin_fmaf(s0[r], L2E, mneg)) * cinv; s1[r] = __builtin_amdgcn_exp2f(__builtin_fmaf(s1[r], L2E, mneg)) * cinv; }
                LAS float* imp = (LAS float*)(lds + L_IMP) + tokl * 128;
                if (true) {
#pragma unroll
                    for (int x = 0; x < 8; ++x) { const f32x16& sv = (x >> 2) ? s1 : s0; const int q4 = x & 3;
                        float gsum = (sv[4 * q4] + sv[4 * q4 + 1]) + (sv[4 * q4 + 2] + sv[4 * q4 + 3]); gsum += qxor1(gsum); gsum += qxor2(gsum);
                        const int j = 16 * tix + 8 * (x >> 2) + 2 * q4 + hi; if ((c32 & 3) == 0) imp[j] += gsum; }
                    asm volatile("" ::: "memory");
#pragma unroll
                    for (int x = 0; x < 8; ++x) { const f32x16& sv = (x >> 2) ? s1 : s0; const int q4 = x & 3;
                        float lst = sv[4 * q4 + 3]; lst += qxor1(lst); lst += qxor2(lst);
                        const int j = 16 * tix + 8 * (x >> 2) + 2 * q4 + hi; if ((c32 & 3) == 0 && j + 1 < 128) imp[j + 1] += lst; }
                }
            } else {
                float mx = tilemax(s0, s1);
                if (MODE == M_SEL) mx = lanesel ? mx : -1e30f;
                mx = halfmax(mx);
                if (__any(mx > st.m + 8.0f)) {
                    const float mnew = fmaxf(st.m, mx), alpha = __builtin_amdgcn_exp2f((st.m - mnew) * L2E);
                    st.l *= alpha; st.m = mnew;
                    if (MODE != M_CMP1) {
#pragma unroll
                        for (int r = 0; r < 16; ++r) { st.o0[r] *= alpha; st.o1[r] *= alpha; }
                    }
                }
                float mneg = -fmaxf(st.m, -1e29f) * L2E;
                if (MODE == M_SEL) mneg = lanesel ? mneg : -1e30f;
                f32x2 rs2 = (f32x2){0.f, 0.f}; const f32x2 l2e2 = (f32x2){L2E, L2E}, mn2 = (f32x2){mneg, mneg};
#pragma unroll
                for (int r = 0; r < 16; r += 2) { f32x2 a = (f32x2){s0[r], s0[r + 1]}, b = (f32x2){s1[r], s1[r + 1]};
                    a = a * l2e2 + mn2; b = b * l2e2 + mn2;
                    a.x = __builtin_amdgcn_exp2f(a.x); a.y = __builtin_amdgcn_exp2f(a.y); b.x = __builtin_amdgcn_exp2f(b.x); b.y = __builtin_amdgcn_exp2f(b.y);
                    s0[r] = a.x; s0[r + 1] = a.y; s1[r] = b.x; s1[r + 1] = b.y; rs2 += a; rs2 += b; }
                st.l += rs2.x + rs2.y;
            }
            if (MODE != M_CMP1) {
                bf16x8 vf[8];
                { LAS const unsigned char* pv = cur + TSZ + c32 * 128;
#pragma unroll
                  for (int q = 0; q < 4; ++q) { vf[2 * q] = *(LAS const bf16x8*)(pv + ((q * 32) ^ xs)); vf[2 * q + 1] = *(LAS const bf16x8*)(pv + 32 * 128 + ((q * 32) ^ xs)); } }
                __builtin_amdgcn_sched_barrier(0);
#pragma unroll
                for (int sub = 0; sub < 2; ++sub)
#pragma unroll
                    for (int s = 0; s < 2; ++s) { const f32x16& sv = sub ? s1 : s0;
                        u32x4 pw; pw.x = cvt_pk_bf16(sv[8 * s + 0], sv[8 * s + 1]); pw.y = cvt_pk_bf16(sv[8 * s + 2], sv[8 * s + 3]); pw.z = cvt_pk_bf16(sv[8 * s + 4], sv[8 * s + 5]); pw.w = cvt_pk_bf16(sv[8 * s + 6], sv[8 * s + 7]);
                        const bf16x8 pb = __builtin_bit_cast(bf16x8, pw);
                        st.o0 = __builtin_amdgcn_mfma_f32_32x32x16_bf16(vf[2 * (2 * sub + s)], pb, st.o0, 0, 0, 0); st.o1 = __builtin_amdgcn_mfma_f32_32x32x16_bf16(vf[2 * (2 * sub + s) + 1], pb, st.o1, 0, 0, 0); }
            }
        }
    }
    asm volatile("s_waitcnt lgkmcnt(0)" ::: "memory"); __builtin_amdgcn_s_barrier(); asm volatile("" ::: "memory");
#undef ATT_DMA
}

template <bool ACC, bool LAST8 = false> __device__ __forceinline__ void o_update(bf16* op, const f32x16& o0, const f32x16& o1, float sc, unsigned char* op8 = nullptr) {
#pragma unroll
    for (int q4 = 0; q4 < 4; ++q4) {
        f32x4 a = (f32x4){o0[4 * q4], o0[4 * q4 + 1], o0[4 * q4 + 2], o0[4 * q4 + 3]} * sc, b = (f32x4){o1[4 * q4], o1[4 * q4 + 1], o1[4 * q4 + 2], o1[4 * q4 + 3]} * sc;
        if (ACC) { const u32x2 pa = *(const u32x2*)(op + 8 * q4), pb = *(const u32x2*)(op + 32 + 8 * q4);
            a += (f32x4){bflo(pa.x), bfhi(pa.x), bflo(pa.y), bfhi(pa.y)}; b += (f32x4){bflo(pb.x), bfhi(pb.x), bflo(pb.y), bfhi(pb.y)}; }
        if (LAST8) { *(unsigned*)(op8 + 8 * q4) = f8pack4(a[0], a[1], a[2], a[3], F8_SO); *(unsigned*)(op8 + 32 + 8 * q4) = f8pack4(b[0], b[1], b[2], b[3], F8_SO); }
        else { u32x2 w0, w1; w0.x = cvt_pk_bf16(a[0], a[1]); w0.y = cvt_pk_bf16(a[2], a[3]); w1.x = cvt_pk_bf16(b[0], b[1]); w1.y = cvt_pk_bf16(b[2], b[3]);
            *(u32x2*)(op + 8 * q4) = w0; *(u32x2*)(op + 32 + 8 * q4) = w1; } }
}

__device__ __forceinline__ void attn_item(Frame& F, int b, int g, int ci) {
    LAS unsigned char* lds = F.lds + RING_OFF;
    const int tid = F.tid, lane = F.lane, wave = F.wave, c32 = lane & 31, hi = lane >> 5;
    const int tokl = 8 * wave + (c32 >> 2), h = c32 & 3, ts = 64 * ci + tokl; const size_t trow = (size_t)b * SEQ + ts;
    const int bg = b * 4 + g;
    const bf16* Q = (const bf16*)(F.ws + WS_Q); bf16* O = (bf16*)(F.ws + WS_O);
    bf16x8 qf[4];
    { const bf16* qp = Q + trow * 1024 + g * 256 + h * 64 + 8 * hi;
#pragma unroll
      for (int ks = 0; ks < 4; ++ks) qf[ks] = *(const bf16x8*)(qp + 16 * ks); }
    const bf16* ngp = (const bf16*)(F.ws + WS_NGT) + trow * 64 + g * 12 + h * 3;
#ifdef CHK_BR
    const float gate_c = (CHK_BR & 1) ? bf2f(ngp[0]) : 0.f, gate_s = (CHK_BR & 2) ? bf2f(ngp[1]) : 0.f, gate_w = (CHK_BR & 4) ? bf2f(ngp[2]) : 0.f;
#else
    const float gate_c = bf2f(ngp[0]), gate_s = bf2f(ngp[1]), gate_w = bf2f(ngp[2]);
#endif
    asm volatile("" : "+v"(qf[0]), "+v"(qf[1]), "+v"(qf[2]), "+v"(qf[3]));
    bf16* const op = O + trow * 1024 + g * 256 + h * 64 + 4 * hi;
    unsigned selw[4] = {0u, 0u, 0u, 0u};
    State st;
    { LAS f32x4* z = (LAS f32x4*)(lds + L_IMP) + tid * 4;
#pragma unroll
      for (int q = 0; q < 4; ++q) z[q] = (f32x4){0.f, 0.f, 0.f, 0.f}; }
    {
        asm volatile("" : "+s"(F.ws));
        int tidl = tid; asm volatile("" : "+v"(tidl)); const int srow = tidl >> 3, sch = (tidl & 7) ^ ((tidl >> 4) & 7);
        const int u0 = (ci >= 8) ? 0 : 8 - ci, nt = 9 - u0; const int pos0 = 64 * (ci - 8 + u0);
        const bf16* kp = (const bf16*)(F.ws + WS_KV + 4 * KV_STRIDE) + ((size_t)b * SEQ + pos0 + srow) * 256 + g * 64 + 8 * sch;
        const bf16* vp = (const bf16*)(F.ws + WS_VWT) + ((size_t)bg * 64 + srow) * SEQ + pos0 + 8 * sch;
#if defined(ATT_DBL) && ATT_DBL == 1
#pragma unroll 1
        for (int rep = 0; rep < 2; ++rep) {
#else
        {
#endif
        st.m = -1e30f; st.l = 0.f; st.o0 = (f32x16){0.f}; st.o1 = (f32x16){0.f};
        run_branch<M_WIN>(lds, nt, u0, kp, (size_t)64 * 256, vp, (size_t)64, qf, st, tokl, ci, 0, selw[0], selw[1], selw[2], selw[3], 0.f, 0.f, tid, lane, wave);
        }
        const float lt = halfsum(st.l); const float sc = (lt > 0.f) ? gate_w / lt : 0.f;
        o_update<false>(op, st.o0, st.o1, sc);
    }
    {
        asm volatile("" : "+s"(F.ws));
        int tidl = tid; asm volatile("" : "+v"(tidl)); const int srow = tidl >> 3, sch = (tidl & 7) ^ ((tidl >> 4) & 7);
        const int ncmp = (4 * ci + 3 < NCMP) ? 4 * ci + 3 : NCMP, nt = (ncmp + 63) >> 6;
        const int nvis = (ts >= 31) ? (ts - 15) >> 4 : 0;
        const bf16* kp = (const bf16*)(F.ws + WS_KC) + ((size_t)bg * 512 + srow) * 64 + 8 * sch;
        const bf16* vp = (const bf16*)(F.ws + WS_VCT) + ((size_t)bg * 64 + srow) * 512 + 8 * sch;
        st.m = -1e30f; st.l = 0.f; st.o0 = (f32x16){0.f}; st.o1 = (f32x16){0.f};
        run_branch<M_CMP1>(lds, nt, 0, kp, (size_t)64 * 64, vp, (size_t)64, qf, st, tokl, ci, nvis, selw[0], selw[1], selw[2], selw[3], 0.f, 0.f, tid, lane, wave);
        const float lt = halfsum(st.l); const float cinv = (lt > 0.f) ? 1.0f / lt : 0.f; const float cm = st.m;
        run_branch<M_CMP2>(lds, nt, 0, kp, (size_t)64 * 64, vp, (size_t)64, qf, st, tokl, ci, nvis, selw[0], selw[1], selw[2], selw[3], cm, cinv, tid, lane, wave);
        o_update<true>(op, st.o0, st.o1, gate_c);
    }
    {
        LAS unsigned* SEL = (LAS unsigned*)(lds + L_SEL);
#if defined(ATT_DBL) && ATT_DBL == 3
#pragma unroll 1
        for (int rep = 0; rep < 2; ++rep)
#endif
        if (ci >= SELTOP) {
            const LAS float* imp = (const LAS float*)(lds + L_IMP);
            const int tk = lane >> 3, r8 = lane & 7, tl2 = 8 * wave + tk;
            float cv[16];
            { const LAS f32x4* ip = (const LAS f32x4*)(imp + tl2 * 128 + 16 * r8);
#pragma unroll
              for (int q = 0; q < 4; ++q) { const f32x4 t4 = ip[q]; cv[4 * q] = t4.x; cv[4 * q + 1] = t4.y; cv[4 * q + 2] = t4.z; cv[4 * q + 3] = t4.w; } }
            unsigned ku[16];
#pragma unroll
            for (int i = 0; i < 16; ++i) { const int j = 16 * r8 + i; ku[i] = (j >= 1 && j <= ci - 2) ? ((__builtin_bit_cast(unsigned, fmaxf(cv[i], 0.f)) & ~0xFFu) | (unsigned)(255 - j)) : 0u; }
            unsigned mymask = 0u;
#pragma unroll 1
            for (int r = 0; r < SELTOP - 3; ++r) {
                unsigned m = max(max(ku[0], ku[1]), max(ku[2], ku[3]));
#pragma unroll
                for (int i = 4; i < 16; i += 4) m = max(m, max(max(ku[i], ku[i + 1]), max(ku[i + 2], ku[i + 3])));
                m = max(m, (unsigned)__builtin_amdgcn_update_dpp((int)m, (int)m, 0xB1, 0xF, 0xF, false));
                m = max(m, (unsigned)__builtin_amdgcn_update_dpp((int)m, (int)m, 0x4E, 0xF, 0xF, false));
                m = max(m, (unsigned)__builtin_amdgcn_update_dpp((int)m, (int)m, 0x141, 0xF, 0xF, false));
                const int gj = 255 - (int)(m & 0xFFu);
                if ((gj >> 4) == r8) mymask |= 1u << (gj & 15);
#pragma unroll
                for (int i = 0; i < 16; ++i) ku[i] = (ku[i] == m) ? 0u : ku[i];
            }
            if (r8 == 0) mymask |= 1u;
            if (((ci - 1) >> 4) == r8) mymask |= 1u << ((ci - 1) & 15);
            if ((ci >> 4) == r8) mymask |= 1u << (ci & 15);
            { const unsigned other = (unsigned)__shfl_xor((int)mymask, 1); if ((r8 & 1) == 0) SEL[tl2 * 4 + (r8 >> 1)] = mymask | (other << 16); }
            LDS_WAIT(); asm volatile("" ::: "memory");
#pragma unroll
            for (int q = 0; q < 4; ++q) selw[q] = SEL[tokl * 4 + q];
        } else {
            selw[0] = (ci == 31) ? 0xffffffffu : ((1u << (ci + 1)) - 1u); selw[1] = 0u; selw[2] = 0u; selw[3] = 0u;
        }
    }
    asm volatile("" : "+s"(F.ws));
    {
        int tidl = tid; asm volatile("" : "+v"(tidl)); const int srow = tidl >> 3, sch = (tidl & 7) ^ ((tidl >> 4) & 7);
        const int nt = ci + 1;
        const bf16* kp = (const bf16*)(F.ws + WS_KV + 2 * KV_STRIDE) + ((size_t)b * SEQ + srow) * 256 + g * 64 + 8 * sch;
        const bf16* vp = (const bf16*)(F.ws + WS_VST) + ((size_t)bg * 64 + srow) * SEQ + 8 * sch;
        bf16x8 qf2[4];
        { const bf16* qp2 = Q + trow * 1024 + g * 256 + h * 64 + 8 * hi;
#pragma unroll
          for (int ks = 0; ks < 4; ++ks) qf2[ks] = *(const bf16x8*)(qp2 + 16 * ks); }
        asm volatile("" : "+v"(qf2[0]), "+v"(qf2[1]), "+v"(qf2[2]), "+v"(qf2[3]));
        st.m = -1e30f; st.l = 0.f; st.o0 = (f32x16){0.f}; st.o1 = (f32x16){0.f};
        run_branch<M_SEL>(lds, nt, 0, kp, (size_t)64 * 256, vp, (size_t)64, qf2, st, tokl, ci, 0, selw[0], selw[1], selw[2], selw[3], 0.f, 0.f, tid, lane, wave);
        const float lt = halfsum(st.l); const float sc = (lt > 0.f) ? gate_s / lt : 0.f;
#if F8_MIXB
        o_update<true, true>(op, st.o0, st.o1, sc, F.ws + WS_O8 + (trow * 1024 + g * 256 + h * 64 + 4 * hi));
#else
        o_update<true>(op, st.o0, st.o1, sc);
#endif
    }
}
__device__ __forceinline__ void attn_phase(Frame& F) {
    { const int x = (F.vcu >> 5) & 7, wl = F.vcu & 31;
        for (int k = 0; k < 8; ++k) { const int m = ((k & 1) ? 31 - wl : wl) + 32 * k, ci = 127 - (m >> 1), bg = 2 * x + (m & 1); attn_item(F, bg >> 2, bg & 3, ci); } }
}
}
#ifdef SELFCHECK
constexpr int CW_CHK = 60000;
__device__ __forceinline__ void chk_add(Frame& F, float err, float nrm) {
    if (F.lane == 0) { atomicAdd((float*)(F.ctl + CW_CHK), err); atomicAdd((float*)(F.ctl + CW_CHK) + 1, nrm); }
}
__device__ __forceinline__ void chk_attn_sample(Frame& F, int b, int ts, int g) {
    const int lane = F.lane, bg = b * 4 + g; const size_t trow = (size_t)b * SEQ + ts;
    LAS float* L = (LAS float*)(F.lds + RING_OFF + F.wave * 16384);
    LAS float* qs = L; LAS float* pc = L + 256; LAS float* sc = L + 256 + 2048; LAS float* impv = sc + 1024; LAS float* orf = impv + 128; LAS int* selL = (LAS int*)(orf + 256);
    const bf16* Q = (const bf16*)(F.ws + WS_Q); const bf16* O = (const bf16*)(F.ws + WS_O);
    const bf16* KC = (const bf16*)(F.ws + WS_KC) + (size_t)bg * 512 * 64; const bf16* VCT = (const bf16*)(F.ws + WS_VCT) + (size_t)bg * 64 * 512;
    const bf16* KS = (const bf16*)(F.ws + WS_KV + 2 * KV_STRIDE); const bf16* VS = (const bf16*)(F.ws + WS_KV + 3 * KV_STRIDE);
    const bf16* KW = (const bf16*)(F.ws + WS_KV + 4 * KV_STRIDE); const bf16* VW = (const bf16*)(F.ws + WS_KV + 5 * KV_STRIDE);
    const bf16* NGp = (const bf16*)(F.ws + WS_NGT) + trow * 64 + g * 12;
    for (int i = lane; i < 256; i += 64) qs[i] = bf2f(Q[trow * 1024 + g * 256 + i]);
    LDS_WAIT(); asm volatile("" ::: "memory");
    const int jq = ts >> 6, nvis = (ts >= 31) ? (ts - 15) >> 4 : 0;
    for (int i = lane; i < 256; i += 64) orf[i] = 0.f;
    for (int h = 0; h < 4; ++h) {
        float mx = -3e38f;
        for (int n = lane; n < 512; n += 64) { float s = -3e38f; if (n < nvis) { s = 0.f; for (int d = 0; d < 64; ++d) s += qs[h * 64 + d] * bf2f(KC[n * 64 + d]); } pc[h * 512 + n] = s; mx = fmaxf(mx, s); }
        mx = wave_max(mx); float sum = 0.f;
        for (int n = lane; n < 512; n += 64) { const float s = pc[h * 512 + n]; const float p = (n < nvis) ? __expf(s - mx) : 0.f; pc[h * 512 + n] = p; sum += p; }
        sum = wave_sum(sum); const float inv = (sum > 0.f) ? 1.f / sum : 0.f;
        for (int n = lane; n < 512; n += 64) pc[h * 512 + n] *= inv;
        LDS_WAIT(); asm volatile("" ::: "memory");
        float o = 0.f; for (int n = 0; n < nvis; ++n) o += pc[h * 512 + n] * bf2f(VCT[lane * 512 + perm16(n)]);
        if (CHK_BR & 1) orf[h * 64 + lane] += bf2f(NGp[h * 3 + 0]) * o;
    }
    for (int j = lane; j < 128; j += 64) { float a = 0.f; for (int h = 0; h < 4; ++h) for (int n = 4 * j - 1; n <= 4 * j + 3; ++n) if (n >= 0 && n < 511) a += pc[h * 512 + n];
        impv[j] = (j == 0 || j == jq || j == jq - 1) ? 1e4f : ((j <= jq) ? a : -1.0f); }
    LDS_WAIT(); asm volatile("" ::: "memory");
    { float v0 = impv[lane], v1 = impv[lane + 64];
      for (int r = 0; r < 16; ++r) { const float mx = wave_max(fmaxf(v0, v1)); const unsigned long long b0 = __ballot(v0 == mx); int js;
          if (b0) { js = __ffsll((long long)b0) - 1; if (lane == js) v0 = -3e38f; } else { const unsigned long long b1 = __ballot(v1 == mx); js = 64 + __ffsll((long long)b1) - 1; if (lane == js - 64) v1 = -3e38f; }
          if (lane == 0) selL[r] = js; } }
    LDS_WAIT(); asm volatile("" ::: "memory");
    for (int h = 0; h < 4; ++h) {
        float mx = -3e38f;
        for (int r = 0; r < 16; ++r) { const int pos = selL[r] * 64 + lane; float s = -3e38f;
            if (pos <= ts) { s = 0.f; const bf16* kr = KS + ((size_t)b * SEQ + pos) * 256 + g * 64; for (int d = 0; d < 64; ++d) s += qs[h * 64 + d] * bf2f(kr[d]); }
            sc[r * 64 + lane] = s; mx = fmaxf(mx, s); }
        mx = wave_max(mx); float sum = 0.f;
        for (int r = 0; r < 16; ++r) { const int pos = selL[r] * 64 + lane; const float p = (pos <= ts) ? __expf(sc[r * 64 + lane] - mx) : 0.f; sc[r * 64 + lane] = p; sum += p; }
        sum = wave_sum(sum); const float inv = (sum > 0.f) ? 1.f / sum : 0.f;
        LDS_WAIT(); asm volatile("" ::: "memory");
        float o = 0.f;
        for (int r = 0; r < 16; ++r) for (int i = 0; i < 64; ++i) { const int pos = selL[r] * 64 + i; if (pos <= ts) o += sc[r * 64 + i] * bf2f(VS[((size_t)b * SEQ + pos) * 256 + g * 64 + lane]); }
        if (CHK_BR & 2) orf[h * 64 + lane] += bf2f(NGp[h * 3 + 1]) * o * inv;
        LDS_WAIT(); asm volatile("" ::: "memory");
    }
    for (int h = 0; h < 4; ++h) {
        float mx = -3e38f;
        for (int i = lane; i < 512; i += 64) { const int pos = ts - 511 + i; float s = -3e38f;
            if (pos >= 0) { s = 0.f; const bf16* kr = KW + ((size_t)b * SEQ + pos) * 256 + g * 64; for (int d = 0; d < 64; ++d) s += qs[h * 64 + d] * bf2f(kr[d]); }
            sc[i] = s; mx = fmaxf(mx, s); }
        mx = wave_max(mx); float sum = 0.f;
        for (int i = lane; i < 512; i += 64) { const int pos = ts - 511 + i; const float p = (pos >= 0) ? __expf(sc[i] - mx) : 0.f; sc[i] = p; sum += p; }
        sum = wave_sum(sum); const float inv = (sum > 0.f) ? 1.f / sum : 0.f;
        LDS_WAIT(); asm volatile("" ::: "memory");
        float o = 0.f;
        for (int i = 0; i < 512; ++i) { const int pos = ts - 511 + i; if (pos >= 0) o += sc[i] * bf2f(VW[((size_t)b * SEQ + pos) * 256 + g * 64 + lane]); }
        if (CHK_BR & 4) orf[h * 64 + lane] += bf2f(NGp[h * 3 + 2]) * o * inv;
        LDS_WAIT(); asm volatile("" ::: "memory");
    }
    float err = 0.f, nrm = 0.f;
    for (int h = 0; h < 4; ++h) { const float ref = orf[h * 64 + lane];
        const float got = bf2f(O[trow * 1024 + g * 256 + h * 64 + lane]);
        err += (got - ref) * (got - ref); nrm += ref * ref; }
    err = wave_sum(err); nrm = wave_sum(nrm);
    chk_add(F, err, nrm);
}
__device__ __forceinline__ void chk_attn_phase(Frame& F) {
    const int gw = F.vcu * NWAVES + F.wave;
    const int tsl[32] = {0, 1, 30, 31, 32, 47, 63, 64, 65, 127, 128, 500, 511, 512, 513, 1000, 1023, 1024, 1087, 1500, 2047, 2048, 3000, 4095, 4096, 5000, 6143, 7000, 8000, 8128, 8190, 8191};
    if (gw < 32 * CHK_NSETS) { const int si = gw & 31, set = gw >> 5; int ts = 0;
#pragma unroll
        for (int k = 0; k < 32; ++k) if (si == k) ts = tsl[k];
        chk_attn_sample(F, (set + 1) & 3, ts, (set * 3 + 2) & 3); }
}
#endif
#ifndef MK_N_LAUNCHES
#define MK_N_LAUNCHES 1
#endif
constexpr int N_PHASES = 14;
constexpr int N_LAUNCHES = MK_N_LAUNCHES;

__global__ void __launch_bounds__(NTHREADS, 2) fwd_megakernel(Args args) {
    extern __shared__ __attribute__((aligned(16))) unsigned char lds_raw[];
    Frame F;
    F.lds = (LAS unsigned char*)lds_raw;
    F.MISC = (volatile LAS unsigned*)(F.lds + MISC_OFF);
    F.tid = threadIdx.x; F.lane = F.tid & 63; F.wave = __builtin_amdgcn_readfirstlane(F.tid >> 6);
    F.G = gridDim.x; { const int bx = blockIdx.x; F.vcu = (F.G % 8 == 0) ? (bx % 8) * (F.G / 8) + bx / 8 : bx; }
    F.ws = args.ws; F.ctl = (gu32*)(args.ws + WS_CTL); F.out = args.out;
    for (int u = F.tid; u < (LDS_BYTES - LDSCTL_OFF) / 4; u += NTHREADS) ((LAS unsigned*)(F.lds + LDSCTL_OFF))[u] = 0u;
    __syncthreads();
    XcdBarrier bar; bar.bar = (unsigned*)(F.ctl + CW_BAR); bar.x = 0; bar.st = nullptr; bar.wave = F.wave;
    bar = xcd_barrier_post((unsigned*)(F.ctl + CW_BAR), F.MISC + 8, F.wave);
    const int lo = args.ph_lo, hi = args.ph_hi;
#ifdef PH_MASK
#define IN(k) (((PH_MASK >> (k)) & 1) && lo <= (k) && (k) < hi)
#else
#define IN(k) (lo <= (k) && (k) < hi)
#endif
#ifdef TSTAMP
#define STAMP(k) do { if (blockIdx.x == 0 && F.tid == 0) ((unsigned long long*)(F.ctl + 41000))[(k)] = __builtin_amdgcn_s_memrealtime(); } while (0)
#else
#define STAMP(k) do {} while (0)
#endif
#define RELANE() do { F.lane = fresh_lane(); F.tid = F.wave * 64 + F.lane; } while (0)
#define SEAM(k) do { if (IN(k) && IN((k) + 1)) xcd_barrier(bar); STAMP((k) + 1); asm volatile("" : "+s"(F.ws), "+s"(F.out)); RELANE(); } while (0)
#define SEAM_LOCAL(k) do { __syncthreads(); STAMP((k) + 1); asm volatile("" : "+s"(F.ws), "+s"(F.out)); RELANE(); } while (0)
    LAS unsigned char* ring = F.lds + RING_OFF;
    const int G = F.G, bx = (int)blockIdx.x;

    STAMP(0);
    if (IN(0)) { p0_prologue(F, args);
#if defined(DBL_MASK) && (DBL_MASK & 0x1)
        xcd_barrier(bar); p0_prologue(F, args);
#endif
    } SEAM(0);
    if (IN(1)) { norm_mod_rows<true>(F, args, AIN[I_X], F8_WIN ? (bf16*)nullptr : (bf16*)(F.ws + WS_XN), AIN[I_N1G], 0, 1024, F8_WIN ? F.ws + WS_XN8A : nullptr); finalize_mod(F, args); } SEAM(1);
    if (IN(2)) {
#if F8_WIN
        pg8::DenseOrder S; S.init(F.ws + WS_XN8A, 1024, F.ws + WS_WIN, 512, T, NINP, G, bx);
        EpiIn E{(const float*)(F.ws + WS_BINP), (bf16*)(F.ws + WS_U), (bf16*)(F.ws + WS_Q), (bf16*)(F.ws + WS_KV), (bf16*)(F.ws + WS_NGT), (bf16*)(F.ws + WS_GM), 1.0f / (F8_SX * F8_SWG)};
        pg8::gemm_phase<EpiIn, pg8::DenseOrder, true, true, true>(ring, 512, S, E, F.wave);
        if (XC_R2 > 0 && bx >= 128) { asm volatile("" : "+s"(F.ws)); RELANE(); expert_convert(F, args, XC_N0, XC_N1, (bx - 128) * NWAVES + F.wave, 128 * NWAVES); }
#else
        pg8::DenseOrder S; S.init(F.ws + WS_XN, 2048, F.ws + WS_WIN, 1024, T, NINP, G, bx);
        EpiIn E{(const float*)(F.ws + WS_BINP), (bf16*)(F.ws + WS_U), (bf16*)(F.ws + WS_Q), (bf16*)(F.ws + WS_KV), (bf16*)(F.ws + WS_NGT), (bf16*)(F.ws + WS_GM), 1.0f};
        pg8::gemm_phase<EpiIn, pg8::DenseOrder, true, true>(ring, 1024, S, E, F.wave);
#endif
    } SEAM(2);
    if (IN(3)) {
#if defined(DBL_MASK) && (DBL_MASK & 0x8)
#pragma unroll 1
        for (int rep = 0; rep < 2; ++rep) { p3_phase(F, args); if (rep == 0) xcd_barrier(bar); }
#else
        p3_phase(F, args);
#endif
    } SEAM(3);
    if (IN(4)) {
#if defined(DBL_MASK) && (DBL_MASK & 0x10)
#pragma unroll 1
        for (int rep = 0; rep < 2; ++rep) { att::attn_phase(F); if (rep == 0) xcd_barrier(bar); }
#else
        att::attn_phase(F);
#endif
    } SEAM_LOCAL(4);
    if (IN(5)) {
#ifdef SELFCHECK
        chk_attn_phase(F); __syncthreads();
#endif
#if F8_MIXA
        pg8::DenseOrder S; S.init(F.ws + WS_CF, 512, F.ws + WS_WC, 256, T, 1024, G, bx);
        EpiMix<0> E{(const bf16*)(F.ws + WS_GM), (bf16*)(F.ws + WS_MIX), AIN[I_BCO], nullptr, 1.0f / (F8_SCF * F8_SWC)};
        pg8::gemm_phase<EpiMix<0>, pg8::DenseOrder, true, true, true>(ring, 256, S, E, F.wave);
#else
        pg8::DenseOrder S; S.init(F.ws + WS_CF, 1024, F.ws + WS_WC, 512, T, 1024, G, bx);
        EpiMix<0> E{(const bf16*)(F.ws + WS_GM), (bf16*)(F.ws + WS_MIX), AIN[I_BCO], nullptr, 1.0f};
        pg8::gemm_phase<EpiMix<0>, pg8::DenseOrder, true, true>(ring, 512, S, E, F.wave);
#endif
    } SEAM(5);
    if (IN(6)) {
#if F8_MIXB
        pg8::DenseOrder S; S.init(F.ws + WS_O8, 1024, F.ws + WS_WN, 512, T, 1024, G, bx);
        EpiMix<1> E{(const bf16*)(F.ws + WS_GM), (bf16*)(F.ws + WS_MIX), nullptr, F8_WOUT ? F.ws + WS_MIX8 : nullptr, 1.0f / (F8_SO * F8_SWG)};
        pg8::gemm_phase<EpiMix<1>, pg8::DenseOrder, true, true, true>(ring, 512, S, E, F.wave);
#else
        pg8::DenseOrder S; S.init(F.ws + WS_O, 2048, F.ws + WS_WN, 1024, T, 1024, G, bx);
        EpiMix<1> E{(const bf16*)(F.ws + WS_GM), (bf16*)(F.ws + WS_MIX), nullptr, F8_WOUT ? F.ws + WS_MIX8 : nullptr, 1.0f};
        pg8::gemm_phase<EpiMix<1>, pg8::DenseOrder, true, true>(ring, 1024, S, E, F.wave);
#endif
    } SEAM(6);
    if (IN(7)) {
#if F8_WOUT
        pg8::DenseOrder S; S.init(F.ws + WS_MIX8, 1024, F.ws + WS_WO, 512, T, 1024, G, bx);
        EpiOut E{AIN[I_X], (bf16*)(F.ws + WS_X1), (const float*)(F.ws + WS_MODF) + 2048, 1.0f / (F8_SMIX * F8_SWG)};
        pg8::gemm_phase<EpiOut, pg8::DenseOrder, true, true, true>(ring, 512, S, E, F.wave);
#else
        pg8::DenseOrder S; S.init(F.ws + WS_MIX, 2048, F.ws + WS_WO, 1024, T, 1024, G, bx);
        EpiOut E{AIN[I_X], (bf16*)(F.ws + WS_X1), (const float*)(F.ws + WS_MODF) + 2048, 1.0f};
        pg8::gemm_phase<EpiOut, pg8::DenseOrder, true, true>(ring, 1024, S, E, F.wave);
#endif
    } SEAM(7);
    if (IN(8)) {
        pg8::DenseOrder S; S.init(F.ws + WS_XN, 2048, F.ws + WS_WR, 1024, T, 256, 128, bx);
        pg8::Unit u0; const bool has = (bx < 128) && S.next(0, u0);
        if (has) {
            norm_mod_rows<false, true>(F, args, (const float*)(F.ws + WS_X1), (bf16*)(F.ws + WS_XN), AIN[I_N2G], 3072, 4096, F.ws + WS_XN8, u0.pm * 16);
            asm volatile("s_waitcnt vmcnt(0)" ::: "memory"); __syncthreads();
            EpiLogits E{(float*)(F.ws + WS_LOG)};
            pg8::gemm_phase<EpiLogits, pg8::DenseOrder, true, true>(ring, 1024, S, E, F.wave);
            asm volatile("s_waitcnt vmcnt(0)" ::: "memory"); __syncthreads();
            asm volatile("" : "+s"(F.ws)); RELANE();
            routing_phase(F, args, u0.pm * 256);
        } else if (XC_R9 > 0) { expert_convert(F, args, XC_N1, XC_TOTAL, (bx - 128) * NWAVES + F.wave, 128 * NWAVES); }
    } SEAM_LOCAL(8); SEAM_LOCAL(9); SEAM(10);
    if (IN(11)) {
        build_tables(F);
        const LAS int* tab = (const LAS int*)(F.lds + TAB_OFF);
        ExpertOrder S{tab, (const char*)(F.ws + WS_XN8), (const char*)(F.ws + WS_WGU), (const char*)(F.ws + WS_WSHGU), nullptr, (const int*)(F.ws + WS_TOKL), 0, 1, G, F.vcu, tab[260 + NEXP + 1]};
        EpiAct E{F.ws + WS_ACT, F.ws + WS_ACTSH};
#if defined(DBL_MASK) && (DBL_MASK & 0x800)
#pragma unroll 1
        for (int rep = 0; rep < 2; ++rep) { pg8::gemm_phase<EpiAct, ExpertOrder, true, true, true>(ring, 512, S, E, F.wave); if (rep == 0) xcd_barrier(bar); }
#else
        pg8::gemm_phase<EpiAct, ExpertOrder, true, true, true>(ring, 512, S, E, F.wave);
#endif
    } SEAM(11);
    if (IN(12)) {
        build_tables(F);
        const LAS int* tab = (const LAS int*)(F.lds + TAB_OFF);
        ExpertOrder S{tab, (const char*)(F.ws + WS_ACT), (const char*)(F.ws + WS_WD), (const char*)(F.ws + WS_WSHD), (const char*)(F.ws + WS_ACTSH), nullptr, 1, 2, G, F.vcu, 2 * tab[260 + NEXP + 1]};
        EpiDown E{(unsigned char*)(F.ws + WS_YS8), (bf16*)(F.ws + WS_YSS)};
        pg8::gemm_phase<EpiDown, ExpertOrder, true, true, true>(ring, 128, S, E, F.wave);
    } SEAM(12);
    if (IN(13)) { build_tables(F);
#if defined(DBL_MASK) && (DBL_MASK & 0x2000)
        combine_phase(F, args, (float*)(F.ws + WS_GM)); xcd_barrier(bar); asm volatile("" : "+s"(F.ws), "+s"(F.out));
#endif
        combine_phase(F, args, F.out); }
#undef IN
#undef SEAM
#undef SEAM_LOCAL
#undef RELANE
}

extern "C" void kernel_launch(void* const* d_in, const int* in_sizes, int n_in, void* d_out, int out_size, void* d_ws, size_t ws_size, hipStream_t stream) {
    static int grid = 0;
    if (grid == 0) {
        if (n_in != 31 || in_sizes[0] != T * DM || out_size != T * DM || ws_size < WS_END) { fprintf(stderr, "kernel_launch: unexpected problem (n_in %d, in0 %d, out %d, ws %zu); nothing launched\n", n_in, n_in > 0 ? in_sizes[0] : -1, out_size, ws_size); grid = -1; return; }
        int dev = 0, cus = 0, per_cu = 0;
        if (hipGetDevice(&dev) != hipSuccess || hipDeviceGetAttribute(&cus, hipDeviceAttributeMultiprocessorCount, dev) != hipSuccess) { grid = -1; return; }
        if (hipFuncSetAttribute((const void*)fwd_megakernel, hipFuncAttributeMaxDynamicSharedMemorySize, LDS_BYTES) != hipSuccess) { fprintf(stderr, "kernel_launch: hipFuncSetAttribute failed\n"); grid = -1; return; }
        if (hipOccupancyMaxActiveBlocksPerMultiprocessor(&per_cu, (const void*)fwd_megakernel, NTHREADS, LDS_BYTES) != hipSuccess || per_cu < 1)
            fprintf(stderr, "kernel_launch: note: occupancy query reports %d workgroups per CU\n", per_cu);
        (void)hipGetLastError();
        if (cus < 256) { fprintf(stderr, "kernel_launch: this kernel's work split needs 256 resident workgroups (one per CU); device has %d CUs; nothing launched\n", cus); grid = -1; return; }
        grid = 256;
    }
    if (grid < 0) return;
    if (hipMemsetAsync((char*)d_ws + WS_CTL, 0, CTL_ZERO_BYTES, stream) != hipSuccess) { fprintf(stderr, "kernel_launch: memset failed\n"); return; }
    Args a{};
    for (int i = 0; i < 31; ++i) a.in[i] = (const float*)d_in[i];
    a.out = (float*)d_out; a.ws = (unsigned char*)d_ws;
    for (int li = 0; li < N_LAUNCHES; ++li) {
        a.ph_lo = (N_LAUNCHES == 1) ? 0 : li; a.ph_hi = (N_LAUNCHES == 1) ? N_PHASES : li + 1; a.li = li;
        hipLaunchKernelGGL(fwd_megakernel, dim3(grid), dim3(NTHREADS), LDS_BYTES, stream, a);
        const hipError_t le = hipPeekAtLastError();
        if (le != hipSuccess) { fprintf(stderr, "kernel_launch: launch %d failed: %s\n", li, hipGetErrorName(le)); break; }
    }
}
```
